# Optimizing an MI355X kernel written in HIP

```python
import jax, jax.numpy as jnp
from jax import lax
import numpy as np

D_MODEL = 1024
BATCH = 8
SEQ = 2048
DEPTH = 1
DEC_BATCH = 128
DEC_SEQ = 1
PAST_LEN = 16384
PAGE_SIZE = 128

D_CONV = D_MODEL
CONV_A_W = 3
N_HEADS = 8
HEAD_K = 128
HEAD_V = 128
D_K = N_HEADS * HEAD_K
D_V = N_HEADS * HEAD_V
D_QKV = 2 * D_K + D_V
CONV_B_W = 4
CHUNK = 64
EPS = 1e-6
IN_SIZES = (D_CONV, D_CONV, D_CONV, D_CONV, D_QKV, D_V, N_HEADS, N_HEADS, D_MODEL, D_MODEL)
IN_COLS = sum(IN_SIZES)

kernel_name = "hybrid_shortconv_gdn_decode_step"


def rmsnorm(x, w):
    xf = x.astype(jnp.float32)
    y = xf * lax.rsqrt(jnp.mean(xf * xf, axis=-1, keepdims=True) + EPS)
    return (y * w.astype(jnp.float32)).astype(x.dtype)


def l2norm(x):
    xf = x.astype(jnp.float32)
    return xf * lax.rsqrt(jnp.sum(xf * xf, axis=-1, keepdims=True) + EPS)


def causal_dwconv(x, buf, w):
    width = w.shape[0]
    L = x.shape[1]
    xp = jnp.concatenate([buf.astype(x.dtype), x], axis=1)
    y = xp[:, 0:L] * w[0]
    for j in range(1, width):
        y = y + xp[:, j:j + L] * w[j]
    return y, xp[:, L:]


def gated_delta_chunked(q, k, v, beta, g, s0):
    bsz, L = q.shape[0], q.shape[1]
    dv = v.shape[-1]
    C = min(CHUNK, L)
    n = -(-L // C)
    pad = n * C - L

    def prep(t):
        t = t.astype(jnp.float32)
        t = jnp.pad(t, [(0, 0), (0, pad)] + [(0, 0)] * (t.ndim - 2))
        t = t.reshape((bsz, n, C) + t.shape[2:])
        return jnp.moveaxis(t, 3, 1)

    q, k, v, beta, g = prep(q), prep(k), prep(v), prep(beta), prep(g)
    q = q * (HEAD_K ** -0.5)
    gc = jnp.cumsum(g, axis=-1)
    idx = jnp.arange(C)
    causal = idx[:, None] >= idx[None, :]
    strict = idx[:, None] > idx[None, :]
    decay = jnp.exp(jnp.where(causal, gc[..., :, None] - gc[..., None, :], -jnp.inf))
    kb = k * beta[..., None]
    a_mat = jnp.where(strict, jnp.einsum('bhncd,bhnsd->bhncs', kb, k) * decay, 0.0)
    a_mat = a_mat + jnp.eye(C, dtype=jnp.float32)
    rhs = jnp.concatenate([v * beta[..., None], kb * jnp.exp(gc)[..., None]], axis=-1)
    sol = lax.linalg.triangular_solve(a_mat, rhs, left_side=True, lower=True, unit_diagonal=True)
    u, w = sol[..., :dv], sol[..., dv:]
    attn_qk = jnp.einsum('bhncd,bhnsd->bhncs', q, k) * decay
    q_dec = q * jnp.exp(gc)[..., None]
    k_dec = k * jnp.exp(gc[..., -1:] - gc)[..., None]
    g_last = jnp.exp(gc[..., -1])

    def step(S, xs):
        u_c, w_c, qd_c, aqk_c, kd_c, gl_c = xs
        v_new = u_c - jnp.einsum('bhcd,bhde->bhce', w_c, S)
        o = jnp.einsum('bhcd,bhde->bhce', qd_c, S) + jnp.einsum('bhcs,bhse->bhce', aqk_c, v_new)
        S = S * gl_c[..., None, None] + jnp.einsum('bhcd,bhce->bhde', kd_c, v_new)
        return S, o

    xs = tuple(jnp.moveaxis(t, 2, 0) for t in (u, w, q_dec, attn_qk, k_dec, g_last))
    S, o = lax.scan(step, s0.astype(jnp.float32), xs)
    o = jnp.moveaxis(o, 0, 2).reshape(bsz, o.shape[2], n * C, dv)[:, :, :L]
    return jnp.transpose(o, (0, 2, 1, 3)), S


def mixer_layer(x, c, buf_a, buf_b, s0, ada_w, ada_b, norm_pre, w_in, conv_a_w, conv_b_w,
                a_log, dt_bias, onorm_w, w_out_a, w_out_b, w_o, norm_post):
    bsz, L, _ = x.shape
    mod = jax.nn.silu(c) @ ada_w + ada_b
    shift, scale, gate = jnp.split(mod, 3, axis=-1)
    h = rmsnorm(x, norm_pre) * (1.0 + scale[:, None]) + shift[:, None]
    proj = h @ w_in
    offs = [int(o) for o in np.cumsum(IN_SIZES)[:-1]]
    hA, cA, bA, zA, qkv, zB, beta_raw, alpha_raw, gA, gB = jnp.split(proj, offs, axis=-1)

    a_conv, new_buf_a = causal_dwconv(cA * hA, buf_a, conv_a_w)
    yA = ((bA * a_conv) * jax.nn.silu(zA)) @ w_out_a

    qkv_c, new_buf_b = causal_dwconv(qkv, buf_b, conv_b_w)
    qkv_c = jax.nn.silu(qkv_c)
    q, k, v = jnp.split(qkv_c, [D_K, 2 * D_K], axis=-1)
    q = l2norm(q.reshape(bsz, L, N_HEADS, HEAD_K))
    k = l2norm(k.reshape(bsz, L, N_HEADS, HEAD_K))
    v = v.reshape(bsz, L, N_HEADS, HEAD_V)
    beta = jax.nn.sigmoid(beta_raw.astype(jnp.float32))
    g = -jnp.exp(a_log.astype(jnp.float32)) * jax.nn.softplus(
        alpha_raw.astype(jnp.float32) + dt_bias.astype(jnp.float32))
    o, S = gated_delta_chunked(q, k, v, beta, g, s0)
    o = rmsnorm(o, onorm_w) * jax.nn.silu(zB.reshape(bsz, L, N_HEADS, HEAD_V).astype(jnp.float32))
    yB = o.reshape(bsz, L, D_V).astype(x.dtype) @ w_out_b

    merged = jax.nn.sigmoid(gA) * yA + jax.nn.sigmoid(gB) * yB
    post = rmsnorm(merged @ w_o, norm_post)
    y = (x + gate[:, None] * post).astype(x.dtype)
    return y, new_buf_a, new_buf_b, S


def setup_inputs(seed: int = 0) -> dict:
    key = jax.random.key(seed)
    ks = jax.random.split(key, 24)
    f32 = jnp.float32

    def nrm(k, shape, s):
        return jax.random.normal(k, shape, f32) * s

    dt = jnp.exp(jax.random.uniform(ks[14], (DEPTH, N_HEADS), f32, np.log(1e-3), np.log(1e-1)))
    dt_bias = dt + jnp.log(-jnp.expm1(-dt))
    return {
        "x_prompt": nrm(ks[0], (BATCH, SEQ, D_MODEL), 1.0),
        "x_sample": nrm(ks[1], (DEC_BATCH, DEC_SEQ, D_MODEL), 1.0),
        "c_prompt": nrm(ks[2], (BATCH, D_MODEL), 1.0),
        "c_sample": nrm(ks[3], (DEC_BATCH, D_MODEL), 1.0),
        "state_conv_a": nrm(ks[4], (DEPTH, DEC_BATCH, CONV_A_W - 1, D_CONV), 1.0),
        "state_conv_qkv": nrm(ks[5], (DEPTH, DEC_BATCH, CONV_B_W - 1, D_QKV), 1.0),
        "state_delta": nrm(ks[6], (DEPTH, DEC_BATCH, N_HEADS, HEAD_K, HEAD_V), 0.1),
        "ada_w": nrm(ks[7], (DEPTH, D_MODEL, 3 * D_MODEL), 0.5 * D_MODEL ** -0.5),
        "ada_b": nrm(ks[8], (DEPTH, 3 * D_MODEL), 0.01),
        "norm_pre": 1.0 + nrm(ks[9], (DEPTH, D_MODEL), 0.05),
        "w_in": nrm(ks[10], (DEPTH, D_MODEL, IN_COLS), D_MODEL ** -0.5),
        "conv_a_w": nrm(ks[11], (DEPTH, CONV_A_W, D_CONV), CONV_A_W ** -0.5),
        "conv_b_w": nrm(ks[12], (DEPTH, CONV_B_W, D_QKV), CONV_B_W ** -0.5),
        "a_log": jnp.log(jax.random.uniform(ks[13], (DEPTH, N_HEADS), f32, 1.0, 16.0)),
        "dt_bias": dt_bias,
        "onorm_w": 1.0 + nrm(ks[15], (DEPTH, HEAD_V), 0.05),
        "w_out_a": nrm(ks[16], (DEPTH, D_CONV, D_MODEL), D_CONV ** -0.5),
        "w_out_b": nrm(ks[17], (DEPTH, D_V, D_MODEL), D_V ** -0.5),
        "w_o": nrm(ks[18], (DEPTH, D_MODEL, D_MODEL), D_MODEL ** -0.5),
        "norm_post": 1.0 + nrm(ks[19], (DEPTH, D_MODEL), 0.05),
    }


def reference(x_prompt, x_sample, c_prompt, c_sample, state_conv_a, state_conv_qkv, state_delta,
              ada_w, ada_b, norm_pre, w_in, conv_a_w, conv_b_w, a_log, dt_bias, onorm_w,
              w_out_a, w_out_b, w_o, norm_post):
    yp, ys = x_prompt, x_sample
    bp = x_prompt.shape[0]
    pa, pb, pd, sa, sb, sd = [], [], [], [], [], []
    for l in range(DEPTH):
        weights = (ada_w[l], ada_b[l], norm_pre[l], w_in[l], conv_a_w[l], conv_b_w[l], a_log[l],
                   dt_bias[l], onorm_w[l], w_out_a[l], w_out_b[l], w_o[l], norm_post[l])
        zero_a = jnp.zeros((bp, CONV_A_W - 1, D_CONV), yp.dtype)
        zero_b = jnp.zeros((bp, CONV_B_W - 1, D_QKV), yp.dtype)
        zero_s = jnp.zeros((bp, N_HEADS, HEAD_K, HEAD_V), jnp.float32)
        yp, na, nb, ns = mixer_layer(yp, c_prompt, zero_a, zero_b, zero_s, *weights)
        pa.append(na)
        pb.append(nb)
        pd.append(ns.astype(state_delta.dtype))
        ys, ma, mb, ms = mixer_layer(ys, c_sample, state_conv_a[l], state_conv_qkv[l], state_delta[l], *weights)
        sa.append(ma)
        sb.append(mb)
        sd.append(ms.astype(state_delta.dtype))
    return (yp, ys, jnp.stack(pa), jnp.stack(pb), jnp.stack(pd), jnp.stack(sa), jnp.stack(sb), jnp.stack(sd))
```

```cpp
#include <hip/hip_runtime.h>
#include <hip/hip_cooperative_groups.h>
#include <cstdio>
#include <cstdint>
namespace cg = cooperative_groups;
namespace pg8 {
#define PG8_LAS __attribute__((address_space(3)))
typedef unsigned short bf16_t;
typedef short bf16x8 __attribute__((ext_vector_type(8)));
typedef float f32x4 __attribute__((ext_vector_type(4)));
typedef unsigned u32x4 __attribute__((ext_vector_type(4)));
constexpr int BM = 256, BK = 64, HALF = 128, HTB = HALF * BK * 2  , STAGE_BYTES = 8 * HTB, NXCD = 8, WGM = 4;

__host__ __device__ __forceinline__ int lds_byte(int r, int c) { const int st = (r >> 4) * 2 + (c >> 5), rr = r & 15, cc = c & 31, ob = rr * 64 + cc * 2; return st * 1024 + (ob ^ (((ob >> 9) & 1) << 5)); }
__host__ __device__ __forceinline__ void stage_rc(int b, int& R, int& C) { const int st = b / 1024, sb = b % 1024, swz = sb ^ (((sb >> 9) & 1) << 5); R = (st >> 1) * 16 + swz / 64; C = (st & 1) * 32 + (swz % 64) / 2; }
__host__ __device__ __forceinline__ int perm32(int rho) { const int n = rho >> 4, i = rho & 15; return 8 * (i >> 2) + 4 * n + (i & 3); }

struct Unit { int pm, pn; };
struct Gemm { const bf16_t* A; const bf16_t* Bt; int M, N, K; };

struct StaticOrder {
    int nM, nN, nwg, G, c;
    __host__ __device__ void init(int M, int N, int G_, int c_) { nM = M / BM; nN = N / BM; nwg = nM * nN; G = G_; c = c_; }
    __host__ __device__ bool next(int i, Unit& u) const {
        const long L = (long)i * G + c; if (L >= nwg) return false;
        int wgid = (int)L; { const int q = nwg / NXCD, r = nwg % NXCD, xcd = wgid % NXCD, off = wgid / NXCD; wgid = (xcd < r ? xcd * (q + 1) : r * (q + 1) + (xcd - r) * q) + off; }
        const int nig = WGM * nN, gid = wgid / nig, fm = gid * WGM, gsz = (nM - fm) < WGM ? (nM - fm) : WGM;
        u.pm = fm + ((wgid % nig) % gsz); u.pn = (wgid % nig) / gsz; return true;
    }
    __device__ __forceinline__ void a_ready(const Unit&) const {}
    __device__ __forceinline__ void done(const Unit&) const {}
};

__device__ __forceinline__ unsigned cvt_pk_bf16(float lo, float hi) { unsigned r; asm volatile("v_cvt_pk_bf16_f32 %0, %1, %2" : "=v"(r) : "v"(lo), "v"(hi)); return r; }
typedef float f32x2 __attribute__((ext_vector_type(2)));
template <class Epi, class Sched, bool ALIGN_EPI = false, bool SP2 = false>
__device__ __forceinline__ void gemm_phase(PG8_LAS unsigned char* lds, const Gemm g, const Sched& S, const Epi& E) {
    int tid = threadIdx.x; asm volatile("" : "+v"(tid));
    const int wid = __builtin_amdgcn_readfirstlane(tid >> 6), lane = tid & 63, wr = wid >> 2, wc = wid & 3, fr = lane & 15, fq = lane >> 4;
    const int K = g.K, nt = K / BK;
    unsigned voffA[2], voffB[2];
#pragma unroll
    for (int i = 0; i < 2; ++i) { int R, C; stage_rc(tid * 16 + i * 8192, R, C); const int Rb = Epi::PERM ? ((R & ~31) + perm32(R & 31)) : R;
        voffA[i] = (unsigned)(R * K + C) * 2u; voffB[i] = (unsigned)(Rb * K + C) * 2u; }
    const size_t kstep = (size_t)(BK * 2);
    const size_t hstep = (size_t)HALF * K * 2;
    const size_t tstep = 2 * hstep;
    const unsigned ldsw = (unsigned)wid * 1024u;
    const int aoff = lds_byte(wr * 64 + fr, fq * 8), boff = lds_byte(wc * 32 + fr, fq * 8);
#define PG8_SA(b, h) (((b) * 2 + (h)) * HTB)
#define PG8_SB(b, h) ((4 + (b) * 2 + (h)) * HTB)
#define PG8_STAGE(bufoff, gbase, voff) do { _Pragma("unroll") for (int _i = 0; _i < 2; ++_i) \
        __builtin_amdgcn_global_load_lds((const unsigned*)((const char*)(gbase) + (voff)[_i]), (PG8_LAS unsigned*)(lds + (bufoff) + ldsw + _i * 8192), 16, 0, 0); } while (0)
#define PG8_LDA(dst, b, h) do { _Pragma("unroll") for (int m = 0; m < 4; ++m) _Pragma("unroll") for (int k = 0; k < 2; ++k) dst[m][k] = *(const PG8_LAS bf16x8*)(lds + PG8_SA(b, h) + aoff + m * 2048 + k * 1024); } while (0)
#define PG8_LDB(dst, b, h) do { _Pragma("unroll") for (int n = 0; n < 2; ++n) _Pragma("unroll") for (int k = 0; k < 2; ++k) dst[n][k] = *(const PG8_LAS bf16x8*)(lds + PG8_SB(b, h) + boff + n * 2048 + k * 1024); } while (0)
#define PG8_MMA(ai, bj, At, Bt) do { __builtin_amdgcn_s_setprio(1); _Pragma("unroll") for (int m = 0; m < 4; ++m) _Pragma("unroll") for (int n = 0; n < 2; ++n) _Pragma("unroll") for (int k = 0; k < 2; ++k) \
        acc[ai][bj][m][n] = __builtin_amdgcn_mfma_f32_16x16x32_bf16(Bt[n][k], At[m][k], acc[ai][bj][m][n], 0, 0, 0); __builtin_amdgcn_s_setprio(0); } while (0)
#define PG8_WAIT_V(n) asm volatile("s_waitcnt vmcnt(" #n ")" ::: "memory")
#define PG8_WAIT_L(n) asm volatile("s_waitcnt lgkmcnt(" #n ")" ::: "memory")
#define PG8_BAR __builtin_amdgcn_s_barrier()
#define PG8_SCHED __builtin_amdgcn_sched_barrier(0)
    Unit cur, nxt; int ui = 0;
    if (!S.next(0, cur)) return;
    f32x4 acc[2][2][4][2];
#pragma unroll
    for (int a = 0; a < 2; ++a)
#pragma unroll
        for (int b = 0; b < 2; ++b)
#pragma unroll
            for (int m = 0; m < 4; ++m)
#pragma unroll
                for (int n = 0; n < 2; ++n) acc[a][b][m][n] = (f32x4){0.f, 0.f, 0.f, 0.f};
    bf16x8 At[4][2], B0[2][2], B1[2][2];
    const char* cA = (const char*)g.A + (size_t)cur.pm * tstep; const char* cB = (const char*)g.Bt + (size_t)cur.pn * tstep;
    S.a_ready(cur);
    if constexpr (SP2) {
        PG8_STAGE(PG8_SB(0, 0), cB, voffB); PG8_STAGE(PG8_SB(0, 1), cB + hstep, voffB); PG8_STAGE(PG8_SA(0, 0), cA, voffA); PG8_STAGE(PG8_SA(0, 1), cA + hstep, voffA);
        if (wr == 1) PG8_BAR;
        PG8_WAIT_V(2); PG8_BAR;
        PG8_STAGE(PG8_SB(1, 0), cB + kstep, voffB); PG8_STAGE(PG8_SA(1, 0), cA + kstep, voffA); PG8_STAGE(PG8_SB(1, 1), cB + hstep + kstep, voffB);
        PG8_WAIT_V(6); PG8_BAR;
    } else {
        PG8_STAGE(PG8_SB(0, 0), cB, voffB); PG8_STAGE(PG8_SA(0, 0), cA, voffA); PG8_STAGE(PG8_SB(0, 1), cB + hstep, voffB); PG8_STAGE(PG8_SA(0, 1), cA + hstep, voffA);
        if (wr == 1) PG8_BAR;
        PG8_WAIT_V(4); PG8_BAR;
        PG8_STAGE(PG8_SB(1, 0), cB + kstep, voffB); PG8_STAGE(PG8_SA(1, 0), cA + kstep, voffA); PG8_STAGE(PG8_SB(1, 1), cB + hstep + kstep, voffB);
        PG8_WAIT_V(6); PG8_BAR;
    }
    for (;;) {
        const bool has_next = S.next(ui + 1, nxt);
        const char* nA = has_next ? (const char*)g.A + (size_t)nxt.pm * tstep : cA; const char* nB = has_next ? (const char*)g.Bt + (size_t)nxt.pn * tstep : cB;
        for (int t = 0; t < nt; t += 2) {
            const bool last = (t == nt - 2);
            const char* a1 = cA + (size_t)(t + 1) * kstep;
            const char* a2 = last ? nA : cA + (size_t)(t + 2) * kstep; const char* b2 = last ? nB : cB + (size_t)(t + 2) * kstep;
            const char* a3 = a2 + kstep; const char* b3 = b2 + kstep;
            if (last && has_next) S.a_ready(nxt);
            if constexpr (SP2) {
            PG8_LDB(B0, 0, 0); PG8_LDB(B1, 0, 1); PG8_SCHED; PG8_LDA(At, 0, 0); PG8_STAGE(PG8_SA(1, 1), a1 + hstep, voffA);
            PG8_WAIT_V(8); PG8_WAIT_L(0); PG8_BAR; PG8_MMA(0, 0, At, B0); PG8_MMA(0, 1, At, B1); PG8_BAR; PG8_SCHED;
            PG8_LDA(At, 0, 1); PG8_STAGE(PG8_SB(0, 0), b2, voffB); PG8_STAGE(PG8_SB(0, 1), b2 + hstep, voffB); PG8_STAGE(PG8_SA(0, 0), a2, voffA);
            PG8_WAIT_V(8); PG8_WAIT_L(0); PG8_BAR; PG8_MMA(1, 0, At, B0); PG8_MMA(1, 1, At, B1); PG8_BAR; PG8_SCHED;
            PG8_LDB(B0, 1, 0); PG8_LDB(B1, 1, 1); PG8_SCHED; PG8_LDA(At, 1, 0); PG8_STAGE(PG8_SA(0, 1), a2 + hstep, voffA);
            PG8_WAIT_V(8); PG8_WAIT_L(0); PG8_BAR; PG8_MMA(0, 0, At, B0); PG8_MMA(0, 1, At, B1); PG8_BAR; PG8_SCHED;
            PG8_LDA(At, 1, 1); PG8_STAGE(PG8_SB(1, 0), b3, voffB); PG8_STAGE(PG8_SB(1, 1), b3 + hstep, voffB); PG8_STAGE(PG8_SA(1, 0), a3, voffA);
            PG8_WAIT_V(8); PG8_WAIT_L(0); PG8_BAR; PG8_MMA(1, 0, At, B0); PG8_MMA(1, 1, At, B1); PG8_BAR; PG8_SCHED;
            } else {
            PG8_LDB(B0, 0, 0); PG8_SCHED; PG8_LDA(At, 0, 0); PG8_STAGE(PG8_SA(1, 1), a1 + hstep, voffA);
            PG8_WAIT_L(8); PG8_BAR; PG8_WAIT_L(0); PG8_MMA(0, 0, At, B0); PG8_BAR; PG8_SCHED;
            PG8_LDB(B1, 0, 1); PG8_STAGE(PG8_SB(0, 0), b2, voffB);
            PG8_BAR; PG8_WAIT_L(0); PG8_MMA(0, 1, At, B1); PG8_BAR;
            PG8_LDA(At, 0, 1); PG8_STAGE(PG8_SA(0, 0), a2, voffA);
            PG8_BAR; PG8_WAIT_L(0); PG8_MMA(1, 0, At, B0); PG8_BAR; PG8_SCHED;
            PG8_STAGE(PG8_SB(0, 1), b2 + hstep, voffB);
            PG8_WAIT_V(6); PG8_BAR; PG8_MMA(1, 1, At, B1); PG8_BAR;
            PG8_LDB(B0, 1, 0); PG8_SCHED; PG8_LDA(At, 1, 0); PG8_STAGE(PG8_SA(0, 1), a2 + hstep, voffA);
            PG8_WAIT_L(8); PG8_BAR; PG8_WAIT_L(0); PG8_MMA(0, 0, At, B0); PG8_BAR; PG8_SCHED;
            PG8_LDB(B1, 1, 1); PG8_STAGE(PG8_SB(1, 0), b3, voffB);
            PG8_BAR; PG8_WAIT_L(0); PG8_MMA(0, 1, At, B1); PG8_BAR;
            PG8_LDA(At, 1, 1); PG8_STAGE(PG8_SA(1, 0), a3, voffA);
            PG8_BAR; PG8_WAIT_L(0); PG8_MMA(1, 0, At, B0); PG8_BAR; PG8_SCHED;
            PG8_STAGE(PG8_SB(1, 1), b3 + hstep, voffB);
            PG8_WAIT_V(6); PG8_BAR; PG8_MMA(1, 1, At, B1); PG8_BAR;
            }
        }
        if constexpr (ALIGN_EPI) { if (wr == 0) PG8_BAR; }
        if constexpr (!Epi::AFTER_DRAIN) { E(acc, cur, wr, wc, fr, fq); S.done(cur); }
        if (!has_next) break;
#pragma unroll
        for (int a = 0; a < 2; ++a)
#pragma unroll
            for (int b = 0; b < 2; ++b)
#pragma unroll
                for (int m = 0; m < 4; ++m)
#pragma unroll
                    for (int n = 0; n < 2; ++n) acc[a][b][m][n] = (f32x4){0.f, 0.f, 0.f, 0.f};
        cur = nxt; cA = nA; cB = nB; ++ui;
        if constexpr (ALIGN_EPI) { if (wr == 1) PG8_BAR; }
    }
    PG8_WAIT_V(0);
    if constexpr (!ALIGN_EPI) { if (wr == 0) PG8_BAR; }
    PG8_BAR;
    if constexpr (Epi::AFTER_DRAIN) { E.fused(acc, cur, wr, wc, fr, fq, lds, wid, lane); S.done(cur); }
#undef PG8_SA
#undef PG8_SB
#undef PG8_STAGE
#undef PG8_LDA
#undef PG8_LDB
#undef PG8_MMA
#undef PG8_WAIT_V
#undef PG8_WAIT_L
#undef PG8_BAR
#undef PG8_SCHED
}
}
#define LAS __attribute__((address_space(3)))
typedef unsigned short bf16;
typedef unsigned v4u __attribute__((ext_vector_type(4)));
typedef unsigned v2u __attribute__((ext_vector_type(2)));
typedef float f32x4 __attribute__((ext_vector_type(4)));
typedef short bf16x8 __attribute__((ext_vector_type(8)));
constexpr int DM = 1024, SEQ = 2048, MP = 16384, NS = 128, MV = MP + NS, MPAD = 16640;
constexpr int DQKV = 3072, INCOLS = 10256, NIN = 10240;
constexpr float EPS = 1e-6f;
constexpr size_t KiB = 1024, MiB = 1u << 20;
constexpr size_t WS_CTL = 0, CTL_BYTES = 64 * KiB;
constexpr size_t WS_MOD = 64 * KiB;
constexpr size_t WS_BA = 2 * MiB;
constexpr size_t WS_GL = 3 * MiB + 256 * KiB;
constexpr size_t WS_WA = 3 * MiB + 512 * KiB, WS_WB = WS_WA + 2 * MiB, WS_WO = WS_WB + 2 * MiB, WS_WIN = WS_WO + 2 * MiB;
constexpr size_t WS_BUF = WS_WIN + 20 * MiB;
constexpr size_t BUF_BYTES = (size_t)MV * 1024 * 2;
constexpr size_t WS_END = WS_BUF + 7 * BUF_BYTES + 512 * KiB;
static_assert(WS_END <= 256 * MiB, "ws map");
constexpr size_t O_YP = 0, O_YS = 16777216, O_NCAP = O_YS + 131072, O_NCQP = O_NCAP + 16384, O_NDP = O_NCQP + 73728,
                 O_NCAS = O_NDP + 1048576, O_NCQS = O_NCAS + 262144, O_NDS = O_NCQS + 1179648, O_END = O_NDS + 16777216;
constexpr int CW_BAR = 4096;
constexpr int LDS_BYTES = 163840, MISC_OFF = LDS_BYTES - 64;

typedef float f32x2v __attribute__((ext_vector_type(2)));
typedef __bf16 bf16x2v __attribute__((ext_vector_type(2)));
__device__ __forceinline__ unsigned pkbf(float lo, float hi) { return pg8::cvt_pk_bf16(lo, hi); }
__device__ __forceinline__ unsigned pk2(float lo, float hi) { const f32x2v v = {lo, hi}; return __builtin_bit_cast(unsigned, __builtin_convertvector(v, bf16x2v)); }
__device__ __forceinline__ float bflo(unsigned u) { return __uint_as_float(u << 16); }
__device__ __forceinline__ float bfhi(unsigned u) { return __uint_as_float(u & 0xffff0000u); }
__device__ __forceinline__ float bf1(unsigned short b) { return __uint_as_float((unsigned)b << 16); }
__device__ __forceinline__ unsigned short f2bf1(float f) { return (unsigned short)(pkbf(f, 0.f) & 0xffffu); }
__device__ __forceinline__ float sigm(float x) { return __builtin_amdgcn_rcpf(1.f + __expf(-x)); }
__device__ __forceinline__ float silu(float x) { return x * sigm(x); }
__device__ __forceinline__ f32x4 silu4(f32x4 v) { return (f32x4){silu(v[0]), silu(v[1]), silu(v[2]), silu(v[3])}; }
__device__ __forceinline__ f32x4 sigm4(f32x4 v) { return (f32x4){sigm(v[0]), sigm(v[1]), sigm(v[2]), sigm(v[3])}; }
__device__ __forceinline__ void unpack8(v4u u, float* f) { f[0] = bflo(u.x); f[1] = bfhi(u.x); f[2] = bflo(u.y); f[3] = bfhi(u.y); f[4] = bflo(u.z); f[5] = bfhi(u.z); f[6] = bflo(u.w); f[7] = bfhi(u.w); }
__device__ __forceinline__ v4u pack8(const float* f) { v4u o; o.x = pkbf(f[0], f[1]); o.y = pkbf(f[2], f[3]); o.z = pkbf(f[4], f[5]); o.w = pkbf(f[6], f[7]); return o; }
__device__ __forceinline__ v2u pack4(f32x4 v) { v2u o; o.x = pkbf(v[0], v[1]); o.y = pkbf(v[2], v[3]); return o; }
__device__ __forceinline__ float dpp_row_shr(float v, int n) {
    const int iv = __builtin_bit_cast(int, v); int r;
    switch (n) { case 1: r = __builtin_amdgcn_update_dpp(0, iv, 0x111, 0xf, 0xf, true); break; case 2: r = __builtin_amdgcn_update_dpp(0, iv, 0x112, 0xf, 0xf, true); break;
                 case 4: r = __builtin_amdgcn_update_dpp(0, iv, 0x114, 0xf, 0xf, true); break; default: r = __builtin_amdgcn_update_dpp(0, iv, 0x118, 0xf, 0xf, true); break; }
    return __builtin_bit_cast(float, r);
}
__device__ __forceinline__ float wave_sum(float v) {
    v += dpp_row_shr(v, 1); v += dpp_row_shr(v, 2); v += dpp_row_shr(v, 4); v += dpp_row_shr(v, 8);
    v += __builtin_bit_cast(float, __builtin_amdgcn_update_dpp(0, __builtin_bit_cast(int, v), 0x142, 0xa, 0xf, false));
    v += __builtin_bit_cast(float, __builtin_amdgcn_update_dpp(0, __builtin_bit_cast(int, v), 0x143, 0xc, 0xf, false));
    return __uint_as_float(__builtin_amdgcn_readlane(__float_as_uint(v), 63));
}
__device__ __forceinline__ float row16_sum(float v) {
    v += __builtin_bit_cast(float, __builtin_amdgcn_update_dpp(0, __builtin_bit_cast(int, v), 0xB1, 0xf, 0xf, false));
    v += __builtin_bit_cast(float, __builtin_amdgcn_update_dpp(0, __builtin_bit_cast(int, v), 0x4E, 0xf, 0xf, false));
    v += __builtin_bit_cast(float, __builtin_amdgcn_update_dpp(0, __builtin_bit_cast(int, v), 0x141, 0xf, 0xf, false));
    v += __builtin_bit_cast(float, __builtin_amdgcn_update_dpp(0, __builtin_bit_cast(int, v), 0x140, 0xf, 0xf, false));
    return v;
}
#define LDS_WAIT() asm volatile("s_waitcnt lgkmcnt(0)" ::: "memory")

struct EpiIn {
    static constexpr bool PERM = true, AFTER_DRAIN = false;
    bf16 *U, *GA, *QKV, *ZB, *SGA, *SGB, *UH;
    __device__ __forceinline__ void operator()(const f32x4 (&acc)[2][2][4][2], const pg8::Unit& u, int wr, int wc, int fr, int fq) const {
        const int row0 = u.pm * 256 + wr * 64 + fr, cl = wc * 32 + 8 * fq, pn = u.pn;
        if (pn < 16) {
            bf16* base = (pn < 8 ? U : GA) + 128 * (pn & 7) + cl;
#pragma unroll
            for (int ai = 0; ai < 2; ++ai)
#pragma unroll
                for (int m = 0; m < 4; ++m) {
                    const int row = row0 + ai * 128 + m * 16;
                    if (row < MV) {
                        f32x4 a0 = acc[ai][0][m][0], a1 = acc[ai][0][m][1], b0 = acc[ai][1][m][0], b1 = acc[ai][1][m][1];
                        if (pn >= 8) { b0 = silu4(b0); b1 = silu4(b1); }
                        a0 = a0 * b0; a1 = a1 * b1;
                        v4u w; w.x = pkbf(a0[0], a0[1]); w.y = pkbf(a0[2], a0[3]); w.z = pkbf(a1[0], a1[1]); w.w = pkbf(a1[2], a1[3]);
                        *(v4u*)(base + (size_t)row * 1024) = w;
                        if (pn < 8 && (row & 7) >= 6 && row < MP) *(v4u*)(UH + ((size_t)(row >> 3) * 2 + ((row & 7) - 6)) * 1024 + 128 * (pn & 7) + cl) = w;
                    }
                }
        } else {
            bf16* base; int ldc, act;
            if (pn < 28) { base = QKV + 256 * (pn - 16); ldc = 3072; act = 0; }
            else if (pn < 32) { base = ZB + 256 * (pn - 28); ldc = 1024; act = 1; }
            else if (pn < 36) { base = SGA + 256 * (pn - 32); ldc = 1024; act = 2; }
            else { base = SGB + 256 * (pn - 36); ldc = 1024; act = 2; }
            base += cl;
#pragma unroll
            for (int ai = 0; ai < 2; ++ai)
#pragma unroll
                for (int m = 0; m < 4; ++m) {
                    const int row = row0 + ai * 128 + m * 16;
                    if (row < MV) {
#pragma unroll
                        for (int bj = 0; bj < 2; ++bj) {
                            f32x4 v0 = acc[ai][bj][m][0], v1 = acc[ai][bj][m][1];
                            if (act == 1) { v0 = silu4(v0); v1 = silu4(v1); } else if (act == 2) { v0 = sigm4(v0); v1 = sigm4(v1); }
                            v4u w; w.x = pkbf(v0[0], v0[1]); w.y = pkbf(v0[2], v0[3]); w.z = pkbf(v1[0], v1[1]); w.w = pkbf(v1[2], v1[3]);
                            *(v4u*)(base + (size_t)row * ldc + bj * 128) = w;
                        }
                    }
                }
        }
    }
};
template <class F> struct EpiEl {
    static constexpr bool PERM = true, AFTER_DRAIN = false;
    F f;
    __device__ __forceinline__ void operator()(const f32x4 (&acc)[2][2][4][2], const pg8::Unit& u, int wr, int wc, int fr, int fq) const {
        const int row0 = u.pm * 256 + wr * 64 + fr, col0 = u.pn * 256 + wc * 32 + 8 * fq;
#pragma unroll
        for (int ai = 0; ai < 2; ++ai) {
            typename F::Ops ops[4][2];
#pragma unroll
            for (int m = 0; m < 4; ++m)
#pragma unroll
                for (int bj = 0; bj < 2; ++bj) ops[m][bj] = f.load8(row0 + ai * 128 + m * 16, col0 + bj * 128);
#pragma unroll
            for (int m = 0; m < 4; ++m)
#pragma unroll
                for (int bj = 0; bj < 2; ++bj) f.store8(row0 + ai * 128 + m * 16, col0 + bj * 128, acc[ai][bj][m][0], acc[ai][bj][m][1], ops[m][bj]);
        }
    }
};
struct FOutA { const bf16* SG; bf16* TMP;
    struct Ops { v4u sg; };
    __device__ __forceinline__ Ops load8(int row, int col) const { Ops o; o.sg = *(const v4u*)(SG + (size_t)row * 1024 + col); return o; }
    __device__ __forceinline__ void store8(int row, int col, f32x4 v0, f32x4 v1, const Ops& p) const { float sg[8]; unpack8(p.sg, sg);
        const float r[8] = {sg[0] * v0[0], sg[1] * v0[1], sg[2] * v0[2], sg[3] * v0[3], sg[4] * v1[0], sg[5] * v1[1], sg[6] * v1[2], sg[7] * v1[3]}; *(v4u*)(TMP + (size_t)row * 1024 + col) = pack8(r); }
    __device__ __forceinline__ void operator()(int row, int col, f32x4 v) const { const size_t o = (size_t)row * 1024 + col; const v2u s = *(const v2u*)(SG + o);
        f32x4 r = {bflo(s.x) * v[0], bfhi(s.x) * v[1], bflo(s.y) * v[2], bfhi(s.y) * v[3]}; *(v2u*)(TMP + o) = pack4(r); } };
struct FOutB { const bf16* SG; const bf16* TIN; bf16* TMP;
    struct Ops { v4u sg, t; };
    __device__ __forceinline__ Ops load8(int row, int col) const { Ops o; o.sg = *(const v4u*)(SG + (size_t)row * 1024 + col); o.t = *(const v4u*)(TIN + (size_t)row * 1024 + col); return o; }
    __device__ __forceinline__ void store8(int row, int col, f32x4 v0, f32x4 v1, const Ops& p) const { float sg[8], t[8]; unpack8(p.sg, sg); unpack8(p.t, t);
        const float r[8] = {t[0] + sg[0] * v0[0], t[1] + sg[1] * v0[1], t[2] + sg[2] * v0[2], t[3] + sg[3] * v0[3], t[4] + sg[4] * v1[0], t[5] + sg[5] * v1[1], t[6] + sg[6] * v1[2], t[7] + sg[7] * v1[3]}; *(v4u*)(TMP + (size_t)row * 1024 + col) = pack8(r); }
    __device__ __forceinline__ void operator()(int row, int col, f32x4 v) const { const size_t o = (size_t)row * 1024 + col; const v2u s = *(const v2u*)(SG + o); const v2u t = *(const v2u*)(TIN + o);
        f32x4 r = {bflo(t.x) + bflo(s.x) * v[0], bfhi(t.x) + bfhi(s.x) * v[1], bflo(t.y) + bflo(s.y) * v[2], bfhi(t.y) + bfhi(s.y) * v[3]}; *(v2u*)(TMP + o) = pack4(r); } };
struct FPlain { bf16* T;
    struct Ops { int dummy; };
    __device__ __forceinline__ Ops load8(int, int) const { return Ops{0}; }
    __device__ __forceinline__ void store8(int row, int col, f32x4 v0, f32x4 v1, const Ops&) const { const float r[8] = {v0[0], v0[1], v0[2], v0[3], v1[0], v1[1], v1[2], v1[3]}; *(v4u*)(T + (size_t)row * 1024 + col) = pack8(r); }
    __device__ __forceinline__ void operator()(int row, int col, f32x4 v) const { *(v2u*)(T + (size_t)row * 1024 + col) = pack4(v); } };


template <class F> __device__ __forceinline__ void small_gemm_wg(LAS unsigned char* L, const bf16* A, const bf16* Bt, int rowbase, const F& f, int wg, int nwg, int tid) {
    const int lane = tid & 63, w = tid >> 6;
    LAS f32x4* part = (LAS f32x4*)L;
    for (int tile = wg; tile < 512; tile += nwg) {
        const int rt = tile & 7, ct = tile >> 3;
        const bf16* ap = A + (size_t)(rowbase + rt * 16 + (lane & 15)) * 1024 + 8 * (lane >> 4) + 128 * w;
        const bf16* bp = Bt + (size_t)(ct * 16 + (lane & 15)) * 1024 + 8 * (lane >> 4) + 128 * w;
        bf16x8 a[4], b[4];
#pragma unroll
        for (int s = 0; s < 4; ++s) { a[s] = *(const bf16x8*)(ap + 32 * s); b[s] = *(const bf16x8*)(bp + 32 * s); }
        f32x4 acc = {0.f, 0.f, 0.f, 0.f};
#pragma unroll
        for (int s = 0; s < 4; ++s) acc = __builtin_amdgcn_mfma_f32_16x16x32_bf16(b[s], a[s], acc, 0, 0, 0);
        part[w * 64 + lane] = acc;
        __syncthreads();
        if (w == 0) { f32x4 t = part[lane];
#pragma unroll
            for (int ww = 1; ww < 8; ++ww) t += part[ww * 64 + lane];
            f(rowbase + rt * 16 + (lane & 15), ct * 16 + 4 * (lane >> 4), t); }
        __syncthreads();
    }
}
template <class F> __device__ __forceinline__ void small_gemm(const bf16* A, const bf16* Bt, int rowbase, const F& f, int gw, int NGW, int lane) {
    for (int task = gw; task < 512; task += NGW) {
        const int rt = task & 7, ct = task >> 3;
        const bf16* ap = A + (size_t)(rowbase + rt * 16 + (lane & 15)) * 1024 + 8 * (lane >> 4);
        const bf16* bp = Bt + (size_t)(ct * 16 + (lane & 15)) * 1024 + 8 * (lane >> 4);
        f32x4 acc = {0.f, 0.f, 0.f, 0.f};
#pragma unroll 8
        for (int s = 0; s < 32; ++s) { const bf16x8 a = *(const bf16x8*)(ap + 32 * s), b = *(const bf16x8*)(bp + 32 * s); acc = __builtin_amdgcn_mfma_f32_16x16x32_bf16(b, a, acc, 0, 0, 0); }
        f(rowbase + rt * 16 + (lane & 15), ct * 16 + 4 * (lane >> 4), acc);
    }
}
#define XB_TMO      128
#define XB_XCNT(j)  (256  + 64 * (j))
#define XB_XSUB(j)  (1280 + 64 * (j))
#define XB_XGEN(j)  (2304 + 64 * (j))
#define XB_TOP      3328
#define XB_TOPGEN   3392
#define XCD_BAR_WORDS 3456
#define XB_SPIN_CAP (1u << 18)

__device__ __forceinline__ unsigned xb_ld(unsigned* p)              { return __hip_atomic_load(p, __ATOMIC_RELAXED, __HIP_MEMORY_SCOPE_AGENT); }
__device__ __forceinline__ unsigned xb_add(unsigned* p, unsigned v) { return __hip_atomic_fetch_add(p, v, __ATOMIC_RELAXED, __HIP_MEMORY_SCOPE_AGENT); }
__device__ __forceinline__ unsigned xb_xcc_id() { return (unsigned)__builtin_amdgcn_s_getreg((3 << 11) | 20) & 0xFu; }
#define XB_SPIN(cond, bar) do { unsigned _sp = 0; while (cond) { __builtin_amdgcn_s_sleep(1); \
    if ((++_sp & 255u) == 0u) { if (xb_ld(&(bar)[XB_TMO])) break; if (_sp > XB_SPIN_CAP) { atomicAdd(&(bar)[XB_TMO], 1u); break; } } } } while (0)

struct XcdBarrier {
    unsigned* bar; unsigned x;
    volatile LAS unsigned* st;
};

__device__ __forceinline__ XcdBarrier xcd_barrier_post(unsigned* bar, volatile LAS unsigned* st) {
    XcdBarrier b; b.bar = bar; b.x = xb_xcc_id(); b.st = st;
    if (threadIdx.x == 0) (void)xb_add(&bar[XB_XCNT(b.x)], 1u);
    return b;
}
__device__ __forceinline__ void xcd_barrier_complete(unsigned* bar, unsigned x, unsigned& nloc, unsigned& nx) {
    const unsigned G = gridDim.x * gridDim.y * gridDim.z;
    unsigned sum, cnt, mine, sp = 0u;
    for (;;) {
        sum = 0u; cnt = 0u; mine = 0u;
#pragma unroll
        for (unsigned j = 0; j < 16; ++j) { const unsigned c = xb_ld(&bar[XB_XCNT(j)]); sum += c; cnt += (c > 0u) ? 1u : 0u; mine = (j == x) ? c : mine; }
        if (sum == G) break;
        __builtin_amdgcn_s_sleep(1);
        if ((++sp & 255u) == 0u) { if (xb_ld(&bar[XB_TMO])) break; if (sp > XB_SPIN_CAP) { atomicAdd(&bar[XB_TMO], 1u); break; } }
    }
    nloc = mine > 0u ? mine : 1u; nx = cnt > 0u ? cnt : 1u;
}

__device__ __forceinline__ void xcd_barrier(const XcdBarrier& b) {
    asm volatile("s_waitcnt vmcnt(0)" ::: "memory");
    __syncthreads();
    if (threadIdx.x == 0) {
        unsigned* bar = b.bar;
        __builtin_amdgcn_s_waitcnt(0);
        unsigned nloc = b.st[0], nx = b.st[1];
        if (nloc == 0u) { xcd_barrier_complete(bar, b.x, nloc, nx); b.st[0] = nloc; b.st[1] = nx; }
        const unsigned old = xb_add(&bar[XB_XSUB(b.x)], 1u);
        const unsigned gen = old / nloc;
        if (old + 1u == (gen + 1u) * nloc) {
            __builtin_amdgcn_fence(__ATOMIC_RELEASE, "agent");
            asm volatile("s_waitcnt vmcnt(0)" ::: "memory");
            const unsigned og = xb_add(&bar[XB_TOP], 1u);
            const unsigned tg = og / nx;
            if (og + 1u == (tg + 1u) * nx) xb_add(&bar[XB_TOPGEN], 1u);
            else XB_SPIN(xb_ld(&bar[XB_TOPGEN]) == tg, bar);
            __builtin_amdgcn_fence(__ATOMIC_ACQUIRE, "agent");
            xb_add(&bar[XB_XGEN(b.x)], 1u);
            asm volatile("s_waitcnt vmcnt(0)" ::: "memory");
        } else {
            XB_SPIN(xb_ld(&bar[XB_XGEN(b.x)]) == gen, bar);
            __builtin_amdgcn_fence(__ATOMIC_ACQUIRE, "agent");
            asm volatile("s_waitcnt vmcnt(0)" ::: "memory");
        }
    }
    __syncthreads();
}
__device__ __forceinline__ void p0_transpose_item(const float* W, int ldw, int srccol0, int k0, bf16* WT, int K, int dstrow0, LAS float* scr, int lane) {
    float tv[32];
#pragma unroll
    for (int i = 0; i < 32; ++i) tv[i] = __builtin_nontemporal_load(W + (size_t)(k0 + 2 * i + (lane >> 5)) * ldw + srccol0 + (lane & 31));
#pragma unroll
    for (int i = 0; i < 32; ++i) scr[(2 * i + (lane >> 5)) * 33 + (lane & 31)] = tv[i];
    LDS_WAIT();
    const int c = lane & 7;
#pragma unroll
    for (int j = 0; j < 4; ++j) { const int n = (lane >> 3) + 8 * j; const LAS float* s = scr + (8 * c) * 33 + n;
        v4u o; o.x = pkbf(s[0 * 33], s[1 * 33]); o.y = pkbf(s[2 * 33], s[3 * 33]); o.z = pkbf(s[4 * 33], s[5 * 33]); o.w = pkbf(s[6 * 33], s[7 * 33]);
        *(v4u*)(WT + (size_t)(dstrow0 + n) * K + k0 + 8 * c) = o; }
    LDS_WAIT();
}
__device__ __forceinline__ int win_src_col(int n0) {
    if (n0 < 4096) { const int t = n0 >> 8, half = (n0 >> 7) & 1, ch = 128 * (t & 7) + (n0 & 127); const int blk = (t < 8) ? half : 2 + half; return blk * 1024 + ch; }
    if (n0 < 8192) return n0;
    return n0 + 16;
}
__device__ __forceinline__ void p0_mod_task(const float* cp, const float* cs, const float* ada_w, const float* ada_b, float* MOD, LAS float* sc, int task, int lane) {
    const int cgi = task % 48, rgi = task / 48, col = cgi * 64 + lane, r0 = rgi * 17;
    float acc[17];
#pragma unroll
    for (int r = 0; r < 17; ++r) acc[r] = 0.f;
    for (int k0 = 0; k0 < 1024; k0 += 128) {
        for (int i = 0; i < 34; ++i) { const int idx = i * 64 + lane, r = idx >> 7, kk = idx & 127, rr = r0 + r;
            const float* crow = rr < 8 ? cp + rr * 1024 : cs + (rr - 8) * 1024; const float v = crow[k0 + kk]; sc[idx] = silu(v); }
        LDS_WAIT();
        for (int kk = 0; kk < 128; kk += 4) {
            const float* wp = ada_w + (size_t)(k0 + kk) * 3072 + col;
            const float w0 = wp[0], w1 = wp[3072], w2 = wp[2 * 3072], w3 = wp[3 * 3072];
#pragma unroll
            for (int r = 0; r < 17; ++r) { const f32x4 c4 = *(const LAS f32x4*)(sc + r * 128 + kk); acc[r] += (c4[0] * w0 + c4[1] * w1) + (c4[2] * w2 + c4[3] * w3); }
        }
        LDS_WAIT();
    }
    const float bb = ada_b[col];
#pragma unroll
    for (int r = 0; r < 17; ++r) MOD[(size_t)(r0 + r) * 3072 + col] = acc[r] + bb;
}

__device__ __forceinline__ void phase_mod(const float* const* in, unsigned char* ws, int gwave, int nwaves, int lane) {
    const float* cp = in[2]; const float* cs = in[3]; const float* ada_w = in[7]; const float* ada_b = in[8]; float* MOD = (float*)(ws + WS_MOD);
    const int g = lane >> 4, col = lane & 15;
    for (int task = gwave; task < 576; task += nwaves) {
        const int nt = task % 192, mg = task / 192;
        f32x4 acc[3]; const float* arow[3]; bool av[3];
#pragma unroll
        for (int t = 0; t < 3; ++t) { acc[t] = (f32x4){0.f, 0.f, 0.f, 0.f}; const int row = 48 * mg + 16 * t + col; av[t] = row < 136; const int rr = av[t] ? row : 0; arow[t] = rr < 8 ? cp + rr * 1024 : cs + (rr - 8) * 1024; }
#pragma unroll 2
        for (int s = 0; s < 32; ++s) {
            const int k = 32 * s + 8 * g; float wv[8];
#pragma unroll
            for (int j = 0; j < 8; ++j) wv[j] = ada_w[(size_t)(k + j) * 3072 + 16 * nt + col];
            v4u bt; bt.x = pk2(wv[0], wv[1]); bt.y = pk2(wv[2], wv[3]); bt.z = pk2(wv[4], wv[5]); bt.w = pk2(wv[6], wv[7]);
            const bf16x8 bfrag = __builtin_bit_cast(bf16x8, bt);
#pragma unroll
            for (int t = 0; t < 3; ++t) { f32x4 a0 = *(const f32x4*)(arow[t] + k), a1 = *(const f32x4*)(arow[t] + k + 4);
                a0 = silu4(a0); a1 = silu4(a1); if (!av[t]) { a0 = (f32x4){0.f, 0.f, 0.f, 0.f}; a1 = a0; }
                v4u at; at.x = pk2(a0[0], a0[1]); at.y = pk2(a0[2], a0[3]); at.z = pk2(a1[0], a1[1]); at.w = pk2(a1[2], a1[3]);
                acc[t] = __builtin_amdgcn_mfma_f32_16x16x32_bf16(__builtin_bit_cast(bf16x8, at), bfrag, acc[t], 0, 0, 0); }
        }
        const float bb = ada_b[16 * nt + col];
#pragma unroll
        for (int t = 0; t < 3; ++t)
#pragma unroll
            for (int r = 0; r < 4; ++r) { const int row = 48 * mg + 16 * t + 4 * g + r; if (row < 136) MOD[(size_t)row * 3072 + 16 * nt + col] = acc[t][r] + bb; }
    }
}
__device__ __forceinline__ void phase0(LAS unsigned char* L, const float* const* in, unsigned char* ws, int vcu, int G, int tid) {
    const int lane = tid & 63, wave = __builtin_amdgcn_readfirstlane(tid >> 6);
    LAS float* scr = (LAS float*)(L + wave * 16384);
    const int ntask_w2 = 576 - 2 * G;
    if (wave < 2 || (wave == 2 && vcu < ntask_w2)) return;
    const int gw = (wave >= 3) ? (wave - 3) * G + vcu : 5 * G + (vcu - ntask_w2), NGW = 5 * G + (G - ntask_w2);
    constexpr int I_IN = 16 * 320, I_SQ = 16 * 32;
    for (int it = gw; it < I_IN + 3 * I_SQ; it += NGW) {
        int r = it;
        if (r < I_IN) { const int kb = r / 320, nb = r % 320; p0_transpose_item(in[10], INCOLS, win_src_col(nb * 32), kb * 64, (bf16*)(ws + WS_WIN), 1024, nb * 32, scr, lane); continue; }
        r -= I_IN; const int which = r / I_SQ; r -= which * I_SQ; const int kb = r / 32, nb = r % 32;
        const float* W = which == 0 ? in[16] : (which == 1 ? in[17] : in[18]);
        bf16* WT = (bf16*)(ws + (which == 0 ? WS_WA : (which == 1 ? WS_WB : WS_WO)));
        p0_transpose_item(W, 1024, nb * 32, kb * 64, WT, 1024, nb * 32, scr, lane);
    }
}
__device__ __forceinline__ void phase1(LAS unsigned char* L, const float* const* in, unsigned char* ws, int vcu, int G, int tid) {
    const int lane = tid & 63, wave = tid >> 6;
    LAS float* wba = (LAS float*)L;
    const float* w_in = in[10];
    {
        f32x4 wv[8];
#pragma unroll
        for (int i = 0; i < 8; ++i) { const int idx = tid + 512 * i, k = idx >> 2, q = idx & 3; wv[i] = *(const f32x4*)(w_in + (size_t)k * INCOLS + 8192 + 4 * q); }
#pragma unroll
        for (int i = 0; i < 8; ++i) { const int idx = tid + 512 * i, k = idx >> 2, q = idx & 3;
#pragma unroll
            for (int e = 0; e < 4; ++e) wba[(4 * q + e) * 1024 + k] = wv[i][e]; }
    }
    __syncthreads();
    const float* MOD = (const float*)(ws + WS_MOD); float* BA = (float*)(ws + WS_BA); bf16* H = (bf16*)(ws + WS_BUF);
    const float* npre = in[9];
    float alog = 0.f, dtb = 0.f; if (lane >= 8 && lane < 16) { alog = in[13][lane - 8]; dtb = in[14][lane - 8]; }
    const int gw = vcu * 8 + wave, NGW = G * 8;
    f32x4 np[4];
#pragma unroll
    for (int j = 0; j < 4; ++j) np[j] = *(const f32x4*)(npre + 4 * lane + 256 * j);
    const int nblk = MP / 8;
    for (int blk = gw; blk < nblk + NS; blk += NGW) {
        const bool samp = blk >= nblk;
        const int m0 = samp ? MP + (blk - nblk) : blk * 8, nrow = samp ? 1 : 8;
        const int mr = samp ? 8 + (blk - nblk) : (m0 >> 11);
        const float* xr = samp ? in[1] + (size_t)(blk - nblk) * 1024 : in[0] + (size_t)m0 * 1024;
        f32x4 sh[4], sc[4], nx[4];
#pragma unroll
        for (int j = 0; j < 4; ++j) { const int k = 4 * lane + 256 * j; nx[j] = __builtin_nontemporal_load((const f32x4*)(xr + k)); sh[j] = *(const f32x4*)(MOD + (size_t)mr * 3072 + k); sc[j] = (*(const f32x4*)(MOD + (size_t)mr * 3072 + 1024 + k) + 1.f) * np[j]; }
        for (int r = 0; r < nrow; ++r) {
            const int m = m0 + r;
            f32x4 v[4]; float ss = 0.f;
#pragma unroll
            for (int j = 0; j < 4; ++j) { v[j] = nx[j]; ss += (v[j][0] * v[j][0] + v[j][1] * v[j][1]) + (v[j][2] * v[j][2] + v[j][3] * v[j][3]); }
            { const int rn = (r + 1 < nrow) ? r + 1 : r;
#pragma unroll
                for (int j = 0; j < 4; ++j) nx[j] = __builtin_nontemporal_load((const f32x4*)(xr + (size_t)rn * 1024 + 4 * lane + 256 * j)); }
            const float rstd = rsqrtf(wave_sum(ss) * (1.f / 1024.f) + EPS);
#pragma unroll
            for (int j = 0; j < 4; ++j) { const int k = 4 * lane + 256 * j; v[j] = v[j] * rstd * sc[j] + sh[j]; *(v2u*)(H + (size_t)m * 1024 + k) = pack4(v[j]); }
            float mine = 0.f;
#pragma unroll
            for (int c = 0; c < 16; ++c) { float p = 0.f;
#pragma unroll
                for (int j = 0; j < 4; ++j) { const f32x4 w4 = *(const LAS f32x4*)(wba + c * 1024 + 4 * lane + 256 * j); p += (v[j][0] * w4[0] + v[j][1] * w4[1]) + (v[j][2] * w4[2] + v[j][3] * w4[3]); }
                p = wave_sum(p); if (lane == c) mine = p; }
            if (lane < 8) BA[(size_t)m * 16 + lane] = sigm(mine);
            else if (lane < 16) { const float xx = mine + dtb; const float sp = fmaxf(xx, 0.f) + log1pf(__expf(-fabsf(xx))); BA[(size_t)m * 16 + lane] = -__expf(alog) * sp; }
        }
    }
}
__device__ __forceinline__ void branch_a_rest(const bf16* U, bf16* GA, const bf16* UH, const float* caw, int bx, int tid) {
    const bool dry = false; (void)dry;
    {
        const int cgp = tid & 127, col = cgp * 8, q = tid >> 7;
        float w0[8], w1[8], w2[8];
#pragma unroll
        for (int e = 0; e < 8; ++e) { w0[e] = caw[col + e]; w1[e] = caw[1024 + col + e]; w2[e] = caw[2048 + col + e]; }
        for (int kk = 0; kk < 4; ++kk) {
            const int kq = 1 + q + 2 * kk; if (kq > 7) break;
            const int i = bx + 256 * kq;
            const int r0 = i * 8; const bool zh = (r0 & 2047) == 0;
            float um2[8], um1[8];
            if (zh) {
#pragma unroll
                for (int e = 0; e < 8; ++e) { um2[e] = 0.f; um1[e] = 0.f; }
            } else { unpack8(*(const v4u*)(UH + ((size_t)(i - 1) * 2) * 1024 + col), um2); unpack8(*(const v4u*)(UH + ((size_t)(i - 1) * 2 + 1) * 1024 + col), um1); }
            v4u ur[8], gr[8];
#pragma unroll
            for (int r = 0; r < 8; ++r) { ur[r] = *(const v4u*)(U + (size_t)(r0 + r) * 1024 + col); gr[r] = *(const v4u*)(GA + (size_t)(r0 + r) * 1024 + col); }
#pragma unroll
            for (int r = 0; r < 8; ++r) { float uc[8], ga[8], o[8]; unpack8(ur[r], uc); unpack8(gr[r], ga);
#pragma unroll
                for (int e = 0; e < 8; ++e) { o[e] = ga[e] * (um2[e] * w0[e] + um1[e] * w1[e] + uc[e] * w2[e]); um2[e] = um1[e]; um1[e] = uc[e]; }
                *(v4u*)(GA + (size_t)(r0 + r) * 1024 + col) = pack8(o); }
        }
    }
}
__device__ __forceinline__ void phase3(const float* const* in, unsigned char* ws, float* out, int vcu, int G, int bx, int tid, bool dry = false) {
    const bf16* UH = (const bf16*)(out + O_NDS);
    const bf16* U = (const bf16*)(ws + WS_BUF + 1 * BUF_BYTES); bf16* GA = (bf16*)(ws + WS_BUF + 2 * BUF_BYTES); const bf16* QKV = (const bf16*)(ws + WS_BUF + 3 * BUF_BYTES);
    const float* caw = in[11];
    {
        const int cgp = tid & 127, col = cgp * 8, q = tid >> 7;
        float w0[8], w1[8], w2[8];
#pragma unroll
        for (int e = 0; e < 8; ++e) { w0[e] = caw[col + e]; w1[e] = caw[1024 + col + e]; w2[e] = caw[2048 + col + e]; }
        for (int kk = 0; kk < 1; ++kk) {
            const int i = bx; if (q != 0) break;
            const int r0 = i * 8; const bool zh = (r0 & 2047) == 0;
            float um2[8], um1[8];
            if (zh) {
#pragma unroll
                for (int e = 0; e < 8; ++e) { um2[e] = 0.f; um1[e] = 0.f; }
            } else { unpack8(*(const v4u*)(UH + ((size_t)(i - 1) * 2) * 1024 + col), um2); unpack8(*(const v4u*)(UH + ((size_t)(i - 1) * 2 + 1) * 1024 + col), um1); }
            v4u ur[8], gr[8];
#pragma unroll
            for (int r = 0; r < 8; ++r) { ur[r] = *(const v4u*)(U + (size_t)(r0 + r) * 1024 + col); gr[r] = *(const v4u*)(GA + (size_t)(r0 + r) * 1024 + col); }
#pragma unroll
            for (int r = 0; r < 8; ++r) { float uc[8], ga[8], o[8]; unpack8(ur[r], uc); unpack8(gr[r], ga);
#pragma unroll
                for (int e = 0; e < 8; ++e) { o[e] = ga[e] * (um2[e] * w0[e] + um1[e] * w1[e] + uc[e] * w2[e]); um2[e] = um1[e]; um1[e] = uc[e]; }
                *(v4u*)(GA + (size_t)(r0 + r) * 1024 + col) = pack8(o); }
        }
    }
    const int gt = vcu * 512 + tid, NT = G * 512;
    const float* sca = in[4]; const float* scq = in[5];
    for (int idx = gt; idx < 128 * 1024; idx += NT) {
        const int s = idx >> 10, ch = idx & 1023; const size_t ro = (size_t)(MP + s) * 1024 + ch;
        const float uc = bf1(U[ro]), ga = bf1(GA[ro]);
        const float s0 = sca[(size_t)(s * 2) * 1024 + ch], s1 = sca[(size_t)(s * 2 + 1) * 1024 + ch];
        const float o = ga * (s0 * caw[ch] + s1 * caw[1024 + ch] + uc * caw[2048 + ch]);
        out[O_NCAS + (size_t)(s * 2) * 1024 + ch] = s1; out[O_NCAS + (size_t)(s * 2 + 1) * 1024 + ch] = uc;
        if (!dry) GA[ro] = f2bf1(o);
    }
    for (int idx = gt; idx < 8 * 2 * 128; idx += NT) {
        const int col = (idx & 127) * 8, j = (idx >> 7) & 1, b = idx >> 8; float uc[8]; unpack8(*(const v4u*)(UH + ((size_t)(b * 256 + 255) * 2 + j) * 1024 + col), uc);
#pragma unroll
        for (int e = 0; e < 8; ++e) out[O_NCAP + (size_t)(b * 2 + j) * 1024 + col + e] = uc[e];
    }
}
__device__ __forceinline__ void phase3b(const float* const* in, unsigned char* ws, float* out, int gt, int NT) {
    const bf16* QKV = (const bf16*)(ws + WS_BUF + 3 * BUF_BYTES); const float* scq = in[5];
    for (int idx = gt; idx < 8 * 3 * 384; idx += NT) {
        const int cgq = idx % 384, j = (idx / 384) % 3, b = idx / 1152, col = cgq * 8; float uc[8]; unpack8(*(const v4u*)(QKV + (size_t)(b * 2048 + 2045 + j) * 3072 + col), uc);
#pragma unroll
        for (int e = 0; e < 8; ++e) out[O_NCQP + (size_t)(b * 3 + j) * 3072 + col + e] = uc[e];
    }
    for (int idx = gt; idx < 128 * 3 * 384; idx += NT) {
        const int cgq = idx % 384, j = (idx / 384) % 3, s = idx / 1152, col = cgq * 8; float uc[8];
        if (j < 2) {
#pragma unroll
            for (int e = 0; e < 8; ++e) uc[e] = scq[(size_t)(s * 3 + j + 1) * 3072 + col + e];
        } else unpack8(*(const v4u*)(QKV + (size_t)(MP + s) * 3072 + col), uc);
#pragma unroll
        for (int e = 0; e < 8; ++e) out[O_NCQS + (size_t)(s * 3 + j) * 3072 + col + e] = uc[e];
    }
}
__device__ __forceinline__ size_t qkv_gran(int t0, int h, int i) { const int row = i / 48, j = i - row * 48; return (size_t)(t0 + row) * 3072 + (j >> 4) * 1024 + h * 128 + (j & 15) * 8; }
__device__ __forceinline__ void stage_a(LAS unsigned char* L, int item, const bf16* QKV, const float* BA, const float* cbw,
                                        bf16* NW, bf16* QD, bf16* KDT, bf16* UD, bf16* AQK, float* GLv, int tid_in) {
    int tid = tid_in; asm volatile("" : "+v"(tid));
    const int lane = tid & 63, wid = tid >> 6;
    const int c = item & 31, h = (item >> 5) & 7, b = item >> 8, t0 = b * 2048 + c * 64;
    LAS float* sGC = (LAS float*)(L + 0); LAS float* sBETA = (LAS float*)(L + 256); LAS float* sEGC = (LAS float*)(L + 512); LAS float* sKDS = (LAS float*)(L + 768);
    LAS bf16* sQb = (LAS bf16*)(L + 1024);
    LAS bf16* sKb = (LAS bf16*)(L + 18432);
    LAS float* sRHS = (LAS float*)(L + 35840);
    LAS bf16* sKD = (LAS bf16*)(L + 101376);
    LAS float* sA = (LAS float*)(L + 118016);
    LAS bf16* sAQ = (LAS bf16*)(L + 134400);
    if (tid < 64) {
        const float g = BA[(size_t)(t0 + tid) * 16 + 8 + h], be = BA[(size_t)(t0 + tid) * 16 + h];
        float gc = g;
#pragma unroll
        for (int o = 1; o < 64; o <<= 1) { const float n = __shfl_up(gc, o); if (lane >= o) gc += n; }
        const float gl = __uint_as_float(__builtin_amdgcn_readlane(__float_as_uint(gc), 63));
        sGC[tid] = gc; sBETA[tid] = be; sEGC[tid] = __expf(gc); sKDS[tid] = __expf(gl - gc);
        if (tid == 0) GLv[item] = __expf(gl);
    }
    __syncthreads();
    if (tid < 384) {
        const int cg_ = tid % 48, strip = tid / 48, tensor = cg_ >> 4, c8 = (cg_ & 15) * 8;
        const int gcol = tensor * 1024 + h * 128 + c8, rl0 = strip * 8;
        float w[4][8];
#pragma unroll
        for (int j = 0; j < 4; ++j)
#pragma unroll
            for (int e = 0; e < 8; ++e) w[j][e] = cbw[j * 3072 + gcol + e];
        float xw[3][8];
#pragma unroll
        for (int j = 0; j < 3; ++j) { const int rr = rl0 - 3 + j;
            if (c > 0 || rr >= 0) unpack8(*(const v4u*)(QKV + (size_t)(t0 + rr) * 3072 + gcol), xw[j]);
            else {
#pragma unroll
                for (int e = 0; e < 8; ++e) xw[j][e] = 0.f; } }
        v4u rowv[8];
#pragma unroll
        for (int r = 0; r < 8; ++r) rowv[r] = *(const v4u*)(QKV + (size_t)(t0 + rl0 + r) * 3072 + gcol);
#pragma unroll
        for (int r = 0; r < 8; ++r) {
            const int tok = rl0 + r; float cur[8], y[8]; unpack8(rowv[r], cur);
            float ss = 0.f;
#pragma unroll
            for (int e = 0; e < 8; ++e) { y[e] = silu(w[0][e] * xw[0][e] + w[1][e] * xw[1][e] + w[2][e] * xw[2][e] + w[3][e] * cur[e]); ss += y[e] * y[e];
                xw[0][e] = xw[1][e]; xw[1][e] = xw[2][e]; xw[2][e] = cur[e]; }
            ss = row16_sum(ss);
            const float rstd = rsqrtf(ss + EPS);
            if (tensor == 0) {
                const float sc = rstd * 0.08838834764831845f, eg = sEGC[tok]; float qn[8], qd[8];
#pragma unroll
                for (int e = 0; e < 8; ++e) { qn[e] = y[e] * sc; qd[e] = qn[e] * eg; }
                *(LAS v4u*)(sQb + tok * 136 + c8) = pack8(qn);
                const int m = tok >> 4, s = c8 >> 5, jh = (c8 >> 4) & 1, g0 = (c8 & 15) >> 2;
                bf16* dst = QD + (size_t)item * 8192 + ((m * 4 + s) * 64 + 16 * g0 + (tok & 15)) * 8 + 4 * jh;
                v2u p0, p1; p0.x = pkbf(qd[0], qd[1]); p0.y = pkbf(qd[2], qd[3]); p1.x = pkbf(qd[4], qd[5]); p1.y = pkbf(qd[6], qd[7]);
                *(v2u*)dst = p0; *(v2u*)(dst + 16 * 8) = p1;
            } else if (tensor == 1) {
                const float be = sBETA[tok] * sEGC[tok], kd = sKDS[tok]; float kn[8], t8[8];
#pragma unroll
                for (int e = 0; e < 8; ++e) kn[e] = y[e] * rstd;
                *(LAS v4u*)(sKb + tok * 136 + c8) = pack8(kn);
#pragma unroll
                for (int e = 0; e < 8; ++e) t8[e] = kn[e] * be;
                *(LAS f32x4*)(sRHS + tok * 256 + 128 + c8) = (f32x4){t8[0], t8[1], t8[2], t8[3]}; *(LAS f32x4*)(sRHS + tok * 256 + 128 + c8 + 4) = (f32x4){t8[4], t8[5], t8[6], t8[7]};
                LAS unsigned* kdp = (LAS unsigned*)(sKD + tok * 130 + c8);
#pragma unroll
                for (int e = 0; e < 4; ++e) kdp[e] = pkbf(kn[2 * e] * kd, kn[2 * e + 1] * kd);
            } else {
                const float be = sBETA[tok];
                *(LAS f32x4*)(sRHS + tok * 256 + c8) = (f32x4){y[0] * be, y[1] * be, y[2] * be, y[3] * be}; *(LAS f32x4*)(sRHS + tok * 256 + c8 + 4) = (f32x4){y[4] * be, y[5] * be, y[6] * be, y[7] * be};
            }
        }
    }
    __syncthreads();
    {
        const int mat = wid >> 2, wr_ = wid & 3, fr = lane & 15, fq = lane >> 4;
        const LAS bf16* Am = mat ? sQb : sKb;
        f32x4 acc[4];
#pragma unroll
        for (int n = 0; n < 4; ++n) acc[n] = (f32x4){0.f, 0.f, 0.f, 0.f};
#pragma unroll
        for (int s = 0; s < 4; ++s) { const bf16x8 a = *(const LAS bf16x8*)(Am + (16 * wr_ + fr) * 136 + 32 * s + 8 * fq);
#pragma unroll
            for (int n = 0; n < 4; ++n) { const bf16x8 bb = *(const LAS bf16x8*)(sKb + (16 * n + fr) * 136 + 32 * s + 8 * fq); acc[n] = __builtin_amdgcn_mfma_f32_16x16x32_bf16(a, bb, acc[n], 0, 0, 0); } }
#pragma unroll
        for (int n = 0; n < 4; ++n)
#pragma unroll
            for (int r = 0; r < 4; ++r) { const int i = 16 * wr_ + 4 * fq + r, j = 16 * n + fr; const float d = acc[n][r], dec = __expf(sGC[i] - sGC[j]);
                if (mat == 0) sA[i * 64 + j] = (i > j) ? sBETA[i] * d * dec : 0.f;
                else { const float v = (i >= j) ? d * dec : 0.f; const int m = i >> 4, s2 = j >> 5, jj = 4 * ((j >> 4) & 1) + (j & 3), lp = 16 * ((j & 15) >> 2) + (i & 15);
                    sAQ[((m * 2 + s2) * 64 + lp) * 8 + jj] = f2bf1(v); } }
    }
    __syncthreads();
    float x[64];
    if (tid < 256) {
        int zoff; asm volatile("v_mov_b32 %0, 0" : "=v"(zoff));
#pragma unroll
        for (int i = 0; i < 64; ++i) x[i] = sRHS[i * 256 + tid];
#pragma unroll
        for (int i = 1; i < 64; ++i) {
#pragma unroll
            for (int jb = 0; jb < (i + 3) / 4; ++jb) { const f32x4 a4 = *(const LAS f32x4*)(sA + zoff + i * 64 + 4 * jb);
                x[i] -= a4[0] * x[4 * jb]; x[i] -= a4[1] * x[4 * jb + 1]; x[i] -= a4[2] * x[4 * jb + 2]; x[i] -= a4[3] * x[4 * jb + 3]; }
            if ((i & 1) == 1) asm volatile("" : "+v"(zoff), "+v"(x[i]));
        }
    } else {
        const int t2 = tid - 256;
#pragma unroll
        for (int q = 0; q < 4; ++q) { const int p = t2 + 256 * q, l = p & 63, fs = p >> 6, i = fs >> 1, s2 = fs & 1, dk = 16 * i + (l & 15), g = l >> 4; unsigned short v8[8];
#pragma unroll
            for (int j = 0; j < 8; ++j) { const int tok = 32 * s2 + 16 * (j >> 2) + 4 * g + (j & 3); v8[j] = sKD[tok * 130 + dk]; }
            v4u o; o.x = v8[0] | ((unsigned)v8[1] << 16); o.y = v8[2] | ((unsigned)v8[3] << 16); o.z = v8[4] | ((unsigned)v8[5] << 16); o.w = v8[6] | ((unsigned)v8[7] << 16);
            *(v4u*)(KDT + qkv_gran(t0, h, p)) = o; }
#pragma unroll
        for (int q = 0; q < 2; ++q) { const int p = t2 + 256 * q; *(v4u*)(AQK + (size_t)item * 4096 + p * 8) = *(const LAS v4u*)(sAQ + p * 8); }
    }
    __syncthreads();
    LAS bf16* stg = (LAS bf16*)sRHS;
    if (tid < 128) {
        const int dv = tid, w_ = dv >> 4;
#pragma unroll
        for (int m = 0; m < 4; ++m)
#pragma unroll
            for (int g = 0; g < 4; ++g) { v2u p; p.x = pkbf(x[16 * m + 4 * g], x[16 * m + 4 * g + 1]); p.y = pkbf(x[16 * m + 4 * g + 2], x[16 * m + 4 * g + 3]);
                { const int e = ((w_ * 4 + m) * 64 + 16 * g + (dv & 15)) * 4; *(v2u*)(UD + qkv_gran(t0, h, 1024 + (e >> 3)) + (e & 7)) = p; } }
    } else if (tid < 256) {
        const int dk = tid - 128, s = dk >> 5, jh = (dk >> 4) & 1, g = (dk & 15) >> 2, j = 4 * jh + (dk & 3);
#pragma unroll
        for (int tok = 0; tok < 64; ++tok) stg[(((tok >> 4) * 4 + s) * 64 + 16 * g + (tok & 15)) * 8 + j] = f2bf1(-x[tok]);
    }
    __syncthreads();
#pragma unroll
    for (int q = 0; q < 2; ++q) { const int p = tid + 512 * q; *(v4u*)(NW + (size_t)item * 8192 + p * 8) = *(const LAS v4u*)(stg + p * 8); }
    __syncthreads();
}

constexpr int SAP_SETB = 68608, SAP_A = 2 * SAP_SETB, SAP_AQ = SAP_A + 16384;
__device__ __forceinline__ void sap_scan(LAS unsigned char* S, int item, const float* BA, float* GLv, int lane) {
    const int c = item & 31, h = (item >> 5) & 7, b = item >> 8, t0 = b * 2048 + c * 64;
    LAS float* sGC = (LAS float*)S;
    const float g = BA[(size_t)(t0 + lane) * 16 + 8 + h], be = BA[(size_t)(t0 + lane) * 16 + h];
    float gc = g;
#pragma unroll
    for (int o = 1; o < 64; o <<= 1) { const float n = __shfl_up(gc, o); if (lane >= o) gc += n; }
    const float gl = __uint_as_float(__builtin_amdgcn_readlane(__float_as_uint(gc), 63));
    sGC[lane] = gc; sGC[64 + lane] = be; sGC[128 + lane] = __expf(gc); sGC[192 + lane] = __expf(gl - gc);
    if (lane == 0) GLv[item] = __expf(gl);
}
struct SapIn { float w[4][8]; float xw[3][8]; v4u rowv[13]; };
__device__ __forceinline__ void sap_conv_load(SapIn& I, int item, const bf16* QKV, const float* cbw, int ct) {
    const int c = item & 31, h = (item >> 5) & 7, b = item >> 8, t0 = b * 2048 + c * 64;
    const int cg_ = ct % 48, strip = ct / 48, tensor = cg_ >> 4, c8 = (cg_ & 15) * 8;
    const int gcol = tensor * 1024 + h * 128 + c8, rl0 = strip * 13, nr = (strip == 4) ? 12 : 13;
#pragma unroll
    for (int j = 0; j < 4; ++j)
#pragma unroll
        for (int e = 0; e < 8; ++e) I.w[j][e] = cbw[j * 3072 + gcol + e];
#pragma unroll
    for (int j = 0; j < 3; ++j) { const int rr = rl0 - 3 + j;
        if (c > 0 || rr >= 0) unpack8(*(const v4u*)(QKV + (size_t)(t0 + rr) * 3072 + gcol), I.xw[j]);
        else {
#pragma unroll
            for (int e = 0; e < 8; ++e) I.xw[j][e] = 0.f; } }
#pragma unroll
    for (int r = 0; r < 13; ++r) I.rowv[r] = __builtin_nontemporal_load((const v4u*)(QKV + (size_t)(t0 + (r < nr ? rl0 + r : rl0)) * 3072 + gcol));
}
__device__ __forceinline__ void sap_conv(LAS unsigned char* S, int item, SapIn& I, bf16* QD, int ct) {
    const int c = item & 31, h = (item >> 5) & 7, b = item >> 8, t0 = b * 2048 + c * 64; (void)c; (void)h; (void)b; (void)t0;
    LAS float* sGC = (LAS float*)S; LAS bf16* sQb = (LAS bf16*)(S + 1024); LAS bf16* sKb = (LAS bf16*)(S + 18432); LAS bf16* sRH = (LAS bf16*)(S + 35840);
    const int cg_ = ct % 48, strip = ct / 48, tensor = cg_ >> 4, c8 = (cg_ & 15) * 8;
    const int rl0 = strip * 13, nr = (strip == 4) ? 12 : 13;
    float (&w)[4][8] = I.w; float (&xw)[3][8] = I.xw; v4u (&rowv)[13] = I.rowv;
#pragma unroll
    for (int r = 0; r < 13; ++r) if (r < nr) {
        const int tok = rl0 + r; float cur[8], y[8]; unpack8(rowv[r], cur);
        float ss = 0.f;
#pragma unroll
        for (int e = 0; e < 8; ++e) { y[e] = silu(w[0][e] * xw[0][e] + w[1][e] * xw[1][e] + w[2][e] * xw[2][e] + w[3][e] * cur[e]); ss += y[e] * y[e];
            xw[0][e] = xw[1][e]; xw[1][e] = xw[2][e]; xw[2][e] = cur[e]; }
        ss = row16_sum(ss);
        const float rstd = rsqrtf(ss + EPS);
        if (tensor == 0) {
            const float sc = rstd * 0.08838834764831845f, eg = sGC[128 + tok]; float qn[8], qd[8];
#pragma unroll
            for (int e = 0; e < 8; ++e) { qn[e] = y[e] * sc; qd[e] = qn[e] * eg; }
            *(LAS v4u*)(sQb + tok * 136 + c8) = pack8(qn);
            const int m = tok >> 4, s = c8 >> 5, jh = (c8 >> 4) & 1, g0 = (c8 & 15) >> 2;
            bf16* dst = QD + (size_t)item * 8192 + ((m * 4 + s) * 64 + 16 * g0 + (tok & 15)) * 8 + 4 * jh;
            v2u p0, p1; p0.x = pkbf(qd[0], qd[1]); p0.y = pkbf(qd[2], qd[3]); p1.x = pkbf(qd[4], qd[5]); p1.y = pkbf(qd[6], qd[7]);
            *(v2u*)dst = p0; *(v2u*)(dst + 16 * 8) = p1;
        } else if (tensor == 1) {
            const float be = sGC[64 + tok] * sGC[128 + tok]; float kn[8], t8[8];
#pragma unroll
            for (int e = 0; e < 8; ++e) { kn[e] = y[e] * rstd; t8[e] = kn[e] * be; }
            *(LAS v4u*)(sKb + tok * 136 + c8) = pack8(kn);
            *(LAS v4u*)(sRH + tok * 256 + 128 + c8) = pack8(t8);
        } else {
            const float be = sGC[64 + tok]; float t8[8];
#pragma unroll
            for (int e = 0; e < 8; ++e) t8[e] = y[e] * be;
            *(LAS v4u*)(sRH + tok * 256 + c8) = pack8(t8);
        }
    }
}
__device__ __forceinline__ void stage_a_pipe(LAS unsigned char* L, int first, int stride, int nitems, const bf16* QKV, const float* BA, const float* cbw,
                                             bf16* NW, bf16* QD, bf16* KDT, bf16* UD, bf16* AQK, float* GLv, int tid_in,
                                             const bf16* Ubuf, bf16* GAbuf, const bf16* UHbuf, const float* caw) {
    LAS float* sA = (LAS float*)(L + SAP_A); LAS bf16* sAQ = (LAS bf16*)(L + SAP_AQ); LAS bf16* stg = (LAS bf16*)(L + SAP_A);
    { int tid = tid_in; asm volatile("" : "+v"(tid)); const int wid = tid >> 6, lane = tid & 63;
      (void)lane;
      if (wid >= 4 && tid - 256 < 240) { SapIn I; sap_conv_load(I, first, QKV, cbw, tid - 256); sap_conv(L, first, I, QD, tid - 256); }
      else if (wid < 4) branch_a_rest(Ubuf, GAbuf, UHbuf, caw, first, tid);
      __syncthreads(); }
    for (int k = 0; k < nitems; ++k) {
        int tid = tid_in; asm volatile("" : "+v"(tid));
        const int wid = tid >> 6, lane = tid & 63;
        const int item = first + k * stride, nxt = item + stride; const bool has_next = (k + 1 < nitems);
        LAS unsigned char* S = L + (k & 1) * SAP_SETB; LAS unsigned char* Sn = L + ((k + 1) & 1) * SAP_SETB;
        const int c = item & 31, h = (item >> 5) & 7, b = item >> 8, t0 = b * 2048 + c * 64;
        LAS float* sGC = (LAS float*)S; LAS bf16* sQb = (LAS bf16*)(S + 1024); LAS bf16* sKb = (LAS bf16*)(S + 18432); LAS bf16* sRH = (LAS bf16*)(S + 35840);
        if (wid < 4) {
            {
            const int fr = lane & 15, fq = lane >> 4;
#pragma unroll
            for (int mat = 0; mat < 2; ++mat) {
                const LAS bf16* Am = mat ? sQb : sKb;
                f32x4 acc[4];
#pragma unroll
                for (int n = 0; n < 4; ++n) acc[n] = (f32x4){0.f, 0.f, 0.f, 0.f};
#pragma unroll
                for (int s = 0; s < 4; ++s) { const bf16x8 a = *(const LAS bf16x8*)(Am + (16 * wid + fr) * 136 + 32 * s + 8 * fq);
#pragma unroll
                    for (int n = 0; n < 4; ++n) { const bf16x8 bb = *(const LAS bf16x8*)(sKb + (16 * n + fr) * 136 + 32 * s + 8 * fq); acc[n] = __builtin_amdgcn_mfma_f32_16x16x32_bf16(a, bb, acc[n], 0, 0, 0); } }
#pragma unroll
                for (int n = 0; n < 4; ++n)
#pragma unroll
                    for (int r = 0; r < 4; ++r) { const int i = 16 * wid + 4 * fq + r, j = 16 * n + fr; const float d = acc[n][r], dec = __expf(sGC[i] - sGC[j]);
                        if (mat == 0) sA[j * 64 + i] = (i > j) ? sGC[64 + i] * d * dec : 0.f;
                        else { const float v = (i >= j) ? d * dec : 0.f; const int m = i >> 4, s2 = j >> 5, jj = 4 * ((j >> 4) & 1) + (j & 3), lp = 16 * ((j & 15) >> 2) + (i & 15);
                            sAQ[((m * 2 + s2) * 64 + lp) * 8 + jj] = f2bf1(v); } }
            }
            }
            __syncthreads();
            f32x2v x2[32];
            {
            int zoff; asm volatile("v_mov_b32 %0, 0" : "=v"(zoff));
#pragma unroll
            for (int i = 0; i < 32; ++i) x2[i] = (f32x2v){bf1(sRH[(2 * i) * 256 + tid]), bf1(sRH[(2 * i + 1) * 256 + tid])};
#pragma unroll
            for (int j = 0; j < 63; ++j) {
                const float xj = (j & 1) ? x2[j >> 1][1] : x2[j >> 1][0];
                const f32x2v xjj = {xj, xj};
#pragma unroll
                for (int ib = (j + 1) / 4; ib < 16; ++ib) { const f32x4 a4 = *(const LAS f32x4*)(sA + zoff + j * 64 + 4 * ib);
                    x2[2 * ib] = x2[2 * ib] - (f32x2v){a4[0], a4[1]} * xjj; x2[2 * ib + 1] = x2[2 * ib + 1] - (f32x2v){a4[2], a4[3]} * xjj; }
                if ((j & 1) == 1) asm volatile("" : "+v"(zoff), "+v"(x2[(j + 1) >> 1]));
            }
            }
            float x[64];
#pragma unroll
            for (int i = 0; i < 32; ++i) { x[2 * i] = x2[i][0]; x[2 * i + 1] = x2[i][1]; }
            __syncthreads();
            if (tid < 128) {
                const int dv = tid, w_ = dv >> 4;
#pragma unroll
                for (int m = 0; m < 4; ++m)
#pragma unroll
                    for (int g = 0; g < 4; ++g) { v2u p; p.x = pkbf(x[16 * m + 4 * g], x[16 * m + 4 * g + 1]); p.y = pkbf(x[16 * m + 4 * g + 2], x[16 * m + 4 * g + 3]);
                        const int e = ((w_ * 4 + m) * 64 + 16 * g + (dv & 15)) * 4; *(v2u*)(UD + qkv_gran(t0, h, 1024 + (e >> 3)) + (e & 7)) = p; }
            } else {
                const int dk = tid - 128, s = dk >> 5, jh = (dk >> 4) & 1, g = (dk & 15) >> 2, j = 4 * jh + (dk & 3);
#pragma unroll
                for (int tok = 0; tok < 64; ++tok) stg[(((tok >> 4) * 4 + s) * 64 + 16 * g + (tok & 15)) * 8 + j] = f2bf1(-x[tok]);
            }
#pragma unroll
            for (int q = 0; q < 4; ++q) { const int p = tid + 256 * q, l = p & 63, fs = p >> 6, i = fs >> 1, s2 = fs & 1, dk = 16 * i + (l & 15), g = l >> 4; float v8[8];
#pragma unroll
                for (int j = 0; j < 8; ++j) { const int tok = 32 * s2 + 16 * (j >> 2) + 4 * g + (j & 3); v8[j] = bf1(sKb[tok * 136 + dk]) * sGC[192 + tok]; }
                *(v4u*)(KDT + qkv_gran(t0, h, p)) = pack8(v8); }
#pragma unroll
            for (int q = 0; q < 2; ++q) { const int p = tid + 256 * q; *(v4u*)(AQK + (size_t)item * 4096 + p * 8) = *(const LAS v4u*)(sAQ + p * 8); }
            __syncthreads();
#pragma unroll
            for (int q = 0; q < 4; ++q) { const int p = tid + 256 * q; *(v4u*)(NW + (size_t)item * 8192 + p * 8) = *(const LAS v4u*)(stg + p * 8); }
            __syncthreads();
        } else {
            SapIn I;
            if (tid - 256 < 240 && has_next) sap_conv_load(I, nxt, QKV, cbw, tid - 256);
            if (wid == 7 && has_next) sap_scan(Sn, nxt, BA, GLv, lane);
            __syncthreads();
            if (tid - 256 < 240 && has_next) sap_conv(Sn, nxt, I, QD, tid - 256);
            __syncthreads();
            __syncthreads();
            __syncthreads();
        }
    }
}
__device__ __forceinline__ void stage_b(LAS unsigned char* L, int bh, const bf16* NW, const bf16* QD, const bf16* KDT, const bf16* UD, const bf16* AQK,
                                        const float* GLv, bf16* ZBO, const float* onw, float* ndp, int tid, bool dry = false) {
    const int lane = tid & 63, w = tid >> 6, g = lane >> 4, colx = lane & 15, dv = 16 * w + colx, b = bh >> 3, h = bh & 7;
    LAS float* red = (LAS float*)(L + 114688);
    f32x4 S[8];
#pragma unroll
    for (int i = 0; i < 8; ++i) S[i] = (f32x4){0.f, 0.f, 0.f, 0.f};
    const float ow = onw[dv];
    v4u R[7];
    int kdo[2], udo[4], zbo[4][4];
#pragma unroll
    for (int q = 0; q < 2; ++q) { const int i = tid + 512 * q, row = i / 48, j = i - row * 48; kdo[q] = row * 3072 + (j >> 4) * 1024 + (j & 15) * 8; }
#pragma unroll
    for (int m = 0; m < 4; ++m) { const int e_ = ((w * 4 + m) * 64 + lane) * 4, i = 1024 + (e_ >> 3), row = i / 48, j = i - row * 48; udo[m] = row * 3072 + (j >> 4) * 1024 + (j & 15) * 8 + (e_ & 7);
#pragma unroll
        for (int r = 0; r < 4; ++r) zbo[m][r] = (16 * m + 4 * g + r) * 1024 + dv; }
#define SB_ISSUE(item_) do { const bf16* nwb_ = NW + (size_t)(item_) * 8192; const bf16* qdb_ = QD + (size_t)(item_) * 8192; const bf16* aqb_ = AQK + (size_t)(item_) * 4096; \
        const bf16* kdb_ = KDT + (size_t)(b * 2048 + ((item_) & 31) * 64) * 3072 + h * 128; \
        R[0] = __builtin_nontemporal_load((const v4u*)(nwb_ + tid * 8)); R[1] = __builtin_nontemporal_load((const v4u*)(nwb_ + (tid + 512) * 8)); R[2] = __builtin_nontemporal_load((const v4u*)(qdb_ + tid * 8)); R[3] = __builtin_nontemporal_load((const v4u*)(qdb_ + (tid + 512) * 8)); \
        R[4] = __builtin_nontemporal_load((const v4u*)(kdb_ + kdo[0])); R[5] = __builtin_nontemporal_load((const v4u*)(kdb_ + kdo[1])); R[6] = __builtin_nontemporal_load((const v4u*)(aqb_ + tid * 8)); } while (0)
#define SB_COMMIT(bufi_) do { _Pragma("unroll") for (int q = 0; q < 7; ++q) { const int p = tid + 512 * q; *(LAS v4u*)(L + (bufi_) * 57344 + p * 16) = R[q]; } } while (0)
    SB_ISSUE(bh * 32); SB_COMMIT(0);
    v2u udn[4]; unsigned short zbn[4][4];
#define SB_PRE(item_, t0_) do { const bf16* udb_ = UD + (size_t)(t0_) * 3072 + h * 128; const bf16* zbb_ = ZBO + (size_t)(t0_) * 1024 + h * 128; \
        _Pragma("unroll") for (int m = 0; m < 4; ++m) { udn[m] = *(const v2u*)(udb_ + udo[m]); \
        _Pragma("unroll") for (int r = 0; r < 4; ++r) zbn[m][r] = zbb_[zbo[m][r]]; } } while (0)
    SB_PRE(bh * 32, b * 2048);
    float gln = GLv[bh * 32];
    __syncthreads();
    for (int c = 0; c < 32; ++c) {
        const int item = bh * 32 + c, cur = c & 1, t0 = b * 2048 + c * 64;
        LAS unsigned char* B = L + cur * 57344;
        const int nitem = (c + 1 < 32) ? item + 1 : item, nt0 = (c + 1 < 32) ? t0 + 64 : t0;
        SB_ISSUE(nitem);
        f32x4 vn[4]; unsigned short zb[4][4];
#pragma unroll
        for (int m = 0; m < 4; ++m) { const v2u u2 = udn[m]; vn[m] = (f32x4){bflo(u2.x), bfhi(u2.x), bflo(u2.y), bfhi(u2.y)};
#pragma unroll
            for (int r = 0; r < 4; ++r) zb[m][r] = zbn[m][r]; }
        const float gl = gln;
        gln = GLv[nitem]; SB_PRE(nitem, nt0);
        bf16x8 Sb[4];
#pragma unroll
        for (int s = 0; s < 4; ++s) { v4u t; t.x = pk2(S[2 * s][0], S[2 * s][1]); t.y = pk2(S[2 * s][2], S[2 * s][3]); t.z = pk2(S[2 * s + 1][0], S[2 * s + 1][1]); t.w = pk2(S[2 * s + 1][2], S[2 * s + 1][3]); Sb[s] = __builtin_bit_cast(bf16x8, t); }
        f32x4 o[4];
#pragma unroll
        for (int m = 0; m < 4; ++m) o[m] = (f32x4){0.f, 0.f, 0.f, 0.f};
#pragma unroll
        for (int s = 0; s < 4; ++s)
#pragma unroll
            for (int m = 0; m < 4; ++m) { const bf16x8 a = *(const LAS bf16x8*)(B + ((m * 4 + s) * 64 + lane) * 16); vn[m] = __builtin_amdgcn_mfma_f32_16x16x32_bf16(a, Sb[s], vn[m], 0, 0, 0);
                const bf16x8 a2 = *(const LAS bf16x8*)(B + 16384 + ((m * 4 + s) * 64 + lane) * 16); o[m] = __builtin_amdgcn_mfma_f32_16x16x32_bf16(a2, Sb[s], o[m], 0, 0, 0); }
        bf16x8 vb[2];
#pragma unroll
        for (int s = 0; s < 2; ++s) { v4u t; t.x = pk2(vn[2 * s][0], vn[2 * s][1]); t.y = pk2(vn[2 * s][2], vn[2 * s][3]); t.z = pk2(vn[2 * s + 1][0], vn[2 * s + 1][1]); t.w = pk2(vn[2 * s + 1][2], vn[2 * s + 1][3]); vb[s] = __builtin_bit_cast(bf16x8, t); }
#pragma unroll
        for (int s = 0; s < 2; ++s)
#pragma unroll
            for (int m = 0; m < 4; ++m) { const bf16x8 a = *(const LAS bf16x8*)(B + 49152 + ((m * 2 + s) * 64 + lane) * 16); o[m] = __builtin_amdgcn_mfma_f32_16x16x32_bf16(a, vb[s], o[m], 0, 0, 0); }
#pragma unroll
        for (int ih = 0; ih < 2; ++ih) {
#pragma unroll
            for (int i = 4 * ih; i < 4 * ih + 4; ++i) S[i] = S[i] * gl;
#pragma unroll
            for (int s = 0; s < 2; ++s)
#pragma unroll
                for (int i = 4 * ih; i < 4 * ih + 4; ++i) { const bf16x8 a = *(const LAS bf16x8*)(B + 32768 + ((i * 2 + s) * 64 + lane) * 16); S[i] = __builtin_amdgcn_mfma_f32_16x16x32_bf16(a, vb[s], S[i], 0, 0, 0); }
        }
#pragma unroll
        for (int m = 0; m < 4; ++m)
#pragma unroll
            for (int r = 0; r < 4; ++r) { float q = row16_sum(o[m][r] * o[m][r]);
                if (colx == 0) red[(cur * 64 + 16 * m + 4 * g + r) * 8 + w] = q; }
        SB_COMMIT(cur ^ 1);
        __syncthreads();
        {
            LAS float* rs = red + 1024 + (cur * 8 + w) * 64;
            bf16* zst = ZBO + (size_t)t0 * 1024 + h * 128;
            const f32x4 p0 = *(const LAS f32x4*)(red + (cur * 64 + lane) * 8), p1 = *(const LAS f32x4*)(red + (cur * 64 + lane) * 8 + 4);
            rs[lane] = rsqrtf((((p0[0] + p0[1]) + (p0[2] + p0[3])) + ((p1[0] + p1[1]) + (p1[2] + p1[3]))) * (1.f / 128.f) + EPS);
#pragma unroll
            for (int m = 0; m < 4; ++m) { const f32x4 r4 = *(const LAS f32x4*)(rs + 16 * m + 4 * g);
#pragma unroll
                for (int r = 0; r < 4; ++r) { const int tok = 16 * m + 4 * g + r;
                    (void)tok; if (!dry) zst[zbo[m][r]] = f2bf1(o[m][r] * r4[r] * ow * bf1(zb[m][r])); } }
        }
    }
#pragma unroll
    for (int i = 0; i < 8; ++i)
#pragma unroll
        for (int r = 0; r < 4; ++r) if (!dry) ndp[((size_t)bh * 128 + 16 * i + 4 * g + r) * 128 + dv] = S[i][r];
    __syncthreads();
}
__device__ __forceinline__ void sample_delta(LAS unsigned char* L, int item, const float* const* in, unsigned char* ws, float* out, int tid, bool dry = false) {
    const int lane = tid & 63, wid = tid >> 6, s = item >> 3, h = item & 7;
    LAS float* vals = (LAS float*)L; LAS float* part = (LAS float*)(L + 2048); LAS float* misc = (LAS float*)(L + 4096);
    const bf16* QKV = (const bf16*)(ws + WS_BUF + 3 * BUF_BYTES); const float* BA = (const float*)(ws + WS_BA); bf16* ZBO = (bf16*)(ws + WS_BUF + 6 * BUF_BYTES);
    const float* scq = in[5]; const float* cbw = in[12]; const float* sd = in[6];
    if (tid < 384) { const int tensor = tid >> 7, d = tid & 127, colg = tensor * 1024 + h * 128 + d; const float* st = scq + (size_t)(s * 3) * 3072 + colg;
        const float y = cbw[colg] * st[0] + cbw[3072 + colg] * st[3072] + cbw[2 * 3072 + colg] * st[2 * 3072] + cbw[3 * 3072 + colg] * bf1(QKV[(size_t)(MP + s) * 3072 + colg]);
        vals[tid] = silu(y); }
    __syncthreads();
    if (wid < 2) { const float a0 = vals[wid * 128 + lane], a1 = vals[wid * 128 + 64 + lane]; const float ss = wave_sum(a0 * a0 + a1 * a1);
        if (lane == 0) misc[wid] = rsqrtf(ss + EPS) * (wid == 0 ? 0.08838834764831845f : 1.f); }
    __syncthreads();
    const int dv = tid & 127, grp = tid >> 7, dk0 = 32 * grp;
    const float a = __expf(BA[(size_t)(MP + s) * 16 + 8 + h]), beta = BA[(size_t)(MP + s) * 16 + h], rq = misc[0], rk = misc[1];
    const float* S0 = sd + (size_t)item * 16384; float* S1 = out + O_NDS + (size_t)item * 16384;
    float Sr[32]; float ks = 0.f;
#pragma unroll
    for (int i = 0; i < 32; ++i) { Sr[i] = __builtin_nontemporal_load(S0 + (dk0 + i) * 128 + dv); }
#pragma unroll
    for (int i = 0; i < 32; ++i) ks += vals[128 + dk0 + i] * Sr[i];
    part[grp * 128 + dv] = ks;
    __syncthreads();
    const float kS = a * rk * (part[dv] + part[128 + dv] + part[256 + dv] + part[384 + dv]);
    const float vnew = beta * (vals[256 + dv] - kS);
    float po = 0.f;
#pragma unroll
    for (int i = 0; i < 32; ++i) { const float sn = a * Sr[i] + (vals[128 + dk0 + i] * rk) * vnew; if (!dry) S1[(dk0 + i) * 128 + dv] = sn; po += vals[dk0 + i] * sn; }
    __syncthreads();
    part[grp * 128 + dv] = po;
    __syncthreads();
    const float o = rq * (part[dv] + part[128 + dv] + part[256 + dv] + part[384 + dv]);
    if (wid < 2) { const float ss = wave_sum(o * o); if (lane == 0) misc[2 + wid] = ss; }
    __syncthreads();
    if (tid < 128) { const float rstd = rsqrtf((misc[2] + misc[3]) * (1.f / 128.f) + EPS); const size_t oi = (size_t)(MP + s) * 1024 + h * 128 + dv;
        if (!dry) ZBO[oi] = f2bf1(o * rstd * in[15][dv] * bf1(ZBO[oi])); }
    __syncthreads();
}

__device__ __forceinline__ void seq_full(LAS unsigned char* L, int bh, const bf16* QKV, const float* BA, const float* cbw, bf16* ZBO, const float* onw, float* ndp, int tid) {
    const int lane = tid & 63, wid = tid >> 6, b = bh >> 3, h = bh & 7;
    LAS float* vals = (LAS float*)L; LAS float* part = (LAS float*)(L + 2048); LAS float* misc = (LAS float*)(L + 4096);
    const int dv = tid & 127, grp = tid >> 7, dk0 = 32 * grp;
    float Sr[32];
#pragma unroll
    for (int i = 0; i < 32; ++i) Sr[i] = 0.f;
    const float ow = onw[dv];
    for (int t = 0; t < 2048; ++t) {
        const size_t row = (size_t)b * 2048 + t;
        if (tid < 384) { const int tensor = tid >> 7, d = tid & 127, colg = tensor * 1024 + h * 128 + d; float y = 0.f;
#pragma unroll
            for (int j = 0; j < 4; ++j) { if (t - 3 + j >= 0) y += cbw[j * 3072 + colg] * bf1(QKV[(row - 3 + j) * 3072 + colg]); }
            vals[tid] = silu(y); }
        __syncthreads();
        if (wid < 2) { const float a0 = vals[wid * 128 + lane], a1 = vals[wid * 128 + 64 + lane]; const float ss = wave_sum(a0 * a0 + a1 * a1); if (lane == 0) misc[wid] = rsqrtf(ss + EPS) * (wid == 0 ? 0.08838834764831845f : 1.f); }
        __syncthreads();
        const float a = __expf(BA[row * 16 + 8 + h]), beta = BA[row * 16 + h], rq = misc[0], rk = misc[1];
        float ks = 0.f;
#pragma unroll
        for (int i = 0; i < 32; ++i) ks += vals[128 + dk0 + i] * Sr[i];
        part[grp * 128 + dv] = ks;
        __syncthreads();
        const float kS = a * rk * (part[dv] + part[128 + dv] + part[256 + dv] + part[384 + dv]);
        const float vnew = beta * (vals[256 + dv] - kS);
        float po = 0.f;
#pragma unroll
        for (int i = 0; i < 32; ++i) { Sr[i] = a * Sr[i] + (vals[128 + dk0 + i] * rk) * vnew; po += vals[dk0 + i] * Sr[i]; }
        __syncthreads();
        part[grp * 128 + dv] = po;
        __syncthreads();
        const float o = rq * (part[dv] + part[128 + dv] + part[256 + dv] + part[384 + dv]);
        if (wid < 2) { const float ss = wave_sum(o * o); if (lane == 0) misc[2 + wid] = ss; }
        __syncthreads();
        if (tid < 128) { const float rstd = rsqrtf((misc[2] + misc[3]) * (1.f / 128.f) + EPS); const size_t oi = row * 1024 + h * 128 + dv; ZBO[oi] = f2bf1(o * rstd * ow * bf1(ZBO[oi])); }
        __syncthreads();
    }
#pragma unroll
    for (int i = 0; i < 32; ++i) ndp[((size_t)bh * 128 + dk0 + i) * 128 + dv] = Sr[i];
}
__device__ __forceinline__ void phase_final(const float* const* in, unsigned char* ws, float* out, int vcu, int G, int tid) {
    const int lane = tid & 63, wave = tid >> 6, gw = vcu * 8 + wave, NGW = G * 8;
    const bf16* T = (const bf16*)(ws + WS_BUF + 4 * BUF_BYTES); const float* MOD = (const float*)(ws + WS_MOD); const float* npost = in[19];
    f32x4 np[2][2];
#pragma unroll
    for (int j = 0; j < 2; ++j)
#pragma unroll
        for (int q = 0; q < 2; ++q) np[j][q] = *(const f32x4*)(npost + 512 * j + 8 * lane + 4 * q);
    const int nblk = MP / 8;
    for (int blk = gw; blk < nblk + NS; blk += NGW) {
        const bool samp = blk >= nblk;
        const int m0 = samp ? MP + (blk - nblk) : blk * 8, nrow = samp ? 1 : 8, mr = samp ? 8 + (blk - nblk) : (m0 >> 11);
        const float* xr = samp ? in[1] + (size_t)(blk - nblk) * 1024 : in[0] + (size_t)m0 * 1024;
        f32x4 gn[2][2];
#pragma unroll
        for (int j = 0; j < 2; ++j)
#pragma unroll
            for (int q = 0; q < 2; ++q) gn[j][q] = *(const f32x4*)(MOD + (size_t)mr * 3072 + 2048 + 512 * j + 8 * lane + 4 * q) * np[j][q];
        v4u tn[2]; f32x4 xn[2][2];
#pragma unroll
        for (int j = 0; j < 2; ++j) { tn[j] = __builtin_nontemporal_load((const v4u*)(T + (size_t)m0 * 1024 + 512 * j + 8 * lane));
#pragma unroll
            for (int q = 0; q < 2; ++q) xn[j][q] = __builtin_nontemporal_load((const f32x4*)(xr + 512 * j + 8 * lane + 4 * q)); }
        for (int r = 0; r < nrow; ++r) {
            const int m = m0 + r;
            float t[2][8]; f32x4 xv[2][2]; float ss = 0.f;
#pragma unroll
            for (int j = 0; j < 2; ++j) { unpack8(tn[j], t[j]);
#pragma unroll
                for (int q = 0; q < 2; ++q) xv[j][q] = xn[j][q];
#pragma unroll
                for (int e = 0; e < 8; ++e) ss += t[j][e] * t[j][e]; }
            { const int rn = (r + 1 < nrow) ? r + 1 : r;
#pragma unroll
                for (int j = 0; j < 2; ++j) { tn[j] = __builtin_nontemporal_load((const v4u*)(T + (size_t)(m0 + rn) * 1024 + 512 * j + 8 * lane));
#pragma unroll
                    for (int q = 0; q < 2; ++q) xn[j][q] = __builtin_nontemporal_load((const f32x4*)(xr + (size_t)rn * 1024 + 512 * j + 8 * lane + 4 * q)); } }
            const float rstd = rsqrtf(wave_sum(ss) * (1.f / 1024.f) + EPS);
#pragma unroll
            for (int j = 0; j < 2; ++j)
#pragma unroll
                for (int q = 0; q < 2; ++q) { const int k = 512 * j + 8 * lane + 4 * q;
                    f32x4 tv = {t[j][4 * q], t[j][4 * q + 1], t[j][4 * q + 2], t[j][4 * q + 3]};
                    *(f32x4*)(out + (size_t)m * 1024 + k) = xv[j][q] + gn[j][q] * (tv * rstd); }
        }
    }
}
struct Args { const float* in[20]; float* out; unsigned char* ws; };
__global__ void __launch_bounds__(512, 2) fwd_kernel(Args args) {
    extern __shared__ __attribute__((aligned(16))) unsigned char lds_raw[];
    LAS unsigned char* L = (LAS unsigned char*)lds_raw;
#define FRESH_TID() ({ int t_ = threadIdx.x; asm volatile("" : "+v"(t_)); t_; })
#define FRESH_WAVE() __builtin_amdgcn_readfirstlane(FRESH_TID() >> 6)
    const int G = gridDim.x, bx = blockIdx.x; const int vcu = (G % 8 == 0) ? (bx % 8) * (G / 8) + bx / 8 : bx;
    unsigned char* ws = args.ws; float* out = args.out;
    if (gridDim.x > 65536u) cg::this_grid().sync();
    volatile LAS unsigned* MISC = (volatile LAS unsigned*)(L + MISC_OFF);
    if (threadIdx.x < 16) MISC[threadIdx.x] = 0u;
    __syncthreads();
    XcdBarrier bar = xcd_barrier_post((unsigned*)(ws + WS_CTL) + CW_BAR, MISC + 8);
    const int NGW = G * 8;
    bf16* B0 = (bf16*)(ws + WS_BUF); bf16* B1 = (bf16*)(ws + WS_BUF + 1 * BUF_BYTES); bf16* B2 = (bf16*)(ws + WS_BUF + 2 * BUF_BYTES); bf16* B3 = (bf16*)(ws + WS_BUF + 3 * BUF_BYTES);
    bf16* B4 = (bf16*)(ws + WS_BUF + 4 * BUF_BYTES); bf16* B6 = (bf16*)(ws + WS_BUF + 6 * BUF_BYTES);
    bf16* D0 = (bf16*)out; bf16* D1 = D0 + (size_t)MV * 1024; bf16* D2 = (bf16*)(out + O_NDS); bf16* D3 = D2 + (size_t)MP * 1024;
    bf16* WIN = (bf16*)(ws + WS_WIN); bf16* WA = (bf16*)(ws + WS_WA); bf16* WB = (bf16*)(ws + WS_WB); bf16* WO = (bf16*)(ws + WS_WO);
    float* GLv = (float*)(ws + WS_GL);

    phase_mod(args.in, ws, FRESH_WAVE() * G + vcu, NGW, FRESH_TID() & 63);
    phase0(L, args.in, ws, vcu, G, FRESH_TID());
    xcd_barrier(bar);
#ifdef DBL_P0
    phase0(L, args.in, ws, vcu, G, FRESH_TID());
#endif
    phase1(L, args.in, ws, vcu, G, FRESH_TID());
#ifdef DBL_P1
    __syncthreads();
    phase1(L, args.in, ws, vcu, G, FRESH_TID());
#endif
    xcd_barrier(bar);
    {   pg8::Gemm g{B0, WIN, MPAD, NIN, 1024}; pg8::StaticOrder S; S.init(MPAD, NIN, G, bx);
        EpiIn E{B1, B2, B3, B6, D0, D1, D2};
        pg8::gemm_phase<EpiIn, pg8::StaticOrder, true, true>(L, g, S, E);
#ifdef DBL_P2
        pg8::gemm_phase<EpiIn, pg8::StaticOrder, true, true>(L, g, S, E);
#endif
 }
    xcd_barrier(bar);
    phase3(args.in, ws, out, vcu, G, bx, FRESH_TID());
    if (FRESH_WAVE() == 7) sap_scan(L, bx, (const float*)(ws + WS_BA), GLv, FRESH_TID() & 63);
    __syncthreads();
    stage_a_pipe(L, bx, G, (2048 - bx + G - 1) / G, B3, (const float*)(ws + WS_BA), args.in[12], B0, B1, B3, B3, WIN, GLv, FRESH_TID(), B1, B2, D2, args.in[11]);
    xcd_barrier(bar);
#ifndef USE_SEQ
#ifdef DBL_P5
    if (bx < 64) { _Pragma("nounroll") for (int rep = 0; rep < 2; ++rep) stage_b(L, bx, B0, B1, B3, B3, WIN, GLv, B6, args.in[15], out + O_NDP, FRESH_TID(), rep == 0); }
    else {
        pg8::StaticOrder S; S.init(MP, 1024, G - 64, bx - 64); pg8::Gemm g{B2, WA, MP, 1024, 1024}; EpiEl<FOutA> E{FOutA{D0, D0}};
        pg8::gemm_phase<EpiEl<FOutA>, pg8::StaticOrder, true, true>(L, g, S, E); small_gemm_wg(L, B2, WA, MP, E.f, bx - 64, G - 64, FRESH_TID());
        for (int it = bx - 64; it < 1024; it += G - 64) sample_delta(L, it, args.in, ws, out, FRESH_TID()); }
#else
    if (bx < 64) stage_b(L, bx, B0, B1, B3, B3, WIN, GLv, B6, args.in[15], out + O_NDP, FRESH_TID());
    else {
        phase3b(args.in, ws, out, (bx - 64) * 512 + FRESH_TID(), (G - 64) * 512);
        pg8::StaticOrder S; S.init(MP, 1024, G - 64, bx - 64); pg8::Gemm g{B2, WA, MP, 1024, 1024}; EpiEl<FOutA> E{FOutA{D0, D0}};
        pg8::gemm_phase<EpiEl<FOutA>, pg8::StaticOrder, true, true>(L, g, S, E); small_gemm_wg(L, B2, WA, MP, E.f, bx - 64, G - 64, FRESH_TID());
        if (bx >= 128) { for (int it = bx - 128; it < 832; it += 128) sample_delta(L, it, args.in, ws, out, FRESH_TID()); }
        else { for (int it = 832 + (bx - 64); it < 1024; it += 64) sample_delta(L, it, args.in, ws, out, FRESH_TID()); } }
#endif
#else
    if (bx < 64) seq_full(L, bx, B3, (const float*)(ws + WS_BA), args.in[12], B6, args.in[15], out + O_NDP, FRESH_TID());
#endif
    xcd_barrier(bar);
#ifdef DBL_P6
    _Pragma("nounroll") for (int rep = 0; rep < 2; ++rep)
#endif
    {   pg8::StaticOrder S; S.init(MP, 1024, G, bx);
        { pg8::Gemm g{B6, WB, MP, 1024, 1024}; EpiEl<FOutB> E{FOutB{D1, D0, B3}}; pg8::gemm_phase<EpiEl<FOutB>, pg8::StaticOrder, true, true>(L, g, S, E); small_gemm_wg(L, B6, WB, MP, E.f, bx, G, FRESH_TID()); } }
    xcd_barrier(bar);
#ifdef DBL_P7
    _Pragma("nounroll") for (int rep = 0; rep < 2; ++rep)
#endif
    {   pg8::StaticOrder S; S.init(MP, 1024, G, bx); pg8::Gemm g{B3, WO, MP, 1024, 1024}; EpiEl<FPlain> E{FPlain{B4}};
        pg8::gemm_phase<EpiEl<FPlain>, pg8::StaticOrder, true, true>(L, g, S, E); small_gemm_wg(L, B3, WO, MP, E.f, bx, G, FRESH_TID()); }
    xcd_barrier(bar);
    phase_final(args.in, ws, out, vcu, G, FRESH_TID());
#ifdef DBL_P8
    phase_final(args.in, ws, out, vcu, G, FRESH_TID());
#endif
}

extern "C" void kernel_launch(void* const* d_in, const int* in_sizes, int n_in, void* d_out, int out_size, void* d_ws, size_t ws_size, hipStream_t stream) {
    static int grid = 0;
    if (grid == 0) {
        if (n_in != 20 || (size_t)out_size != O_END || ws_size < WS_END) { fprintf(stderr, "kernel_launch: unexpected shapes: n_in %d out %d ws %zu\n", n_in, out_size, ws_size); grid = -1; return; }
        int dev = 0, cus = 0, per_cu = 0;
        hipGetDevice(&dev); hipDeviceGetAttribute(&cus, hipDeviceAttributeMultiprocessorCount, dev);
        if (hipFuncSetAttribute((const void*)fwd_kernel, hipFuncAttributeMaxDynamicSharedMemorySize, LDS_BYTES) != hipSuccess) { fprintf(stderr, "kernel_launch: hipFuncSetAttribute failed\n"); grid = -1; return; }
        hipOccupancyMaxActiveBlocksPerMultiprocessor(&per_cu, (const void*)fwd_kernel, 512, LDS_BYTES);
        (void)hipGetLastError();
        if (per_cu < 1) fprintf(stderr, "kernel_launch: occupancy query says %d blocks/CU\n", per_cu);
        grid = cus;
    }
    if (grid < 0) return;
    hipMemsetAsync((char*)d_ws + WS_CTL, 0, CTL_BYTES, stream);
    Args a{};
    for (int i = 0; i < 20; ++i) a.in[i] = (const float*)d_in[i];
    a.out = (float*)d_out; a.ws = (unsigned char*)d_ws;
    void* params[] = {&a};
    hipError_t e = hipLaunchCooperativeKernel((const void*)fwd_kernel, dim3(grid), dim3(512), params, LDS_BYTES, stream);
    if (e != hipSuccess) fprintf(stderr, "kernel_launch: cooperative launch failed: %s (grid %d)\n", hipGetErrorString(e), grid);
}
```

```cpp
#include <hip/hip_runtime.h>
#include <hip/hip_cooperative_groups.h>
#include <cstdio>
#include <cstdint>
namespace cg = cooperative_groups;
namespace pg8 {
#define PG8_LAS __attribute__((address_space(3)))
typedef unsigned short bf16_t;
typedef short bf16x8 __attribute__((ext_vector_type(8)));
typedef float f32x4 __attribute__((ext_vector_type(4)));
typedef unsigned u32x4 __attribute__((ext_vector_type(4)));
constexpr int BM = 256, BK = 64, HALF = 128, HTB = HALF * BK * 2  , STAGE_BYTES = 8 * HTB, NXCD = 8, WGM = 4;

__host__ __device__ __forceinline__ int lds_byte(int r, int c) { const int st = (r >> 4) * 2 + (c >> 5), rr = r & 15, cc = c & 31, ob = rr * 64 + cc * 2; return st * 1024 + (ob ^ (((ob >> 9) & 1) << 5)); }
__host__ __device__ __forceinline__ void stage_rc(int b, int& R, int& C) { const int st = b / 1024, sb = b % 1024, swz = sb ^ (((sb >> 9) & 1) << 5); R = (st >> 1) * 16 + swz / 64; C = (st & 1) * 32 + (swz % 64) / 2; }
__host__ __device__ __forceinline__ int perm32(int rho) { const int n = rho >> 4, i = rho & 15; return 8 * (i >> 2) + 4 * n + (i & 3); }

struct Unit { int pm, pn; };
struct Gemm { const bf16_t* A; const bf16_t* Bt; int M, N, K; };

struct StaticOrder {
    int nM, nN, nwg, G, c;
    __host__ __device__ void init(int M, int N, int G_, int c_) { nM = M / BM; nN = N / BM; nwg = nM * nN; G = G_; c = c_; }
    __host__ __device__ bool next(int i, Unit& u) const {
        const long L = (long)i * G + c; if (L >= nwg) return false;
        int wgid = (int)L; { const int q = nwg / NXCD, r = nwg % NXCD, xcd = wgid % NXCD, off = wgid / NXCD; wgid = (xcd < r ? xcd * (q + 1) : r * (q + 1) + (xcd - r) * q) + off; }
        const int nig = WGM * nN, gid = wgid / nig, fm = gid * WGM, gsz = (nM - fm) < WGM ? (nM - fm) : WGM;
        u.pm = fm + ((wgid % nig) % gsz); u.pn = (wgid % nig) / gsz; return true;
    }
    __device__ __forceinline__ void a_ready(const Unit&) const {}
    __device__ __forceinline__ void done(const Unit&) const {}
};

__device__ __forceinline__ unsigned cvt_pk_bf16(float lo, float hi) { unsigned r; asm volatile("v_cvt_pk_bf16_f32 %0, %1, %2" : "=v"(r) : "v"(lo), "v"(hi)); return r; }
typedef float f32x2 __attribute__((ext_vector_type(2)));
template <class Epi, class Sched, bool ALIGN_EPI = false, bool SP2 = false>
__device__ __forceinline__ void gemm_phase(PG8_LAS unsigned char* lds, const Gemm g, const Sched& S, const Epi& E) {
    int tid = threadIdx.x; asm volatile("" : "+v"(tid));
    const int wid = __builtin_amdgcn_readfirstlane(tid >> 6), lane = tid & 63, wr = wid >> 2, wc = wid & 3, fr = lane & 15, fq = lane >> 4;
    const int K = g.K, nt = K / BK;
    unsigned voffA[2], voffB[2];
#pragma unroll
    for (int i = 0; i < 2; ++i) { int R, C; stage_rc(tid * 16 + i * 8192, R, C); const int Rb = Epi::PERM ? ((R & ~31) + perm32(R & 31)) : R;
        voffA[i] = (unsigned)(R * K + C) * 2u; voffB[i] = (unsigned)(Rb * K + C) * 2u; }
    const size_t kstep = (size_t)(BK * 2);
    const size_t hstep = (size_t)HALF * K * 2;
    const size_t tstep = 2 * hstep;
    const unsigned ldsw = (unsigned)wid * 1024u;
    const int aoff = lds_byte(wr * 64 + fr, fq * 8), boff = lds_byte(wc * 32 + fr, fq * 8);
#define PG8_SA(b, h) (((b) * 2 + (h)) * HTB)
#define PG8_SB(b, h) ((4 + (b) * 2 + (h)) * HTB)
#define PG8_STAGE(bufoff, gbase, voff) do { _Pragma("unroll") for (int _i = 0; _i < 2; ++_i) \
        __builtin_amdgcn_global_load_lds((const unsigned*)((const char*)(gbase) + (voff)[_i]), (PG8_LAS unsigned*)(lds + (bufoff) + ldsw + _i * 8192), 16, 0, 0); } while (0)
#define PG8_LDA(dst, b, h) do { _Pragma("unroll") for (int m = 0; m < 4; ++m) _Pragma("unroll") for (int k = 0; k < 2; ++k) dst[m][k] = *(const PG8_LAS bf16x8*)(lds + PG8_SA(b, h) + aoff + m * 2048 + k * 1024); } while (0)
#define PG8_LDB(dst, b, h) do { _Pragma("unroll") for (int n = 0; n < 2; ++n) _Pragma("unroll") for (int k = 0; k < 2; ++k) dst[n][k] = *(const PG8_LAS bf16x8*)(lds + PG8_SB(b, h) + boff + n * 2048 + k * 1024); } while (0)
#define PG8_MMA(ai, bj, At, Bt) do { __builtin_amdgcn_s_setprio(1); _Pragma("unroll") for (int m = 0; m < 4; ++m) _Pragma("unroll") for (int n = 0; n < 2; ++n) _Pragma("unroll") for (int k = 0; k < 2; ++k) \
        acc[ai][bj][m][n] = __builtin_amdgcn_mfma_f32_16x16x32_bf16(Bt[n][k], At[m][k], acc[ai][bj][m][n], 0, 0, 0); __builtin_amdgcn_s_setprio(0); } while (0)
#define PG8_WAIT_V(n) asm volatile("s_waitcnt vmcnt(" #n ")" ::: "memory")
#define PG8_WAIT_L(n) asm volatile("s_waitcnt lgkmcnt(" #n ")" ::: "memory")
#define PG8_BAR __builtin_amdgcn_s_barrier()
#define PG8_SCHED __builtin_amdgcn_sched_barrier(0)
    Unit cur, nxt; int ui = 0;
    if (!S.next(0, cur)) return;
    f32x4 acc[2][2][4][2];
#pragma unroll
    for (int a = 0; a < 2; ++a)
#pragma unroll
        for (int b = 0; b < 2; ++b)
#pragma unroll
            for (int m = 0; m < 4; ++m)
#pragma unroll
                for (int n = 0; n < 2; ++n) acc[a][b][m][n] = (f32x4){0.f, 0.f, 0.f, 0.f};
    bf16x8 At[4][2], B0[2][2], B1[2][2];
    const char* cA = (const char*)g.A + (size_t)cur.pm * tstep; const char* cB = (const char*)g.Bt + (size_t)cur.pn * tstep;
    S.a_ready(cur);
    if constexpr (SP2) {
        PG8_STAGE(PG8_SB(0, 0), cB, voffB); PG8_STAGE(PG8_SB(0, 1), cB + hstep, voffB); PG8_STAGE(PG8_SA(0, 0), cA, voffA); PG8_STAGE(PG8_SA(0, 1), cA + hstep, voffA);
        if (wr == 1) PG8_BAR;
        PG8_WAIT_V(2); PG8_BAR;
        PG8_STAGE(PG8_SB(1, 0), cB + kstep, voffB); PG8_STAGE(PG8_SA(1, 0), cA + kstep, voffA); PG8_STAGE(PG8_SB(1, 1), cB + hstep + kstep, voffB);
        PG8_WAIT_V(6); PG8_BAR;
    } else {
        PG8_STAGE(PG8_SB(0, 0), cB, voffB); PG8_STAGE(PG8_SA(0, 0), cA, voffA); PG8_STAGE(PG8_SB(0, 1), cB + hstep, voffB); PG8_STAGE(PG8_SA(0, 1), cA + hstep, voffA);
        if (wr == 1) PG8_BAR;
        PG8_WAIT_V(4); PG8_BAR;
        PG8_STAGE(PG8_SB(1, 0), cB + kstep, voffB); PG8_STAGE(PG8_SA(1, 0), cA + kstep, voffA); PG8_STAGE(PG8_SB(1, 1), cB + hstep + kstep, voffB);
        PG8_WAIT_V(6); PG8_BAR;
    }
    for (;;) {
        const bool has_next = S.next(ui + 1, nxt);
        const char* nA = has_next ? (const char*)g.A + (size_t)nxt.pm * tstep : cA; const char* nB = has_next ? (const char*)g.Bt + (size_t)nxt.pn * tstep : cB;
        for (int t = 0; t < nt; t += 2) {
            const bool last = (t == nt - 2);
            const char* a1 = cA + (size_t)(t + 1) * kstep;
            const char* a2 = last ? nA : cA + (size_t)(t + 2) * kstep; const char* b2 = last ? nB : cB + (size_t)(t + 2) * kstep;
            const char* a3 = a2 + kstep; const char* b3 = b2 + kstep;
            if (last && has_next) S.a_ready(nxt);
            if constexpr (SP2) {
            PG8_LDB(B0, 0, 0); PG8_LDB(B1, 0, 1); PG8_SCHED; PG8_LDA(At, 0, 0); PG8_STAGE(PG8_SA(1, 1), a1 + hstep, voffA);
            PG8_WAIT_V(8); PG8_WAIT_L(0); PG8_BAR; PG8_MMA(0, 0, At, B0); PG8_MMA(0, 1, At, B1); PG8_BAR; PG8_SCHED;
            PG8_LDA(At, 0, 1); PG8_STAGE(PG8_SB(0, 0), b2, voffB); PG8_STAGE(PG8_SB(0, 1), b2 + hstep, voffB); PG8_STAGE(PG8_SA(0, 0), a2, voffA);
            PG8_WAIT_V(8); PG8_WAIT_L(0); PG8_BAR; PG8_MMA(1, 0, At, B0); PG8_MMA(1, 1, At, B1); PG8_BAR; PG8_SCHED;
            PG8_LDB(B0, 1, 0); PG8_LDB(B1, 1, 1); PG8_SCHED; PG8_LDA(At, 1, 0); PG8_STAGE(PG8_SA(0, 1), a2 + hstep, voffA);
            PG8_WAIT_V(8); PG8_WAIT_L(0); PG8_BAR; PG8_MMA(0, 0, At, B0); PG8_MMA(0, 1, At, B1); PG8_BAR; PG8_SCHED;
            PG8_LDA(At, 1, 1); PG8_STAGE(PG8_SB(1, 0), b3, voffB); PG8_STAGE(PG8_SB(1, 1), b3 + hstep, voffB); PG8_STAGE(PG8_SA(1, 0), a3, voffA);
            PG8_WAIT_V(8); PG8_WAIT_L(0); PG8_BAR; PG8_MMA(1, 0, At, B0); PG8_MMA(1, 1, At, B1); PG8_BAR; PG8_SCHED;
            } else {
            PG8_LDB(B0, 0, 0); PG8_SCHED; PG8_LDA(At, 0, 0); PG8_STAGE(PG8_SA(1, 1), a1 + hstep, voffA);
            PG8_WAIT_L(8); PG8_BAR; PG8_WAIT_L(0); PG8_MMA(0, 0, At, B0); PG8_BAR; PG8_SCHED;
            PG8_LDB(B1, 0, 1); PG8_STAGE(PG8_SB(0, 0), b2, voffB);
            PG8_BAR; PG8_WAIT_L(0); PG8_MMA(0, 1, At, B1); PG8_BAR;
            PG8_LDA(At, 0, 1); PG8_STAGE(PG8_SA(0, 0), a2, voffA);
            PG8_BAR; PG8_WAIT_L(0); PG8_MMA(1, 0, At, B0); PG8_BAR; PG8_SCHED;
            PG8_STAGE(PG8_SB(0, 1), b2 + hstep, voffB);
            PG8_WAIT_V(6); PG8_BAR; PG8_MMA(1, 1, At, B1); PG8_BAR;
            PG8_LDB(B0, 1, 0); PG8_SCHED; PG8_LDA(At, 1, 0); PG8_STAGE(PG8_SA(0, 1), a2 + hstep, voffA);
            PG8_WAIT_L(8); PG8_BAR; PG8_WAIT_L(0); PG8_MMA(0, 0, At, B0); PG8_BAR; PG8_SCHED;
            PG8_LDB(B1, 1, 1); PG8_STAGE(PG8_SB(1, 0), b3, voffB);
            PG8_BAR; PG8_WAIT_L(0); PG8_MMA(0, 1, At, B1); PG8_BAR;
            PG8_LDA(At, 1, 1); PG8_STAGE(PG8_SA(1, 0), a3, voffA);
            PG8_BAR; PG8_WAIT_L(0); PG8_MMA(1, 0, At, B0); PG8_BAR; PG8_SCHED;
            PG8_STAGE(PG8_SB(1, 1), b3 + hstep, voffB);
            PG8_WAIT_V(6); PG8_BAR; PG8_MMA(1, 1, At, B1); PG8_BAR;
            }
        }
        if constexpr (ALIGN_EPI) { if (wr == 0) PG8_BAR; }
        if constexpr (!Epi::AFTER_DRAIN) { E(acc, cur, wr, wc, fr, fq); S.done(cur); }
        if (!has_next) break;
#pragma unroll
        for (int a = 0; a < 2; ++a)
#pragma unroll
            for (int b = 0; b < 2; ++b)
#pragma unroll
                for (int m = 0; m < 4; ++m)
#pragma unroll
                    for (int n = 0; n < 2; ++n) acc[a][b][m][n] = (f32x4){0.f, 0.f, 0.f, 0.f};
        cur = nxt; cA = nA; cB = nB; ++ui;
        if constexpr (ALIGN_EPI) { if (wr == 1) PG8_BAR; }
    }
    PG8_WAIT_V(0);
    if constexpr (!ALIGN_EPI) { if (wr == 0) PG8_BAR; }
    PG8_BAR;
    if constexpr (Epi::AFTER_DRAIN) { E.fused(acc, cur, wr, wc, fr, fq, lds, wid, lane); S.done(cur); }
#undef PG8_SA
#undef PG8_SB
#undef PG8_STAGE
#undef PG8_LDA
#undef PG8_LDB
#undef PG8_MMA
#undef PG8_WAIT_V
#undef PG8_WAIT_L
#undef PG8_BAR
#undef PG8_SCHED
}
}
#define LAS __attribute__((address_space(3)))
typedef unsigned short bf16;
typedef unsigned v4u __attribute__((ext_vector_type(4)));
typedef unsigned v2u __attribute__((ext_vector_type(2)));
typedef float f32x4 __attribute__((ext_vector_type(4)));
typedef short bf16x8 __attribute__((ext_vector_type(8)));
constexpr int DM = 1024, SEQ = 2048, MP = 16384, NS = 128, MV = MP + NS, MPAD = 16640;
constexpr int DQKV = 3072, INCOLS = 10256, NIN = 10240;
constexpr float EPS = 1e-6f;
constexpr size_t KiB = 1024, MiB = 1u << 20;
constexpr size_t WS_CTL = 0, CTL_BYTES = 64 * KiB;
constexpr size_t WS_MOD = 64 * KiB;
constexpr size_t WS_BA = 2 * MiB;
constexpr size_t WS_GL = 3 * MiB + 256 * KiB;
constexpr size_t WS_WA = 3 * MiB + 512 * KiB, WS_WB = WS_WA + 2 * MiB, WS_WO = WS_WB + 2 * MiB, WS_WIN = WS_WO + 2 * MiB;
constexpr size_t WS_BUF = WS_WIN + 20 * MiB;
constexpr size_t BUF_BYTES = (size_t)MV * 1024 * 2;
constexpr size_t WS_END = WS_BUF + 7 * BUF_BYTES + 512 * KiB;
static_assert(WS_END <= 256 * MiB, "ws map");
constexpr size_t O_YP = 0, O_YS = 16777216, O_NCAP = O_YS + 131072, O_NCQP = O_NCAP + 16384, O_NDP = O_NCQP + 73728,
                 O_NCAS = O_NDP + 1048576, O_NCQS = O_NCAS + 262144, O_NDS = O_NCQS + 1179648, O_END = O_NDS + 16777216;
constexpr int CW_BAR = 4096;
constexpr int LDS_BYTES = 163840, MISC_OFF = LDS_BYTES - 64;

typedef float f32x2v __attribute__((ext_vector_type(2)));
typedef __bf16 bf16x2v __attribute__((ext_vector_type(2)));
__device__ __forceinline__ unsigned pkbf(float lo, float hi) { return pg8::cvt_pk_bf16(lo, hi); }
__device__ __forceinline__ unsigned pk2(float lo, float hi) { const f32x2v v = {lo, hi}; return __builtin_bit_cast(unsigned, __builtin_convertvector(v, bf16x2v)); }
__device__ __forceinline__ float bflo(unsigned u) { return __uint_as_float(u << 16); }
__device__ __forceinline__ float bfhi(unsigned u) { return __uint_as_float(u & 0xffff0000u); }
__device__ __forceinline__ float bf1(unsigned short b) { return __uint_as_float((unsigned)b << 16); }
__device__ __forceinline__ unsigned short f2bf1(float f) { return (unsigned short)(pkbf(f, 0.f) & 0xffffu); }
__device__ __forceinline__ float sigm(float x) { return __builtin_amdgcn_rcpf(1.f + __expf(-x)); }
__device__ __forceinline__ float silu(float x) { return x * sigm(x); }
__device__ __forceinline__ f32x4 silu4(f32x4 v) { return (f32x4){silu(v[0]), silu(v[1]), silu(v[2]), silu(v[3])}; }
__device__ __forceinline__ f32x4 sigm4(f32x4 v) { return (f32x4){sigm(v[0]), sigm(v[1]), sigm(v[2]), sigm(v[3])}; }
__device__ __forceinline__ void unpack8(v4u u, float* f) { f[0] = bflo(u.x); f[1] = bfhi(u.x); f[2] = bflo(u.y); f[3] = bfhi(u.y); f[4] = bflo(u.z); f[5] = bfhi(u.z); f[6] = bflo(u.w); f[7] = bfhi(u.w); }
__device__ __forceinline__ v4u pack8(const float* f) { v4u o; o.x = pkbf(f[0], f[1]); o.y = pkbf(f[2], f[3]); o.z = pkbf(f[4], f[5]); o.w = pkbf(f[6], f[7]); return o; }
__device__ __forceinline__ v2u pack4(f32x4 v) { v2u o; o.x = pkbf(v[0], v[1]); o.y = pkbf(v[2], v[3]); return o; }
__device__ __forceinline__ float dpp_row_shr(float v, int n) {
    const int iv = __builtin_bit_cast(int, v); int r;
    switch (n) { case 1: r = __builtin_amdgcn_update_dpp(0, iv, 0x111, 0xf, 0xf, true); break; case 2: r = __builtin_amdgcn_update_dpp(0, iv, 0x112, 0xf, 0xf, true); break;
                 case 4: r = __builtin_amdgcn_update_dpp(0, iv, 0x114, 0xf, 0xf, true); break; default: r = __builtin_amdgcn_update_dpp(0, iv, 0x118, 0xf, 0xf, true); break; }
    return __builtin_bit_cast(float, r);
}
__device__ __forceinline__ float wave_sum(float v) {
    v += dpp_row_shr(v, 1); v += dpp_row_shr(v, 2); v += dpp_row_shr(v, 4); v += dpp_row_shr(v, 8);
    v += __builtin_bit_cast(float, __builtin_amdgcn_update_dpp(0, __builtin_bit_cast(int, v), 0x142, 0xa, 0xf, false));
    v += __builtin_bit_cast(float, __builtin_amdgcn_update_dpp(0, __builtin_bit_cast(int, v), 0x143, 0xc, 0xf, false));
    return __uint_as_float(__builtin_amdgcn_readlane(__float_as_uint(v), 63));
}
__device__ __forceinline__ float row16_sum(float v) {
    v += __builtin_bit_cast(float, __builtin_amdgcn_update_dpp(0, __builtin_bit_cast(int, v), 0xB1, 0xf, 0xf, false));
    v += __builtin_bit_cast(float, __builtin_amdgcn_update_dpp(0, __builtin_bit_cast(int, v), 0x4E, 0xf, 0xf, false));
    v += __builtin_bit_cast(float, __builtin_amdgcn_update_dpp(0, __builtin_bit_cast(int, v), 0x141, 0xf, 0xf, false));
    v += __builtin_bit_cast(float, __builtin_amdgcn_update_dpp(0, __builtin_bit_cast(int, v), 0x140, 0xf, 0xf, false));
    return v;
}
#define LDS_WAIT() asm volatile("s_waitcnt lgkmcnt(0)" ::: "memory")

struct EpiIn {
    static constexpr bool PERM = true, AFTER_DRAIN = false;
    bf16 *U, *GA, *QKV, *ZB, *SGA, *SGB, *UH;
    __device__ __forceinline__ void operator()(const f32x4 (&acc)[2][2][4][2], const pg8::Unit& u, int wr, int wc, int fr, int fq) const {
        const int row0 = u.pm * 256 + wr * 64 + fr, cl = wc * 32 + 8 * fq, pn = u.pn;
        if (pn < 16) {
            bf16* base = (pn < 8 ? U : GA) + 128 * (pn & 7) + cl;
#pragma unroll
            for (int ai = 0; ai < 2; ++ai)
#pragma unroll
                for (int m = 0; m < 4; ++m) {
                    const int row = row0 + ai * 128 + m * 16;
                    if (row < MV) {
                        f32x4 a0 = acc[ai][0][m][0], a1 = acc[ai][0][m][1], b0 = acc[ai][1][m][0], b1 = acc[ai][1][m][1];
                        if (pn >= 8) { b0 = silu4(b0); b1 = silu4(b1); }
                        a0 = a0 * b0; a1 = a1 * b1;
                        v4u w; w.x = pkbf(a0[0], a0[1]); w.y = pkbf(a0[2], a0[3]); w.z = pkbf(a1[0], a1[1]); w.w = pkbf(a1[2], a1[3]);
                        *(v4u*)(base + (size_t)row * 1024) = w;
                        if (pn < 8 && (row & 7) >= 6 && row < MP) *(v4u*)(UH + ((size_t)(row >> 3) * 2 + ((row & 7) - 6)) * 1024 + 128 * (pn & 7) + cl) = w;
                    }
                }
        } else {
            bf16* base; int ldc, act;
            if (pn < 28) { base = QKV + 256 * (pn - 16); ldc = 3072; act = 0; }
            else if (pn < 32) { base = ZB + 256 * (pn - 28); ldc = 1024; act = 1; }
            else if (pn < 36) { base = SGA + 256 * (pn - 32); ldc = 1024; act = 2; }
            else { base = SGB + 256 * (pn - 36); ldc = 1024; act = 2; }
            base += cl;
#pragma unroll
            for (int ai = 0; ai < 2; ++ai)
#pragma unroll
                for (int m = 0; m < 4; ++m) {
                    const int row = row0 + ai * 128 + m * 16;
                    if (row < MV) {
#pragma unroll
                        for (int bj = 0; bj < 2; ++bj) {
                            f32x4 v0 = acc[ai][bj][m][0], v1 = acc[ai][bj][m][1];
                            if (act == 1) { v0 = silu4(v0); v1 = silu4(v1); } else if (act == 2) { v0 = sigm4(v0); v1 = sigm4(v1); }
                            v4u w; w.x = pkbf(v0[0], v0[1]); w.y = pkbf(v0[2], v0[3]); w.z = pkbf(v1[0], v1[1]); w.w = pkbf(v1[2], v1[3]);
                            *(v4u*)(base + (size_t)row * ldc + bj * 128) = w;
                        }
                    }
                }
        }
    }
};
template <class F> struct EpiEl {
    static constexpr bool PERM = true, AFTER_DRAIN = false;
    F f;
    __device__ __forceinline__ void operator()(const f32x4 (&acc)[2][2][4][2], const pg8::Unit& u, int wr, int wc, int fr, int fq) const {
        const int row0 = u.pm * 256 + wr * 64 + fr, col0 = u.pn * 256 + wc * 32 + 8 * fq;
#pragma unroll
        for (int ai = 0; ai < 2; ++ai) {
            typename F::Ops ops[4][2];
#pragma unroll
            for (int m = 0; m < 4; ++m)
#pragma unroll
                for (int bj = 0; bj < 2; ++bj) ops[m][bj] = f.load8(row0 + ai * 128 + m * 16, col0 + bj * 128);
#pragma unroll
            for (int m = 0; m < 4; ++m)
#pragma unroll
                for (int bj = 0; bj < 2; ++bj) f.store8(row0 + ai * 128 + m * 16, col0 + bj * 128, acc[ai][bj][m][0], acc[ai][bj][m][1], ops[m][bj]);
        }
    }
};
struct FOutA { const bf16* SG; bf16* TMP;
    struct Ops { v4u sg; };
    __device__ __forceinline__ Ops load8(int row, int col) const { Ops o; o.sg = *(const v4u*)(SG + (size_t)row * 1024 + col); return o; }
    __device__ __forceinline__ void store8(int row, int col, f32x4 v0, f32x4 v1, const Ops& p) const { float sg[8]; unpack8(p.sg, sg);
        const float r[8] = {sg[0] * v0[0], sg[1] * v0[1], sg[2] * v0[2], sg[3] * v0[3], sg[4] * v1[0], sg[5] * v1[1], sg[6] * v1[2], sg[7] * v1[3]}; *(v4u*)(TMP + (size_t)row * 1024 + col) = pack8(r); }
    __device__ __forceinline__ void operator()(int row, int col, f32x4 v) const { const size_t o = (size_t)row * 1024 + col; const v2u s = *(const v2u*)(SG + o);
        f32x4 r = {bflo(s.x) * v[0], bfhi(s.x) * v[1], bflo(s.y) * v[2], bfhi(s.y) * v[3]}; *(v2u*)(TMP + o) = pack4(r); } };
struct FOutB { const bf16* SG; const bf16* TIN; bf16* TMP;
    struct Ops { v4u sg, t; };
    __device__ __forceinline__ Ops load8(int row, int col) const { Ops o; o.sg = *(const v4u*)(SG + (size_t)row * 1024 + col); o.t = *(const v4u*)(TIN + (size_t)row * 1024 + col); return o; }
    __device__ __forceinline__ void store8(int row, int col, f32x4 v0, f32x4 v1, const Ops& p) const { float sg[8], t[8]; unpack8(p.sg, sg); unpack8(p.t, t);
        const float r[8] = {t[0] + sg[0] * v0[0], t[1] + sg[1] * v0[1], t[2] + sg[2] * v0[2], t[3] + sg[3] * v0[3], t[4] + sg[4] * v1[0], t[5] + sg[5] * v1[1], t[6] + sg[6] * v1[2], t[7] + sg[7] * v1[3]}; *(v4u*)(TMP + (size_t)row * 1024 + col) = pack8(r); }
    __device__ __forceinline__ void operator()(int row, int col, f32x4 v) const { const size_t o = (size_t)row * 1024 + col; const v2u s = *(const v2u*)(SG + o); const v2u t = *(const v2u*)(TIN + o);
        f32x4 r = {bflo(t.x) + bflo(s.x) * v[0], bfhi(t.x) + bfhi(s.x) * v[1], bflo(t.y) + bflo(s.y) * v[2], bfhi(t.y) + bfhi(s.y) * v[3]}; *(v2u*)(TMP + o) = pack4(r); } };
struct FPlain { bf16* T;
    struct Ops { int dummy; };
    __device__ __forceinline__ Ops load8(int, int) const { return Ops{0}; }
    __device__ __forceinline__ void store8(int row, int col, f32x4 v0, f32x4 v1, const Ops&) const { const float r[8] = {v0[0], v0[1], v0[2], v0[3], v1[0], v1[1], v1[2], v1[3]}; *(v4u*)(T + (size_t)row * 1024 + col) = pack8(r); }
    __device__ __forceinline__ void operator()(int row, int col, f32x4 v) const { *(v2u*)(T + (size_t)row * 1024 + col) = pack4(v); } };


template <class F> __device__ __forceinline__ void small_gemm_wg(LAS unsigned char* L, const bf16* A, const bf16* Bt, int rowbase, const F& f, int wg, int nwg, int tid) {
    const int lane = tid & 63, w = tid >> 6;
    LAS f32x4* part = (LAS f32x4*)L;
    for (int tile = wg; tile < 512; tile += nwg) {
        const int rt = tile & 7, ct = tile >> 3;
        const bf16* ap = A + (size_t)(rowbase + rt * 16 + (lane & 15)) * 1024 + 8 * (lane >> 4) + 128 * w;
        const bf16* bp = Bt + (size_t)(ct * 16 + (lane & 15)) * 1024 + 8 * (lane >> 4) + 128 * w;
        bf16x8 a[4], b[4];
#pragma unroll
        for (int s = 0; s < 4; ++s) { a[s] = *(const bf16x8*)(ap + 32 * s); b[s] = *(const bf16x8*)(bp + 32 * s); }
        f32x4 acc = {0.f, 0.f, 0.f, 0.f};
#pragma unroll
        for (int s = 0; s < 4; ++s) acc = __builtin_amdgcn_mfma_f32_16x16x32_bf16(b[s], a[s], acc, 0, 0, 0);
        part[w * 64 + lane] = acc;
        __syncthreads();
        if (w == 0) { f32x4 t = part[lane];
#pragma unroll
            for (int ww = 1; ww < 8; ++ww) t += part[ww * 64 + lane];
            f(rowbase + rt * 16 + (lane & 15), ct * 16 + 4 * (lane >> 4), t); }
        __syncthreads();
    }
}
template <class F> __device__ __forceinline__ void small_gemm(const bf16* A, const bf16* Bt, int rowbase, const F& f, int gw, int NGW, int lane) {
    for (int task = gw; task < 512; task += NGW) {
        const int rt = task & 7, ct = task >> 3;
        const bf16* ap = A + (size_t)(rowbase + rt * 16 + (lane & 15)) * 1024 + 8 * (lane >> 4);
        const bf16* bp = Bt + (size_t)(ct * 16 + (lane & 15)) * 1024 + 8 * (lane >> 4);
        f32x4 acc = {0.f, 0.f, 0.f, 0.f};
#pragma unroll 8
        for (int s = 0; s < 32; ++s) { const bf16x8 a = *(const bf16x8*)(ap + 32 * s), b = *(const bf16x8*)(bp + 32 * s); acc = __builtin_amdgcn_mfma_f32_16x16x32_bf16(b, a, acc, 0, 0, 0); }
        f(rowbase + rt * 16 + (lane & 15), ct * 16 + 4 * (lane >> 4), acc);
    }
}
#define XB_TMO      128
#define XB_XCNT(j)  (256  + 64 * (j))
#define XB_XSUB(j)  (1280 + 64 * (j))
#define XB_XGEN(j)  (2304 + 64 * (j))
#define XB_TOP      3328
#define XB_TOPGEN   3392
#define XCD_BAR_WORDS 3456
#define XB_SPIN_CAP (1u << 18)

__device__ __forceinline__ unsigned xb_ld(unsigned* p)              { return __hip_atomic_load(p, __ATOMIC_RELAXED, __HIP_MEMORY_SCOPE_AGENT); }
__device__ __forceinline__ unsigned xb_add(unsigned* p, unsigned v) { return __hip_atomic_fetch_add(p, v, __ATOMIC_RELAXED, __HIP_MEMORY_SCOPE_AGENT); }
__device__ __forceinline__ unsigned xb_xcc_id() { return (unsigned)__builtin_amdgcn_s_getreg((3 << 11) | 20) & 0xFu; }
#define XB_SPIN(cond, bar) do { unsigned _sp = 0; while (cond) { __builtin_amdgcn_s_sleep(1); \
    if ((++_sp & 255u) == 0u) { if (xb_ld(&(bar)[XB_TMO])) break; if (_sp > XB_SPIN_CAP) { atomicAdd(&(bar)[XB_TMO], 1u); break; } } } } while (0)

struct XcdBarrier {
    unsigned* bar; unsigned x;
    volatile LAS unsigned* st;
};

__device__ __forceinline__ XcdBarrier xcd_barrier_post(unsigned* bar, volatile LAS unsigned* st) {
    XcdBarrier b; b.bar = bar; b.x = xb_xcc_id(); b.st = st;
    if (threadIdx.x == 0) (void)xb_add(&bar[XB_XCNT(b.x)], 1u);
    return b;
}
__device__ __forceinline__ void xcd_barrier_complete(unsigned* bar, unsigned x, unsigned& nloc, unsigned& nx) {
    const unsigned G = gridDim.x * gridDim.y * gridDim.z;
    unsigned sum, cnt, mine, sp = 0u;
    for (;;) {
        sum = 0u; cnt = 0u; mine = 0u;
#pragma unroll
        for (unsigned j = 0; j < 16; ++j) { const unsigned c = xb_ld(&bar[XB_XCNT(j)]); sum += c; cnt += (c > 0u) ? 1u : 0u; mine = (j == x) ? c : mine; }
        if (sum == G) break;
        __builtin_amdgcn_s_sleep(1);
        if ((++sp & 255u) == 0u) { if (xb_ld(&bar[XB_TMO])) break; if (sp > XB_SPIN_CAP) { atomicAdd(&bar[XB_TMO], 1u); break; } }
    }
    nloc = mine > 0u ? mine : 1u; nx = cnt > 0u ? cnt : 1u;
}

__device__ __forceinline__ void xcd_barrier(const XcdBarrier& b) {
    asm volatile("s_waitcnt vmcnt(0)" ::: "memory");
    __syncthreads();
    if (threadIdx.x == 0) {
        unsigned* bar = b.bar;
        __builtin_amdgcn_s_waitcnt(0);
        unsigned nloc = b.st[0], nx = b.st[1];
        if (nloc == 0u) { xcd_barrier_complete(bar, b.x, nloc, nx); b.st[0] = nloc; b.st[1] = nx; }
        const unsigned old = xb_add(&bar[XB_XSUB(b.x)], 1u);
        const unsigned gen = old / nloc;
        if (old + 1u == (gen + 1u) * nloc) {
            __builtin_amdgcn_fence(__ATOMIC_RELEASE, "agent");
            asm volatile("s_waitcnt vmcnt(0)" ::: "memory");
            const unsigned og = xb_add(&bar[XB_TOP], 1u);
            const unsigned tg = og / nx;
            if (og + 1u == (tg + 1u) * nx) xb_add(&bar[XB_TOPGEN], 1u);
            else XB_SPIN(xb_ld(&bar[XB_TOPGEN]) == tg, bar);
            __builtin_amdgcn_fence(__ATOMIC_ACQUIRE, "agent");
            xb_add(&bar[XB_XGEN(b.x)], 1u);
            asm volatile("s_waitcnt vmcnt(0)" ::: "memory");
        } else {
            XB_SPIN(xb_ld(&bar[XB_XGEN(b.x)]) == gen, bar);
            __builtin_amdgcn_fence(__ATOMIC_ACQUIRE, "agent");
            asm volatile("s_waitcnt vmcnt(0)" ::: "memory");
        }
    }
    __syncthreads();
}
__device__ __forceinline__ void p0_transpose_item(const float* W, int ldw, int srccol0, int k0, bf16* WT, int K, int dstrow0, LAS float* scr, int lane) {
    float tv[32];
#pragma unroll
    for (int i = 0; i < 32; ++i) tv[i] = __builtin_nontemporal_load(W + (size_t)(k0 + 2 * i + (lane >> 5)) * ldw + srccol0 + (lane & 31));
#pragma unroll
    for (int i = 0; i < 32; ++i) scr[(2 * i + (lane >> 5)) * 33 + (lane & 31)] = tv[i];
    LDS_WAIT();
    const int c = lane & 7;
#pragma unroll
    for (int j = 0; j < 4; ++j) { const int n = (lane >> 3) + 8 * j; const LAS float* s = scr + (8 * c) * 33 + n;
        v4u o; o.x = pkbf(s[0 * 33], s[1 * 33]); o.y = pkbf(s[2 * 33], s[3 * 33]); o.z = pkbf(s[4 * 33], s[5 * 33]); o.w = pkbf(s[6 * 33], s[7 * 33]);
        *(v4u*)(WT + (size_t)(dstrow0 + n) * K + k0 + 8 * c) = o; }
    LDS_WAIT();
}
__device__ __forceinline__ int win_src_col(int n0) {
    if (n0 < 4096) { const int t = n0 >> 8, half = (n0 >> 7) & 1, ch = 128 * (t & 7) + (n0 & 127); const int blk = (t < 8) ? half : 2 + half; return blk * 1024 + ch; }
    if (n0 < 8192) return n0;
    return n0 + 16;
}
__device__ __forceinline__ void p0_mod_task(const float* cp, const float* cs, const float* ada_w, const float* ada_b, float* MOD, LAS float* sc, int task, int lane) {
    const int cgi = task % 48, rgi = task / 48, col = cgi * 64 + lane, r0 = rgi * 17;
    float acc[17];
#pragma unroll
    for (int r = 0; r < 17; ++r) acc[r] = 0.f;
    for (int k0 = 0; k0 < 1024; k0 += 128) {
        for (int i = 0; i < 34; ++i) { const int idx = i * 64 + lane, r = idx >> 7, kk = idx & 127, rr = r0 + r;
            const float* crow = rr < 8 ? cp + rr * 1024 : cs + (rr - 8) * 1024; const float v = crow[k0 + kk]; sc[idx] = silu(v); }
        LDS_WAIT();
        for (int kk = 0; kk < 128; kk += 4) {
            const float* wp = ada_w + (size_t)(k0 + kk) * 3072 + col;
            const float w0 = wp[0], w1 = wp[3072], w2 = wp[2 * 3072], w3 = wp[3 * 3072];
#pragma unroll
            for (int r = 0; r < 17; ++r) { const f32x4 c4 = *(const LAS f32x4*)(sc + r * 128 + kk); acc[r] += (c4[0] * w0 + c4[1] * w1) + (c4[2] * w2 + c4[3] * w3); }
        }
        LDS_WAIT();
    }
    const float bb = ada_b[col];
#pragma unroll
    for (int r = 0; r < 17; ++r) MOD[(size_t)(r0 + r) * 3072 + col] = acc[r] + bb;
}

__device__ __forceinline__ void phase_mod(const float* const* in, unsigned char* ws, int gwave, int nwaves, int lane) {
    const float* cp = in[2]; const float* cs = in[3]; const float* ada_w = in[7]; const float* ada_b = in[8]; float* MOD = (float*)(ws + WS_MOD);
    const int g = lane >> 4, col = lane & 15;
    for (int task = gwave; task < 576; task += nwaves) {
        const int nt = task % 192, mg = task / 192;
        f32x4 acc[3]; const float* arow[3]; bool av[3];
#pragma unroll
        for (int t = 0; t < 3; ++t) { acc[t] = (f32x4){0.f, 0.f, 0.f, 0.f}; const int row = 48 * mg + 16 * t + col; av[t] = row < 136; const int rr = av[t] ? row : 0; arow[t] = rr < 8 ? cp + rr * 1024 : cs + (rr - 8) * 1024; }
#pragma unroll 2
        for (int s = 0; s < 32; ++s) {
            const int k = 32 * s + 8 * g; float wv[8];
#pragma unroll
            for (int j = 0; j < 8; ++j) wv[j] = ada_w[(size_t)(k + j) * 3072 + 16 * nt + col];
            v4u bt; bt.x = pk2(wv[0], wv[1]); bt.y = pk2(wv[2], wv[3]); bt.z = pk2(wv[4], wv[5]); bt.w = pk2(wv[6], wv[7]);
            const bf16x8 bfrag = __builtin_bit_cast(bf16x8, bt);
#pragma unroll
            for (int t = 0; t < 3; ++t) { f32x4 a0 = *(const f32x4*)(arow[t] + k), a1 = *(const f32x4*)(arow[t] + k + 4);
                a0 = silu4(a0); a1 = silu4(a1); if (!av[t]) { a0 = (f32x4){0.f, 0.f, 0.f, 0.f}; a1 = a0; }
                v4u at; at.x = pk2(a0[0], a0[1]); at.y = pk2(a0[2], a0[3]); at.z = pk2(a1[0], a1[1]); at.w = pk2(a1[2], a1[3]);
                acc[t] = __builtin_amdgcn_mfma_f32_16x16x32_bf16(__builtin_bit_cast(bf16x8, at), bfrag, acc[t], 0, 0, 0); }
        }
        const float bb = ada_b[16 * nt + col];
#pragma unroll
        for (int t = 0; t < 3; ++t)
#pragma unroll
            for (int r = 0; r < 4; ++r) { const int row = 48 * mg + 16 * t + 4 * g + r; if (row < 136) MOD[(size_t)row * 3072 + 16 * nt + col] = acc[t][r] + bb; }
    }
}
__device__ __forceinline__ void phase0(LAS unsigned char* L, const float* const* in, unsigned char* ws, int vcu, int G, int tid) {
    const int lane = tid & 63, wave = __builtin_amdgcn_readfirstlane(tid >> 6);
    LAS float* scr = (LAS float*)(L + wave * 16384);
    const int ntask_w2 = 576 - 2 * G;
    if (wave < 2 || (wave == 2 && vcu < ntask_w2)) return;
    const int gw = (wave >= 3) ? (wave - 3) * G + vcu : 5 * G + (vcu - ntask_w2), NGW = 5 * G + (G - ntask_w2);
    constexpr int I_IN = 16 * 320, I_SQ = 16 * 32;
    for (int it = gw; it < I_IN + 3 * I_SQ; it += NGW) {
        int r = it;
        if (r < I_IN) { const int kb = r / 320, nb = r % 320; p0_transpose_item(in[10], INCOLS, win_src_col(nb * 32), kb * 64, (bf16*)(ws + WS_WIN), 1024, nb * 32, scr, lane); continue; }
        r -= I_IN; const int which = r / I_SQ; r -= which * I_SQ; const int kb = r / 32, nb = r % 32;
        const float* W = which == 0 ? in[16] : (which == 1 ? in[17] : in[18]);
        bf16* WT = (bf16*)(ws + (which == 0 ? WS_WA : (which == 1 ? WS_WB : WS_WO)));
        p0_transpose_item(W, 1024, nb * 32, kb * 64, WT, 1024, nb * 32, scr, lane);
    }
}
__device__ __forceinline__ void phase1(LAS unsigned char* L, const float* const* in, unsigned char* ws, int vcu, int G, int tid) {
    const int lane = tid & 63, wave = tid >> 6;
    LAS float* wba = (LAS float*)L;
    const float* w_in = in[10];
    {
        f32x4 wv[8];
#pragma unroll
        for (int i = 0; i < 8; ++i) { const int idx = tid + 512 * i, k = idx >> 2, q = idx & 3; wv[i] = *(const f32x4*)(w_in + (size_t)k * INCOLS + 8192 + 4 * q); }
#pragma unroll
        for (int i = 0; i < 8; ++i) { const int idx = tid + 512 * i, k = idx >> 2, q = idx & 3;
#pragma unroll
            for (int e = 0; e < 4; ++e) wba[(4 * q + e) * 1024 + k] = wv[i][e]; }
    }
    __syncthreads();
    const float* MOD = (const float*)(ws + WS_MOD); float* BA = (float*)(ws + WS_BA); bf16* H = (bf16*)(ws + WS_BUF);
    const float* npre = in[9];
    float alog = 0.f, dtb = 0.f; if (lane >= 8 && lane < 16) { alog = in[13][lane - 8]; dtb = in[14][lane - 8]; }
    const int gw = vcu * 8 + wave, NGW = G * 8;
    f32x4 np[4];
#pragma unroll
    for (int j = 0; j < 4; ++j) np[j] = *(const f32x4*)(npre + 4 * lane + 256 * j);
    const int nblk = MP / 8;
    for (int blk = gw; blk < nblk + NS; blk += NGW) {
        const bool samp = blk >= nblk;
        const int m0 = samp ? MP + (blk - nblk) : blk * 8, nrow = samp ? 1 : 8;
        const int mr = samp ? 8 + (blk - nblk) : (m0 >> 11);
        const float* xr = samp ? in[1] + (size_t)(blk - nblk) * 1024 : in[0] + (size_t)m0 * 1024;
        f32x4 sh[4], sc[4], nx[4];
#pragma unroll
        for (int j = 0; j < 4; ++j) { const int k = 4 * lane + 256 * j; nx[j] = __builtin_nontemporal_load((const f32x4*)(xr + k)); sh[j] = *(const f32x4*)(MOD + (size_t)mr * 3072 + k); sc[j] = (*(const f32x4*)(MOD + (size_t)mr * 3072 + 1024 + k) + 1.f) * np[j]; }
        for (int r = 0; r < nrow; ++r) {
            const int m = m0 + r;
            f32x4 v[4]; float ss = 0.f;
#pragma unroll
            for (int j = 0; j < 4; ++j) { v[j] = nx[j]; ss += (v[j][0] * v[j][0] + v[j][1] * v[j][1]) + (v[j][2] * v[j][2] + v[j][3] * v[j][3]); }
            { const int rn = (r + 1 < nrow) ? r + 1 : r;
#pragma unroll
                for (int j = 0; j < 4; ++j) nx[j] = __builtin_nontemporal_load((const f32x4*)(xr + (size_t)rn * 1024 + 4 * lane + 256 * j)); }
            const float rstd = rsqrtf(wave_sum(ss) * (1.f / 1024.f) + EPS);
#pragma unroll
            for (int j = 0; j < 4; ++j) { const int k = 4 * lane + 256 * j; v[j] = v[j] * rstd * sc[j] + sh[j]; *(v2u*)(H + (size_t)m * 1024 + k) = pack4(v[j]); }
            float mine = 0.f;
#pragma unroll
            for (int c = 0; c < 16; ++c) { float p = 0.f;
#pragma unroll
                for (int j = 0; j < 4; ++j) { const f32x4 w4 = *(const LAS f32x4*)(wba + c * 1024 + 4 * lane + 256 * j); p += (v[j][0] * w4[0] + v[j][1] * w4[1]) + (v[j][2] * w4[2] + v[j][3] * w4[3]); }
                p = wave_sum(p); if (lane == c) mine = p; }
            if (lane < 8) BA[(size_t)m * 16 + lane] = sigm(mine);
            else if (lane < 16) { const float xx = mine + dtb; const float sp = fmaxf(xx, 0.f) + log1pf(__expf(-fabsf(xx))); BA[(size_t)m * 16 + lane] = -__expf(alog) * sp; }
        }
    }
}
__device__ __forceinline__ void branch_a_rest(const bf16* U, bf16* GA, const bf16* UH, const float* caw, int bx, int tid) {
    const bool dry = false; (void)dry;
    {
        const int cgp = tid & 127, col = cgp * 8, q = tid >> 7;
        float w0[8], w1[8], w2[8];
#pragma unroll
        for (int e = 0; e < 8; ++e) { w0[e] = caw[col + e]; w1[e] = caw[1024 + col + e]; w2[e] = caw[2048 + col + e]; }
        for (int kk = 0; kk < 4; ++kk) {
            const int kq = 1 + q + 2 * kk; if (kq > 7) break;
            const int i = bx + 256 * kq;
            const int r0 = i * 8; const bool zh = (r0 & 2047) == 0;
            float um2[8], um1[8];
            if (zh) {
#pragma unroll
                for (int e = 0; e < 8; ++e) { um2[e] = 0.f; um1[e] = 0.f; }
            } else { unpack8(*(const v4u*)(UH + ((size_t)(i - 1) * 2) * 1024 + col), um2); unpack8(*(const v4u*)(UH + ((size_t)(i - 1) * 2 + 1) * 1024 + col), um1); }
            v4u ur[8], gr[8];
#pragma unroll
            for (int r = 0; r < 8; ++r) { ur[r] = *(const v4u*)(U + (size_t)(r0 + r) * 1024 + col); gr[r] = *(const v4u*)(GA + (size_t)(r0 + r) * 1024 + col); }
#pragma unroll
            for (int r = 0; r < 8; ++r) { float uc[8], ga[8], o[8]; unpack8(ur[r], uc); unpack8(gr[r], ga);
#pragma unroll
                for (int e = 0; e < 8; ++e) { o[e] = ga[e] * (um2[e] * w0[e] + um1[e] * w1[e] + uc[e] * w2[e]); um2[e] = um1[e]; um1[e] = uc[e]; }
                *(v4u*)(GA + (size_t)(r0 + r) * 1024 + col) = pack8(o); }
        }
    }
}
__device__ __forceinline__ void phase3(const float* const* in, unsigned char* ws, float* out, int vcu, int G, int bx, int tid, bool dry = false) {
    const bf16* UH = (const bf16*)(out + O_NDS);
    const bf16* U = (const bf16*)(ws + WS_BUF + 1 * BUF_BYTES); bf16* GA = (bf16*)(ws + WS_BUF + 2 * BUF_BYTES); const bf16* QKV = (const bf16*)(ws + WS_BUF + 3 * BUF_BYTES);
    const float* caw = in[11];
    {
        const int cgp = tid & 127, col = cgp * 8, q = tid >> 7;
        float w0[8], w1[8], w2[8];
#pragma unroll
        for (int e = 0; e < 8; ++e) { w0[e] = caw[col + e]; w1[e] = caw[1024 + col + e]; w2[e] = caw[2048 + col + e]; }
        for (int kk = 0; kk < 1; ++kk) {
            const int i = bx; if (q != 0) break;
            const int r0 = i * 8; const bool zh = (r0 & 2047) == 0;
            float um2[8], um1[8];
            if (zh) {
#pragma unroll
                for (int e = 0; e < 8; ++e) { um2[e] = 0.f; um1[e] = 0.f; }
            } else { unpack8(*(const v4u*)(UH + ((size_t)(i - 1) * 2) * 1024 + col), um2); unpack8(*(const v4u*)(UH + ((size_t)(i - 1) * 2 + 1) * 1024 + col), um1); }
            v4u ur[8], gr[8];
#pragma unroll
            for (int r = 0; r < 8; ++r) { ur[r] = *(const v4u*)(U + (size_t)(r0 + r) * 1024 + col); gr[r] = *(const v4u*)(GA + (size_t)(r0 + r) * 1024 + col); }
#pragma unroll
            for (int r = 0; r < 8; ++r) { float uc[8], ga[8], o[8]; unpack8(ur[r], uc); unpack8(gr[r], ga);
#pragma unroll
                for (int e = 0; e < 8; ++e) { o[e] = ga[e] * (um2[e] * w0[e] + um1[e] * w1[e] + uc[e] * w2[e]); um2[e] = um1[e]; um1[e] = uc[e]; }
                *(v4u*)(GA + (size_t)(r0 + r) * 1024 + col) = pack8(o); }
        }
    }
    const int gt = vcu * 512 + tid, NT = G * 512;
    const float* sca = in[4]; const float* scq = in[5];
    for (int idx = gt; idx < 128 * 1024; idx += NT) {
        const int s = idx >> 10, ch = idx & 1023; const size_t ro = (size_t)(MP + s) * 1024 + ch;
        const float uc = bf1(U[ro]), ga = bf1(GA[ro]);
        const float s0 = sca[(size_t)(s * 2) * 1024 + ch], s1 = sca[(size_t)(s * 2 + 1) * 1024 + ch];
        const float o = ga * (s0 * caw[ch] + s1 * caw[1024 + ch] + uc * caw[2048 + ch]);
        out[O_NCAS + (size_t)(s * 2) * 1024 + ch] = s1; out[O_NCAS + (size_t)(s * 2 + 1) * 1024 + ch] = uc;
        if (!dry) GA[ro] = f2bf1(o);
    }
    for (int idx = gt; idx < 8 * 2 * 128; idx += NT) {
        const int col = (idx & 127) * 8, j = (idx >> 7) & 1, b = idx >> 8; float uc[8]; unpack8(*(const v4u*)(UH + ((size_t)(b * 256 + 255) * 2 + j) * 1024 + col), uc);
#pragma unroll
        for (int e = 0; e < 8; ++e) out[O_NCAP + (size_t)(b * 2 + j) * 1024 + col + e] = uc[e];
    }
}
__device__ __forceinline__ void phase3b(const float* const* in, unsigned char* ws, float* out, int gt, int NT) {
    const bf16* QKV = (const bf16*)(ws + WS_BUF + 3 * BUF_BYTES); const float* scq = in[5];
    for (int idx = gt; idx < 8 * 3 * 384; idx += NT) {
        const int cgq = idx % 384, j = (idx / 384) % 3, b = idx / 1152, col = cgq * 8; float uc[8]; unpack8(*(const v4u*)(QKV + (size_t)(b * 2048 + 2045 + j) * 3072 + col), uc);
#pragma unroll
        for (int e = 0; e < 8; ++e) out[O_NCQP + (size_t)(b * 3 + j) * 3072 + col + e] = uc[e];
    }
    for (int idx = gt; idx < 128 * 3 * 384; idx += NT) {
        const int cgq = idx % 384, j = (idx / 384) % 3, s = idx / 1152, col = cgq * 8; float uc[8];
        if (j < 2) {
#pragma unroll
            for (int e = 0; e < 8; ++e) uc[e] = scq[(size_t)(s * 3 + j + 1) * 3072 + col + e];
        } else unpack8(*(const v4u*)(QKV + (size_t)(MP + s) * 3072 + col), uc);
#pragma unroll
        for (int e = 0; e < 8; ++e) out[O_NCQS + (size_t)(s * 3 + j) * 3072 + col + e] = uc[e];
    }
}
__device__ __forceinline__ size_t qkv_gran(int t0, int h, int i) { const int row = i / 48, j = i - row * 48; return (size_t)(t0 + row) * 3072 + (j >> 4) * 1024 + h * 128 + (j & 15) * 8; }
__device__ __forceinline__ void stage_a(LAS unsigned char* L, int item, const bf16* QKV, const float* BA, const float* cbw,
                                        bf16* NW, bf16* QD, bf16* KDT, bf16* UD, bf16* AQK, float* GLv, int tid_in) {
    int tid = tid_in; asm volatile("" : "+v"(tid));
    const int lane = tid & 63, wid = tid >> 6;
    const int c = item & 31, h = (item >> 5) & 7, b = item >> 8, t0 = b * 2048 + c * 64;
    LAS float* sGC = (LAS float*)(L + 0); LAS float* sBETA = (LAS float*)(L + 256); LAS float* sEGC = (LAS float*)(L + 512); LAS float* sKDS = (LAS float*)(L + 768);
    LAS bf16* sQb = (LAS bf16*)(L + 1024);
    LAS bf16* sKb = (LAS bf16*)(L + 18432);
    LAS float* sRHS = (LAS float*)(L + 35840);
    LAS bf16* sKD = (LAS bf16*)(L + 101376);
    LAS float* sA = (LAS float*)(L + 118016);
    LAS bf16* sAQ = (LAS bf16*)(L + 134400);
    if (tid < 64) {
        const float g = BA[(size_t)(t0 + tid) * 16 + 8 + h], be = BA[(size_t)(t0 + tid) * 16 + h];
        float gc = g;
#pragma unroll
        for (int o = 1; o < 64; o <<= 1) { const float n = __shfl_up(gc, o); if (lane >= o) gc += n; }
        const float gl = __uint_as_float(__builtin_amdgcn_readlane(__float_as_uint(gc), 63));
        sGC[tid] = gc; sBETA[tid] = be; sEGC[tid] = __expf(gc); sKDS[tid] = __expf(gl - gc);
        if (tid == 0) GLv[item] = __expf(gl);
    }
    __syncthreads();
    if (tid < 384) {
        const int cg_ = tid % 48, strip = tid / 48, tensor = cg_ >> 4, c8 = (cg_ & 15) * 8;
        const int gcol = tensor * 1024 + h * 128 + c8, rl0 = strip * 8;
        float w[4][8];
#pragma unroll
        for (int j = 0; j < 4; ++j)
#pragma unroll
            for (int e = 0; e < 8; ++e) w[j][e] = cbw[j * 3072 + gcol + e];
        float xw[3][8];
#pragma unroll
        for (int j = 0; j < 3; ++j) { const int rr = rl0 - 3 + j;
            if (c > 0 || rr >= 0) unpack8(*(const v4u*)(QKV + (size_t)(t0 + rr) * 3072 + gcol), xw[j]);
            else {
#pragma unroll
                for (int e = 0; e < 8; ++e) xw[j][e] = 0.f; } }
        v4u rowv[8];
#pragma unroll
        for (int r = 0; r < 8; ++r) rowv[r] = *(const v4u*)(QKV + (size_t)(t0 + rl0 + r) * 3072 + gcol);
#pragma unroll
        for (int r = 0; r < 8; ++r) {
            const int tok = rl0 + r; float cur[8], y[8]; unpack8(rowv[r], cur);
            float ss = 0.f;
#pragma unroll
            for (int e = 0; e < 8; ++e) { y[e] = silu(w[0][e] * xw[0][e] + w[1][e] * xw[1][e] + w[2][e] * xw[2][e] + w[3][e] * cur[e]); ss += y[e] * y[e];
                xw[0][e] = xw[1][e]; xw[1][e] = xw[2][e]; xw[2][e] = cur[e]; }
            ss = row16_sum(ss);
            const float rstd = rsqrtf(ss + EPS);
            if (tensor == 0) {
                const float sc = rstd * 0.08838834764831845f, eg = sEGC[tok]; float qn[8], qd[8];
#pragma unroll
                for (int e = 0; e < 8; ++e) { qn[e] = y[e] * sc; qd[e] = qn[e] * eg; }
                *(LAS v4u*)(sQb + tok * 136 + c8) = pack8(qn);
                const int m = tok >> 4, s = c8 >> 5, jh = (c8 >> 4) & 1, g0 = (c8 & 15) >> 2;
                bf16* dst = QD + (size_t)item * 8192 + ((m * 4 + s) * 64 + 16 * g0 + (tok & 15)) * 8 + 4 * jh;
                v2u p0, p1; p0.x = pkbf(qd[0], qd[1]); p0.y = pkbf(qd[2], qd[3]); p1.x = pkbf(qd[4], qd[5]); p1.y = pkbf(qd[6], qd[7]);
                *(v2u*)dst = p0; *(v2u*)(dst + 16 * 8) = p1;
            } else if (tensor == 1) {
                const float be = sBETA[tok] * sEGC[tok], kd = sKDS[tok]; float kn[8], t8[8];
#pragma unroll
                for (int e = 0; e < 8; ++e) kn[e] = y[e] * rstd;
                *(LAS v4u*)(sKb + tok * 136 + c8) = pack8(kn);
#pragma unroll
                for (int e = 0; e < 8; ++e) t8[e] = kn[e] * be;
                *(LAS f32x4*)(sRHS + tok * 256 + 128 + c8) = (f32x4){t8[0], t8[1], t8[2], t8[3]}; *(LAS f32x4*)(sRHS + tok * 256 + 128 + c8 + 4) = (f32x4){t8[4], t8[5], t8[6], t8[7]};
                LAS unsigned* kdp = (LAS unsigned*)(sKD + tok * 130 + c8);
#pragma unroll
                for (int e = 0; e < 4; ++e) kdp[e] = pkbf(kn[2 * e] * kd, kn[2 * e + 1] * kd);
            } else {
                const float be = sBETA[tok];
                *(LAS f32x4*)(sRHS + tok * 256 + c8) = (f32x4){y[0] * be, y[1] * be, y[2] * be, y[3] * be}; *(LAS f32x4*)(sRHS + tok * 256 + c8 + 4) = (f32x4){y[4] * be, y[5] * be, y[6] * be, y[7] * be};
            }
        }
    }
    __syncthreads();
    {
        const int mat = wid >> 2, wr_ = wid & 3, fr = lane & 15, fq = lane >> 4;
        const LAS bf16* Am = mat ? sQb : sKb;
        f32x4 acc[4];
#pragma unroll
        for (int n = 0; n < 4; ++n) acc[n] = (f32x4){0.f, 0.f, 0.f, 0.f};
#pragma unroll
        for (int s = 0; s < 4; ++s) { const bf16x8 a = *(const LAS bf16x8*)(Am + (16 * wr_ + fr) * 136 + 32 * s + 8 * fq);
#pragma unroll
            for (int n = 0; n < 4; ++n) { const bf16x8 bb = *(const LAS bf16x8*)(sKb + (16 * n + fr) * 136 + 32 * s + 8 * fq); acc[n] = __builtin_amdgcn_mfma_f32_16x16x32_bf16(a, bb, acc[n], 0, 0, 0); } }
#pragma unroll
        for (int n = 0; n < 4; ++n)
#pragma unroll
            for (int r = 0; r < 4; ++r) { const int i = 16 * wr_ + 4 * fq + r, j = 16 * n + fr; const float d = acc[n][r], dec = __expf(sGC[i] - sGC[j]);
                if (mat == 0) sA[i * 64 + j] = (i > j) ? sBETA[i] * d * dec : 0.f;
                else { const float v = (i >= j) ? d * dec : 0.f; const int m = i >> 4, s2 = j >> 5, jj = 4 * ((j >> 4) & 1) + (j & 3), lp = 16 * ((j & 15) >> 2) + (i & 15);
                    sAQ[((m * 2 + s2) * 64 + lp) * 8 + jj] = f2bf1(v); } }
    }
    __syncthreads();
    float x[64];
    if (tid < 256) {
        int zoff; asm volatile("v_mov_b32 %0, 0" : "=v"(zoff));
#pragma unroll
        for (int i = 0; i < 64; ++i) x[i] = sRHS[i * 256 + tid];
#pragma unroll
        for (int i = 1; i < 64; ++i) {
#pragma unroll
            for (int jb = 0; jb < (i + 3) / 4; ++jb) { const f32x4 a4 = *(const LAS f32x4*)(sA + zoff + i * 64 + 4 * jb);
                x[i] -= a4[0] * x[4 * jb]; x[i] -= a4[1] * x[4 * jb + 1]; x[i] -= a4[2] * x[4 * jb + 2]; x[i] -= a4[3] * x[4 * jb + 3]; }
            if ((i & 1) == 1) asm volatile("" : "+v"(zoff), "+v"(x[i]));
        }
    } else {
        const int t2 = tid - 256;
#pragma unroll
        for (int q = 0; q < 4; ++q) { const int p = t2 + 256 * q, l = p & 63, fs = p >> 6, i = fs >> 1, s2 = fs & 1, dk = 16 * i + (l & 15), g = l >> 4; unsigned short v8[8];
#pragma unroll
            for (int j = 0; j < 8; ++j) { const int tok = 32 * s2 + 16 * (j >> 2) + 4 * g + (j & 3); v8[j] = sKD[tok * 130 + dk]; }
            v4u o; o.x = v8[0] | ((unsigned)v8[1] << 16); o.y = v8[2] | ((unsigned)v8[3] << 16); o.z = v8[4] | ((unsigned)v8[5] << 16); o.w = v8[6] | ((unsigned)v8[7] << 16);
            *(v4u*)(KDT + qkv_gran(t0, h, p)) = o; }
#pragma unroll
        for (int q = 0; q < 2; ++q) { const int p = t2 + 256 * q; *(v4u*)(AQK + (size_t)item * 4096 + p * 8) = *(const LAS v4u*)(sAQ + p * 8); }
    }
    __syncthreads();
    LAS bf16* stg = (LAS bf16*)sRHS;
    if (tid < 128) {
        const int dv = tid, w_ = dv >> 4;
#pragma unroll
        for (int m = 0; m < 4; ++m)
#pragma unroll
            for (int g = 0; g < 4; ++g) { v2u p; p.x = pkbf(x[16 * m + 4 * g], x[16 * m + 4 * g + 1]); p.y = pkbf(x[16 * m + 4 * g + 2], x[16 * m + 4 * g + 3]);
                { const int e = ((w_ * 4 + m) * 64 + 16 * g + (dv & 15)) * 4; *(v2u*)(UD + qkv_gran(t0, h, 1024 + (e >> 3)) + (e & 7)) = p; } }
    } else if (tid < 256) {
        const int dk = tid - 128, s = dk >> 5, jh = (dk >> 4) & 1, g = (dk & 15) >> 2, j = 4 * jh + (dk & 3);
#pragma unroll
        for (int tok = 0; tok < 64; ++tok) stg[(((tok >> 4) * 4 + s) * 64 + 16 * g + (tok & 15)) * 8 + j] = f2bf1(-x[tok]);
    }
    __syncthreads();
#pragma unroll
    for (int q = 0; q < 2; ++q) { const int p = tid + 512 * q; *(v4u*)(NW + (size_t)item * 8192 + p * 8) = *(const LAS v4u*)(stg + p * 8); }
    __syncthreads();
}

constexpr int SAP_SETB = 68608, SAP_A = 2 * SAP_SETB, SAP_AQ = SAP_A + 16384;
__device__ __forceinline__ void sap_scan(LAS unsigned char* S, int item, const float* BA, float* GLv, int lane) {
    const int c = item & 31, h = (item >> 5) & 7, b = item >> 8, t0 = b * 2048 + c * 64;
    LAS float* sGC = (LAS float*)S;
    const float g = BA[(size_t)(t0 + lane) * 16 + 8 + h], be = BA[(size_t)(t0 + lane) * 16 + h];
    float gc = g;
#pragma unroll
    for (int o = 1; o < 64; o <<= 1) { const float n = __shfl_up(gc, o); if (lane >= o) gc += n; }
    const float gl = __uint_as_float(__builtin_amdgcn_readlane(__float_as_uint(gc), 63));
    sGC[lane] = gc; sGC[64 + lane] = be; sGC[128 + lane] = __expf(gc); sGC[192 + lane] = __expf(gl - gc);
    if (lane == 0) GLv[item] = __expf(gl);
}
struct SapIn { float w[4][8]; float xw[3][8]; v4u rowv[13]; };
__device__ __forceinline__ void sap_conv_load(SapIn& I, int item, const bf16* QKV, const float* cbw, int ct) {
    const int c = item & 31, h = (item >> 5) & 7, b = item >> 8, t0 = b * 2048 + c * 64;
    const int cg_ = ct % 48, strip = ct / 48, tensor = cg_ >> 4, c8 = (cg_ & 15) * 8;
    const int gcol = tensor * 1024 + h * 128 + c8, rl0 = strip * 13, nr = (strip == 4) ? 12 : 13;
#pragma unroll
    for (int j = 0; j < 4; ++j)
#pragma unroll
        for (int e = 0; e < 8; ++e) I.w[j][e] = cbw[j * 3072 + gcol + e];
#pragma unroll
    for (int j = 0; j < 3; ++j) { const int rr = rl0 - 3 + j;
        if (c > 0 || rr >= 0) unpack8(*(const v4u*)(QKV + (size_t)(t0 + rr) * 3072 + gcol), I.xw[j]);
        else {
#pragma unroll
            for (int e = 0; e < 8; ++e) I.xw[j][e] = 0.f; } }
#pragma unroll
    for (int r = 0; r < 13; ++r) I.rowv[r] = __builtin_nontemporal_load((const v4u*)(QKV + (size_t)(t0 + (r < nr ? rl0 + r : rl0)) * 3072 + gcol));
}
__device__ __forceinline__ void sap_conv(LAS unsigned char* S, int item, SapIn& I, bf16* QD, int ct) {
    const int c = item & 31, h = (item >> 5) & 7, b = item >> 8, t0 = b * 2048 + c * 64; (void)c; (void)h; (void)b; (void)t0;
    LAS float* sGC = (LAS float*)S; LAS bf16* sQb = (LAS bf16*)(S + 1024); LAS bf16* sKb = (LAS bf16*)(S + 18432); LAS bf16* sRH = (LAS bf16*)(S + 35840);
    const int cg_ = ct % 48, strip = ct / 48, tensor = cg_ >> 4, c8 = (cg_ & 15) * 8;
    const int rl0 = strip * 13, nr = (strip == 4) ? 12 : 13;
    float (&w)[4][8] = I.w; float (&xw)[3][8] = I.xw; v4u (&rowv)[13] = I.rowv;
#pragma unroll
    for (int r = 0; r < 13; ++r) if (r < nr) {
        const int tok = rl0 + r; float cur[8], y[8]; unpack8(rowv[r], cur);
        float ss = 0.f;
#pragma unroll
        for (int e = 0; e < 8; ++e) { y[e] = silu(w[0][e] * xw[0][e] + w[1][e] * xw[1][e] + w[2][e] * xw[2][e] + w[3][e] * cur[e]); ss += y[e] * y[e];
            xw[0][e] = xw[1][e]; xw[1][e] = xw[2][e]; xw[2][e] = cur[e]; }
        ss = row16_sum(ss);
        const float rstd = rsqrtf(ss + EPS);
        if (tensor == 0) {
            const float sc = rstd * 0.08838834764831845f, eg = sGC[128 + tok]; float qn[8], qd[8];
#pragma unroll
            for (int e = 0; e < 8; ++e) { qn[e] = y[e] * sc; qd[e] = qn[e] * eg; }
            *(LAS v4u*)(sQb + tok * 136 + c8) = pack8(qn);
            const int m = tok >> 4, s = c8 >> 5, jh = (c8 >> 4) & 1, g0 = (c8 & 15) >> 2;
            bf16* dst = QD + (size_t)item * 8192 + ((m * 4 + s) * 64 + 16 * g0 + (tok & 15)) * 8 + 4 * jh;
            v2u p0, p1; p0.x = pkbf(qd[0], qd[1]); p0.y = pkbf(qd[2], qd[3]); p1.x = pkbf(qd[4], qd[5]); p1.y = pkbf(qd[6], qd[7]);
            *(v2u*)dst = p0; *(v2u*)(dst + 16 * 8) = p1;
        } else if (tensor == 1) {
            const float be = sGC[64 + tok] * sGC[128 + tok]; float kn[8], t8[8];
#pragma unroll
            for (int e = 0; e < 8; ++e) { kn[e] = y[e] * rstd; t8[e] = kn[e] * be; }
            *(LAS v4u*)(sKb + tok * 136 + c8) = pack8(kn);
            *(LAS v4u*)(sRH + tok * 256 + 128 + c8) = pack8(t8);
        } else {
            const float be = sGC[64 + tok]; float t8[8];
#pragma unroll
            for (int e = 0; e < 8; ++e) t8[e] = y[e] * be;
            *(LAS v4u*)(sRH + tok * 256 + c8) = pack8(t8);
        }
    }
}
__device__ __forceinline__ void stage_a_pipe(LAS unsigned char* L, int first, int stride, int nitems, const bf16* QKV, const float* BA, const float* cbw,
                                             bf16* NW, bf16* QD, bf16* KDT, bf16* UD, bf16* AQK, float* GLv, int tid_in,
                                             const bf16* Ubuf, bf16* GAbuf, const bf16* UHbuf, const float* caw) {
    LAS float* sA = (LAS float*)(L + SAP_A); LAS bf16* sAQ = (LAS bf16*)(L + SAP_AQ); LAS bf16* stg = (LAS bf16*)(L + SAP_A);
    { int tid = tid_in; asm volatile("" : "+v"(tid)); const int wid = tid >> 6, lane = tid & 63;
      if (wid == 7) sap_scan(L, first, BA, GLv, lane);
      __syncthreads();
      if (wid >= 4 && tid - 256 < 240) { SapIn I; sap_conv_load(I, first, QKV, cbw, tid - 256); sap_conv(L, first, I, QD, tid - 256); }
      else if (wid < 4) branch_a_rest(Ubuf, GAbuf, UHbuf, caw, first, tid);
      __syncthreads(); }
    for (int k = 0; k < nitems; ++k) {
        int tid = tid_in; asm volatile("" : "+v"(tid));
        const int wid = tid >> 6, lane = tid & 63;
        const int item = first + k * stride, nxt = item + stride; const bool has_next = (k + 1 < nitems);
        LAS unsigned char* S = L + (k & 1) * SAP_SETB; LAS unsigned char* Sn = L + ((k + 1) & 1) * SAP_SETB;
        const int c = item & 31, h = (item >> 5) & 7, b = item >> 8, t0 = b * 2048 + c * 64;
        LAS float* sGC = (LAS float*)S; LAS bf16* sQb = (LAS bf16*)(S + 1024); LAS bf16* sKb = (LAS bf16*)(S + 18432); LAS bf16* sRH = (LAS bf16*)(S + 35840);
        if (wid < 4) {
            {
            const int fr = lane & 15, fq = lane >> 4;
#pragma unroll
            for (int mat = 0; mat < 2; ++mat) {
                const LAS bf16* Am = mat ? sQb : sKb;
                f32x4 acc[4];
#pragma unroll
                for (int n = 0; n < 4; ++n) acc[n] = (f32x4){0.f, 0.f, 0.f, 0.f};
#pragma unroll
                for (int s = 0; s < 4; ++s) { const bf16x8 a = *(const LAS bf16x8*)(Am + (16 * wid + fr) * 136 + 32 * s + 8 * fq);
#pragma unroll
                    for (int n = 0; n < 4; ++n) { const bf16x8 bb = *(const LAS bf16x8*)(sKb + (16 * n + fr) * 136 + 32 * s + 8 * fq); acc[n] = __builtin_amdgcn_mfma_f32_16x16x32_bf16(a, bb, acc[n], 0, 0, 0); } }
#pragma unroll
                for (int n = 0; n < 4; ++n)
#pragma unroll
                    for (int r = 0; r < 4; ++r) { const int i = 16 * wid + 4 * fq + r, j = 16 * n + fr; const float d = acc[n][r], dec = __expf(sGC[i] - sGC[j]);
                        if (mat == 0) sA[j * 64 + i] = (i > j) ? sGC[64 + i] * d * dec : 0.f;
                        else { const float v = (i >= j) ? d * dec : 0.f; const int m = i >> 4, s2 = j >> 5, jj = 4 * ((j >> 4) & 1) + (j & 3), lp = 16 * ((j & 15) >> 2) + (i & 15);
                            sAQ[((m * 2 + s2) * 64 + lp) * 8 + jj] = f2bf1(v); } }
            }
            }
            __syncthreads();
            f32x2v x2[32];
            {
            int zoff; asm volatile("v_mov_b32 %0, 0" : "=v"(zoff));
#pragma unroll
            for (int i = 0; i < 32; ++i) x2[i] = (f32x2v){bf1(sRH[(2 * i) * 256 + tid]), bf1(sRH[(2 * i + 1) * 256 + tid])};
#pragma unroll
            for (int j = 0; j < 63; ++j) {
                const float xj = (j & 1) ? x2[j >> 1][1] : x2[j >> 1][0];
                const f32x2v xjj = {xj, xj};
#pragma unroll
                for (int ib = (j + 1) / 4; ib < 16; ++ib) { const f32x4 a4 = *(const LAS f32x4*)(sA + zoff + j * 64 + 4 * ib);
                    x2[2 * ib] = x2[2 * ib] - (f32x2v){a4[0], a4[1]} * xjj; x2[2 * ib + 1] = x2[2 * ib + 1] - (f32x2v){a4[2], a4[3]} * xjj; }
                if ((j & 1) == 1) asm volatile("" : "+v"(zoff), "+v"(x2[(j + 1) >> 1]));
            }
            }
            float x[64];
#pragma unroll
            for (int i = 0; i < 32; ++i) { x[2 * i] = x2[i][0]; x[2 * i + 1] = x2[i][1]; }
            __syncthreads();
            if (tid < 128) {
                const int dv = tid, w_ = dv >> 4;
#pragma unroll
                for (int m = 0; m < 4; ++m)
#pragma unroll
                    for (int g = 0; g < 4; ++g) { v2u p; p.x = pkbf(x[16 * m + 4 * g], x[16 * m + 4 * g + 1]); p.y = pkbf(x[16 * m + 4 * g + 2], x[16 * m + 4 * g + 3]);
                        const int e = ((w_ * 4 + m) * 64 + 16 * g + (dv & 15)) * 4; *(v2u*)(UD + qkv_gran(t0, h, 1024 + (e >> 3)) + (e & 7)) = p; }
            } else {
                const int dk = tid - 128, s = dk >> 5, jh = (dk >> 4) & 1, g = (dk & 15) >> 2, j = 4 * jh + (dk & 3);
#pragma unroll
                for (int tok = 0; tok < 64; ++tok) stg[(((tok >> 4) * 4 + s) * 64 + 16 * g + (tok & 15)) * 8 + j] = f2bf1(-x[tok]);
            }
            __syncthreads();
#pragma unroll
            for (int q = 0; q < 4; ++q) { const int p = tid + 256 * q; *(v4u*)(NW + (size_t)item * 8192 + p * 8) = *(const LAS v4u*)(stg + p * 8); }
            __syncthreads();
        } else {
            SapIn I;
            if (tid - 256 < 240 && has_next) sap_conv_load(I, nxt, QKV, cbw, tid - 256);
            if (wid == 7 && has_next) sap_scan(Sn, nxt, BA, GLv, lane);
            __syncthreads();
            if (tid - 256 < 240 && has_next) sap_conv(Sn, nxt, I, QD, tid - 256);
            __syncthreads();
#pragma unroll
            for (int q = 0; q < 4; ++q) { const int p = (tid - 256) + 256 * q, l = p & 63, fs = p >> 6, i = fs >> 1, s2 = fs & 1, dk = 16 * i + (l & 15), g = l >> 4; float v8[8];
#pragma unroll
                for (int j = 0; j < 8; ++j) { const int tok = 32 * s2 + 16 * (j >> 2) + 4 * g + (j & 3); v8[j] = bf1(sKb[tok * 136 + dk]) * sGC[192 + tok]; }
                *(v4u*)(KDT + qkv_gran(t0, h, p)) = pack8(v8); }
#pragma unroll
            for (int q = 0; q < 2; ++q) { const int p = (tid - 256) + 256 * q; *(v4u*)(AQK + (size_t)item * 4096 + p * 8) = *(const LAS v4u*)(sAQ + p * 8); }
            __syncthreads();
            __syncthreads();
        }
    }
}
__device__ __forceinline__ void stage_b(LAS unsigned char* L, int bh, const bf16* NW, const bf16* QD, const bf16* KDT, const bf16* UD, const bf16* AQK,
                                        const float* GLv, bf16* ZBO, const float* onw, float* ndp, int tid, bool dry = false) {
    const int lane = tid & 63, w = tid >> 6, g = lane >> 4, colx = lane & 15, dv = 16 * w + colx, b = bh >> 3, h = bh & 7;
    LAS float* red = (LAS float*)(L + 114688);
    f32x4 S[8];
#pragma unroll
    for (int i = 0; i < 8; ++i) S[i] = (f32x4){0.f, 0.f, 0.f, 0.f};
    const float ow = onw[dv];
    v4u R[7];
    int kdo[2], udo[4], zbo[4][4];
#pragma unroll
    for (int q = 0; q < 2; ++q) { const int i = tid + 512 * q, row = i / 48, j = i - row * 48; kdo[q] = row * 3072 + (j >> 4) * 1024 + (j & 15) * 8; }
#pragma unroll
    for (int m = 0; m < 4; ++m) { const int e_ = ((w * 4 + m) * 64 + lane) * 4, i = 1024 + (e_ >> 3), row = i / 48, j = i - row * 48; udo[m] = row * 3072 + (j >> 4) * 1024 + (j & 15) * 8 + (e_ & 7);
#pragma unroll
        for (int r = 0; r < 4; ++r) zbo[m][r] = (16 * m + 4 * g + r) * 1024 + dv; }
#define SB_ISSUE(item_) do { const bf16* nwb_ = NW + (size_t)(item_) * 8192; const bf16* qdb_ = QD + (size_t)(item_) * 8192; const bf16* aqb_ = AQK + (size_t)(item_) * 4096; \
        const bf16* kdb_ = KDT + (size_t)(b * 2048 + ((item_) & 31) * 64) * 3072 + h * 128; \
        R[0] = __builtin_nontemporal_load((const v4u*)(nwb_ + tid * 8)); R[1] = __builtin_nontemporal_load((const v4u*)(nwb_ + (tid + 512) * 8)); R[2] = __builtin_nontemporal_load((const v4u*)(qdb_ + tid * 8)); R[3] = __builtin_nontemporal_load((const v4u*)(qdb_ + (tid + 512) * 8)); \
        R[4] = __builtin_nontemporal_load((const v4u*)(kdb_ + kdo[0])); R[5] = __builtin_nontemporal_load((const v4u*)(kdb_ + kdo[1])); R[6] = __builtin_nontemporal_load((const v4u*)(aqb_ + tid * 8)); } while (0)
#define SB_COMMIT(bufi_) do { _Pragma("unroll") for (int q = 0; q < 7; ++q) { const int p = tid + 512 * q; *(LAS v4u*)(L + (bufi_) * 57344 + p * 16) = R[q]; } } while (0)
    SB_ISSUE(bh * 32); SB_COMMIT(0);
    v2u udn[4]; unsigned short zbn[4][4];
#define SB_PRE(item_, t0_) do { const bf16* udb_ = UD + (size_t)(t0_) * 3072 + h * 128; const bf16* zbb_ = ZBO + (size_t)(t0_) * 1024 + h * 128; \
        _Pragma("unroll") for (int m = 0; m < 4; ++m) { udn[m] = *(const v2u*)(udb_ + udo[m]); \
        _Pragma("unroll") for (int r = 0; r < 4; ++r) zbn[m][r] = zbb_[zbo[m][r]]; } } while (0)
    SB_PRE(bh * 32, b * 2048);
    float gln = GLv[bh * 32];
    __syncthreads();
    for (int c = 0; c < 32; ++c) {
        const int item = bh * 32 + c, cur = c & 1, t0 = b * 2048 + c * 64;
        LAS unsigned char* B = L + cur * 57344;
        const int nitem = (c + 1 < 32) ? item + 1 : item, nt0 = (c + 1 < 32) ? t0 + 64 : t0;
        SB_ISSUE(nitem);
        f32x4 vn[4]; unsigned short zb[4][4];
#pragma unroll
        for (int m = 0; m < 4; ++m) { const v2u u2 = udn[m]; vn[m] = (f32x4){bflo(u2.x), bfhi(u2.x), bflo(u2.y), bfhi(u2.y)};
#pragma unroll
            for (int r = 0; r < 4; ++r) zb[m][r] = zbn[m][r]; }
        const float gl = gln;
        gln = GLv[nitem]; SB_PRE(nitem, nt0);
        bf16x8 Sb[4];
#pragma unroll
        for (int s = 0; s < 4; ++s) { v4u t; t.x = pk2(S[2 * s][0], S[2 * s][1]); t.y = pk2(S[2 * s][2], S[2 * s][3]); t.z = pk2(S[2 * s + 1][0], S[2 * s + 1][1]); t.w = pk2(S[2 * s + 1][2], S[2 * s + 1][3]); Sb[s] = __builtin_bit_cast(bf16x8, t); }
        f32x4 o[4];
#pragma unroll
        for (int m = 0; m < 4; ++m) o[m] = (f32x4){0.f, 0.f, 0.f, 0.f};
#pragma unroll
        for (int s = 0; s < 4; ++s)
#pragma unroll
            for (int m = 0; m < 4; ++m) { const bf16x8 a = *(const LAS bf16x8*)(B + ((m * 4 + s) * 64 + lane) * 16); vn[m] = __builtin_amdgcn_mfma_f32_16x16x32_bf16(a, Sb[s], vn[m], 0, 0, 0);
                const bf16x8 a2 = *(const LAS bf16x8*)(B + 16384 + ((m * 4 + s) * 64 + lane) * 16); o[m] = __builtin_amdgcn_mfma_f32_16x16x32_bf16(a2, Sb[s], o[m], 0, 0, 0); }
        bf16x8 vb[2];
#pragma unroll
        for (int s = 0; s < 2; ++s) { v4u t; t.x = pk2(vn[2 * s][0], vn[2 * s][1]); t.y = pk2(vn[2 * s][2], vn[2 * s][3]); t.z = pk2(vn[2 * s + 1][0], vn[2 * s + 1][1]); t.w = pk2(vn[2 * s + 1][2], vn[2 * s + 1][3]); vb[s] = __builtin_bit_cast(bf16x8, t); }
#pragma unroll
        for (int s = 0; s < 2; ++s)
#pragma unroll
            for (int m = 0; m < 4; ++m) { const bf16x8 a = *(const LAS bf16x8*)(B + 49152 + ((m * 2 + s) * 64 + lane) * 16); o[m] = __builtin_amdgcn_mfma_f32_16x16x32_bf16(a, vb[s], o[m], 0, 0, 0); }
#pragma unroll
        for (int ih = 0; ih < 2; ++ih) {
#pragma unroll
            for (int i = 4 * ih; i < 4 * ih + 4; ++i) S[i] = S[i] * gl;
#pragma unroll
            for (int s = 0; s < 2; ++s)
#pragma unroll
                for (int i = 4 * ih; i < 4 * ih + 4; ++i) { const bf16x8 a = *(const LAS bf16x8*)(B + 32768 + ((i * 2 + s) * 64 + lane) * 16); S[i] = __builtin_amdgcn_mfma_f32_16x16x32_bf16(a, vb[s], S[i], 0, 0, 0); }
        }
#pragma unroll
        for (int m = 0; m < 4; ++m)
#pragma unroll
            for (int r = 0; r < 4; ++r) { float q = row16_sum(o[m][r] * o[m][r]);
                if (colx == 0) red[(cur * 64 + 16 * m + 4 * g + r) * 8 + w] = q; }
        SB_COMMIT(cur ^ 1);
        __syncthreads();
        {
            LAS float* rs = red + 1024 + (cur * 8 + w) * 64;
            bf16* zst = ZBO + (size_t)t0 * 1024 + h * 128;
            const f32x4 p0 = *(const LAS f32x4*)(red + (cur * 64 + lane) * 8), p1 = *(const LAS f32x4*)(red + (cur * 64 + lane) * 8 + 4);
            rs[lane] = rsqrtf((((p0[0] + p0[1]) + (p0[2] + p0[3])) + ((p1[0] + p1[1]) + (p1[2] + p1[3]))) * (1.f / 128.f) + EPS);
#pragma unroll
            for (int m = 0; m < 4; ++m) { const f32x4 r4 = *(const LAS f32x4*)(rs + 16 * m + 4 * g);
#pragma unroll
                for (int r = 0; r < 4; ++r) { const int tok = 16 * m + 4 * g + r;
                    (void)tok; if (!dry) zst[zbo[m][r]] = f2bf1(o[m][r] * r4[r] * ow * bf1(zb[m][r])); } }
        }
    }
#pragma unroll
    for (int i = 0; i < 8; ++i)
#pragma unroll
        for (int r = 0; r < 4; ++r) if (!dry) ndp[((size_t)bh * 128 + 16 * i + 4 * g + r) * 128 + dv] = S[i][r];
    __syncthreads();
}
__device__ __forceinline__ void sample_delta(LAS unsigned char* L, int item, const float* const* in, unsigned char* ws, float* out, int tid, bool dry = false) {
    const int lane = tid & 63, wid = tid >> 6, s = item >> 3, h = item & 7;
    LAS float* vals = (LAS float*)L; LAS float* part = (LAS float*)(L + 2048); LAS float* misc = (LAS float*)(L + 4096);
    const bf16* QKV = (const bf16*)(ws + WS_BUF + 3 * BUF_BYTES); const float* BA = (const float*)(ws + WS_BA); bf16* ZBO = (bf16*)(ws + WS_BUF + 6 * BUF_BYTES);
    const float* scq = in[5]; const float* cbw = in[12]; const float* sd = in[6];
    if (tid < 384) { const int tensor = tid >> 7, d = tid & 127, colg = tensor * 1024 + h * 128 + d; const float* st = scq + (size_t)(s * 3) * 3072 + colg;
        const float y = cbw[colg] * st[0] + cbw[3072 + colg] * st[3072] + cbw[2 * 3072 + colg] * st[2 * 3072] + cbw[3 * 3072 + colg] * bf1(QKV[(size_t)(MP + s) * 3072 + colg]);
        vals[tid] = silu(y); }
    __syncthreads();
    if (wid < 2) { const float a0 = vals[wid * 128 + lane], a1 = vals[wid * 128 + 64 + lane]; const float ss = wave_sum(a0 * a0 + a1 * a1);
        if (lane == 0) misc[wid] = rsqrtf(ss + EPS) * (wid == 0 ? 0.08838834764831845f : 1.f); }
    __syncthreads();
    const int dv = tid & 127, grp = tid >> 7, dk0 = 32 * grp;
    const float a = __expf(BA[(size_t)(MP + s) * 16 + 8 + h]), beta = BA[(size_t)(MP + s) * 16 + h], rq = misc[0], rk = misc[1];
    const float* S0 = sd + (size_t)item * 16384; float* S1 = out + O_NDS + (size_t)item * 16384;
    float Sr[32]; float ks = 0.f;
#pragma unroll
    for (int i = 0; i < 32; ++i) { Sr[i] = __builtin_nontemporal_load(S0 + (dk0 + i) * 128 + dv); }
#pragma unroll
    for (int i = 0; i < 32; ++i) ks += vals[128 + dk0 + i] * Sr[i];
    part[grp * 128 + dv] = ks;
    __syncthreads();
    const float kS = a * rk * (part[dv] + part[128 + dv] + part[256 + dv] + part[384 + dv]);
    const float vnew = beta * (vals[256 + dv] - kS);
    float po = 0.f;
#pragma unroll
    for (int i = 0; i < 32; ++i) { const float sn = a * Sr[i] + (vals[128 + dk0 + i] * rk) * vnew; if (!dry) S1[(dk0 + i) * 128 + dv] = sn; po += vals[dk0 + i] * sn; }
    __syncthreads();
    part[grp * 128 + dv] = po;
    __syncthreads();
    const float o = rq * (part[dv] + part[128 + dv] + part[256 + dv] + part[384 + dv]);
    if (wid < 2) { const float ss = wave_sum(o * o); if (lane == 0) misc[2 + wid] = ss; }
    __syncthreads();
    if (tid < 128) { const float rstd = rsqrtf((misc[2] + misc[3]) * (1.f / 128.f) + EPS); const size_t oi = (size_t)(MP + s) * 1024 + h * 128 + dv;
        if (!dry) ZBO[oi] = f2bf1(o * rstd * in[15][dv] * bf1(ZBO[oi])); }
    __syncthreads();
}

__device__ __forceinline__ void seq_full(LAS unsigned char* L, int bh, const bf16* QKV, const float* BA, const float* cbw, bf16* ZBO, const float* onw, float* ndp, int tid) {
    const int lane = tid & 63, wid = tid >> 6, b = bh >> 3, h = bh & 7;
    LAS float* vals = (LAS float*)L; LAS float* part = (LAS float*)(L + 2048); LAS float* misc = (LAS float*)(L + 4096);
    const int dv = tid & 127, grp = tid >> 7, dk0 = 32 * grp;
    float Sr[32];
#pragma unroll
    for (int i = 0; i < 32; ++i) Sr[i] = 0.f;
    const float ow = onw[dv];
    for (int t = 0; t < 2048; ++t) {
        const size_t row = (size_t)b * 2048 + t;
        if (tid < 384) { const int tensor = tid >> 7, d = tid & 127, colg = tensor * 1024 + h * 128 + d; float y = 0.f;
#pragma unroll
            for (int j = 0; j < 4; ++j) { if (t - 3 + j >= 0) y += cbw[j * 3072 + colg] * bf1(QKV[(row - 3 + j) * 3072 + colg]); }
            vals[tid] = silu(y); }
        __syncthreads();
        if (wid < 2) { const float a0 = vals[wid * 128 + lane], a1 = vals[wid * 128 + 64 + lane]; const float ss = wave_sum(a0 * a0 + a1 * a1); if (lane == 0) misc[wid] = rsqrtf(ss + EPS) * (wid == 0 ? 0.08838834764831845f : 1.f); }
        __syncthreads();
        const float a = __expf(BA[row * 16 + 8 + h]), beta = BA[row * 16 + h], rq = misc[0], rk = misc[1];
        float ks = 0.f;
#pragma unroll
        for (int i = 0; i < 32; ++i) ks += vals[128 + dk0 + i] * Sr[i];
        part[grp * 128 + dv] = ks;
        __syncthreads();
        const float kS = a * rk * (part[dv] + part[128 + dv] + part[256 + dv] + part[384 + dv]);
        const float vnew = beta * (vals[256 + dv] - kS);
        float po = 0.f;
#pragma unroll
        for (int i = 0; i < 32; ++i) { Sr[i] = a * Sr[i] + (vals[128 + dk0 + i] * rk) * vnew; po += vals[dk0 + i] * Sr[i]; }
        __syncthreads();
        part[grp * 128 + dv] = po;
        __syncthreads();
        const float o = rq * (part[dv] + part[128 + dv] + part[256 + dv] + part[384 + dv]);
        if (wid < 2) { const float ss = wave_sum(o * o); if (lane == 0) misc[2 + wid] = ss; }
        __syncthreads();
        if (tid < 128) { const float rstd = rsqrtf((misc[2] + misc[3]) * (1.f / 128.f) + EPS); const size_t oi = row * 1024 + h * 128 + dv; ZBO[oi] = f2bf1(o * rstd * ow * bf1(ZBO[oi])); }
        __syncthreads();
    }
#pragma unroll
    for (int i = 0; i < 32; ++i) ndp[((size_t)bh * 128 + dk0 + i) * 128 + dv] = Sr[i];
}
__device__ __forceinline__ void phase_final(const float* const* in, unsigned char* ws, float* out, int vcu, int G, int tid) {
    const int lane = tid & 63, wave = tid >> 6, gw = vcu * 8 + wave, NGW = G * 8;
    const bf16* T = (const bf16*)(ws + WS_BUF + 4 * BUF_BYTES); const float* MOD = (const float*)(ws + WS_MOD); const float* npost = in[19];
    f32x4 np[2][2];
#pragma unroll
    for (int j = 0; j < 2; ++j)
#pragma unroll
        for (int q = 0; q < 2; ++q) np[j][q] = *(const f32x4*)(npost + 512 * j + 8 * lane + 4 * q);
    const int nblk = MP / 8;
    for (int blk = gw; blk < nblk + NS; blk += NGW) {
        const bool samp = blk >= nblk;
        const int m0 = samp ? MP + (blk - nblk) : blk * 8, nrow = samp ? 1 : 8, mr = samp ? 8 + (blk - nblk) : (m0 >> 11);
        const float* xr = samp ? in[1] + (size_t)(blk - nblk) * 1024 : in[0] + (size_t)m0 * 1024;
        f32x4 gn[2][2];
#pragma unroll
        for (int j = 0; j < 2; ++j)
#pragma unroll
            for (int q = 0; q < 2; ++q) gn[j][q] = *(const f32x4*)(MOD + (size_t)mr * 3072 + 2048 + 512 * j + 8 * lane + 4 * q) * np[j][q];
        v4u tn[2]; f32x4 xn[2][2];
#pragma unroll
        for (int j = 0; j < 2; ++j) { tn[j] = __builtin_nontemporal_load((const v4u*)(T + (size_t)m0 * 1024 + 512 * j + 8 * lane));
#pragma unroll
            for (int q = 0; q < 2; ++q) xn[j][q] = __builtin_nontemporal_load((const f32x4*)(xr + 512 * j + 8 * lane + 4 * q)); }
        for (int r = 0; r < nrow; ++r) {
            const int m = m0 + r;
            float t[2][8]; f32x4 xv[2][2]; float ss = 0.f;
#pragma unroll
            for (int j = 0; j < 2; ++j) { unpack8(tn[j], t[j]);
#pragma unroll
                for (int q = 0; q < 2; ++q) xv[j][q] = xn[j][q];
#pragma unroll
                for (int e = 0; e < 8; ++e) ss += t[j][e] * t[j][e]; }
            { const int rn = (r + 1 < nrow) ? r + 1 : r;
#pragma unroll
                for (int j = 0; j < 2; ++j) { tn[j] = __builtin_nontemporal_load((const v4u*)(T + (size_t)(m0 + rn) * 1024 + 512 * j + 8 * lane));
#pragma unroll
                    for (int q = 0; q < 2; ++q) xn[j][q] = __builtin_nontemporal_load((const f32x4*)(xr + (size_t)rn * 1024 + 512 * j + 8 * lane + 4 * q)); } }
            const float rstd = rsqrtf(wave_sum(ss) * (1.f / 1024.f) + EPS);
#pragma unroll
            for (int j = 0; j < 2; ++j)
#pragma unroll
                for (int q = 0; q < 2; ++q) { const int k = 512 * j + 8 * lane + 4 * q;
                    f32x4 tv = {t[j][4 * q], t[j][4 * q + 1], t[j][4 * q + 2], t[j][4 * q + 3]};
                    *(f32x4*)(out + (size_t)m * 1024 + k) = xv[j][q] + gn[j][q] * (tv * rstd); }
        }
    }
}
struct Args { const float* in[20]; float* out; unsigned char* ws; };
__global__ void __launch_bounds__(512, 2) fwd_kernel(Args args) {
    extern __shared__ __attribute__((aligned(16))) unsigned char lds_raw[];
    LAS unsigned char* L = (LAS unsigned char*)lds_raw;
#define FRESH_TID() ({ int t_ = threadIdx.x; asm volatile("" : "+v"(t_)); t_; })
#define FRESH_WAVE() __builtin_amdgcn_readfirstlane(FRESH_TID() >> 6)
    const int G = gridDim.x, bx = blockIdx.x; const int vcu = (G % 8 == 0) ? (bx % 8) * (G / 8) + bx / 8 : bx;
    unsigned char* ws = args.ws; float* out = args.out;
    if (gridDim.x > 65536u) cg::this_grid().sync();
    volatile LAS unsigned* MISC = (volatile LAS unsigned*)(L + MISC_OFF);
    if (threadIdx.x < 16) MISC[threadIdx.x] = 0u;
    __syncthreads();
    XcdBarrier bar = xcd_barrier_post((unsigned*)(ws + WS_CTL) + CW_BAR, MISC + 8);
    const int NGW = G * 8;
    bf16* B0 = (bf16*)(ws + WS_BUF); bf16* B1 = (bf16*)(ws + WS_BUF + 1 * BUF_BYTES); bf16* B2 = (bf16*)(ws + WS_BUF + 2 * BUF_BYTES); bf16* B3 = (bf16*)(ws + WS_BUF + 3 * BUF_BYTES);
    bf16* B4 = (bf16*)(ws + WS_BUF + 4 * BUF_BYTES); bf16* B6 = (bf16*)(ws + WS_BUF + 6 * BUF_BYTES);
    bf16* D0 = (bf16*)out; bf16* D1 = D0 + (size_t)MV * 1024; bf16* D2 = (bf16*)(out + O_NDS); bf16* D3 = D2 + (size_t)MP * 1024;
    bf16* WIN = (bf16*)(ws + WS_WIN); bf16* WA = (bf16*)(ws + WS_WA); bf16* WB = (bf16*)(ws + WS_WB); bf16* WO = (bf16*)(ws + WS_WO);
    float* GLv = (float*)(ws + WS_GL);

    phase_mod(args.in, ws, FRESH_WAVE() * G + vcu, NGW, FRESH_TID() & 63);
    phase0(L, args.in, ws, vcu, G, FRESH_TID());
    xcd_barrier(bar);
#ifdef DBL_P0
    phase0(L, args.in, ws, vcu, G, FRESH_TID());
#endif
    phase1(L, args.in, ws, vcu, G, FRESH_TID());
#ifdef DBL_P1
    __syncthreads();
    phase1(L, args.in, ws, vcu, G, FRESH_TID());
#endif
    xcd_barrier(bar);
    {   pg8::Gemm g{B0, WIN, MPAD, NIN, 1024}; pg8::StaticOrder S; S.init(MPAD, NIN, G, bx);
        EpiIn E{B1, B2, B3, B6, D0, D1, D2};
        pg8::gemm_phase<EpiIn, pg8::StaticOrder, true, true>(L, g, S, E);
#ifdef DBL_P2
        pg8::gemm_phase<EpiIn, pg8::StaticOrder, true, true>(L, g, S, E);
#endif
 }
    xcd_barrier(bar);
    phase3(args.in, ws, out, vcu, G, bx, FRESH_TID());
    __syncthreads();
    stage_a_pipe(L, bx, G, (2048 - bx + G - 1) / G, B3, (const float*)(ws + WS_BA), args.in[12], B0, B1, B3, B3, WIN, GLv, FRESH_TID(), B1, B2, D2, args.in[11]);
    xcd_barrier(bar);
#ifndef USE_SEQ
#ifdef DBL_P5
    if (bx < 64) { _Pragma("nounroll") for (int rep = 0; rep < 2; ++rep) stage_b(L, bx, B0, B1, B3, B3, WIN, GLv, B6, args.in[15], out + O_NDP, FRESH_TID(), rep == 0); }
    else {
        pg8::StaticOrder S; S.init(MP, 1024, G - 64, bx - 64); pg8::Gemm g{B2, WA, MP, 1024, 1024}; EpiEl<FOutA> E{FOutA{D0, D0}};
        pg8::gemm_phase<EpiEl<FOutA>, pg8::StaticOrder, true, true>(L, g, S, E); small_gemm_wg(L, B2, WA, MP, E.f, bx - 64, G - 64, FRESH_TID());
        for (int it = bx - 64; it < 1024; it += G - 64) sample_delta(L, it, args.in, ws, out, FRESH_TID()); }
#else
    if (bx < 64) stage_b(L, bx, B0, B1, B3, B3, WIN, GLv, B6, args.in[15], out + O_NDP, FRESH_TID());
    else {
        phase3b(args.in, ws, out, (bx - 64) * 512 + FRESH_TID(), (G - 64) * 512);
        pg8::StaticOrder S; S.init(MP, 1024, G - 64, bx - 64); pg8::Gemm g{B2, WA, MP, 1024, 1024}; EpiEl<FOutA> E{FOutA{D0, D0}};
        pg8::gemm_phase<EpiEl<FOutA>, pg8::StaticOrder, true, true>(L, g, S, E); small_gemm_wg(L, B2, WA, MP, E.f, bx - 64, G - 64, FRESH_TID());
        if (bx >= 128) { for (int it = bx - 128; it < 832; it += 128) sample_delta(L, it, args.in, ws, out, FRESH_TID()); }
        else { for (int it = 832 + (bx - 64); it < 1024; it += 64) sample_delta(L, it, args.in, ws, out, FRESH_TID()); } }
#endif
#else
    if (bx < 64) seq_full(L, bx, B3, (const float*)(ws + WS_BA), args.in[12], B6, args.in[15], out + O_NDP, FRESH_TID());
#endif
    xcd_barrier(bar);
#ifdef DBL_P6
    _Pragma("nounroll") for (int rep = 0; rep < 2; ++rep)
#endif
    {   pg8::StaticOrder S; S.init(MP, 1024, G, bx);
        { pg8::Gemm g{B6, WB, MP, 1024, 1024}; EpiEl<FOutB> E{FOutB{D1, D0, B3}}; pg8::gemm_phase<EpiEl<FOutB>, pg8::StaticOrder, true, true>(L, g, S, E); small_gemm_wg(L, B6, WB, MP, E.f, bx, G, FRESH_TID()); } }
    xcd_barrier(bar);
#ifdef DBL_P7
    _Pragma("nounroll") for (int rep = 0; rep < 2; ++rep)
#endif
    {   pg8::StaticOrder S; S.init(MP, 1024, G, bx); pg8::Gemm g{B3, WO, MP, 1024, 1024}; EpiEl<FPlain> E{FPlain{B4}};
        pg8::gemm_phase<EpiEl<FPlain>, pg8::StaticOrder, true, true>(L, g, S, E); small_gemm_wg(L, B3, WO, MP, E.f, bx, G, FRESH_TID()); }
    xcd_barrier(bar);
    phase_final(args.in, ws, out, vcu, G, FRESH_TID());
#ifdef DBL_P8
    phase_final(args.in, ws, out, vcu, G, FRESH_TID());
#endif
}

extern "C" void kernel_launch(void* const* d_in, const int* in_sizes, int n_in, void* d_out, int out_size, void* d_ws, size_t ws_size, hipStream_t stream) {
    static int grid = 0;
    if (grid == 0) {
        if (n_in != 20 || (size_t)out_size != O_END || ws_size < WS_END) { fprintf(stderr, "kernel_launch: unexpected shapes: n_in %d out %d ws %zu\n", n_in, out_size, ws_size); grid = -1; return; }
        int dev = 0, cus = 0, per_cu = 0;
        hipGetDevice(&dev); hipDeviceGetAttribute(&cus, hipDeviceAttributeMultiprocessorCount, dev);
        if (hipFuncSetAttribute((const void*)fwd_kernel, hipFuncAttributeMaxDynamicSharedMemorySize, LDS_BYTES) != hipSuccess) { fprintf(stderr, "kernel_launch: hipFuncSetAttribute failed\n"); grid = -1; return; }
        hipOccupancyMaxActiveBlocksPerMultiprocessor(&per_cu, (const void*)fwd_kernel, 512, LDS_BYTES);
        (void)hipGetLastError();
        if (per_cu < 1) fprintf(stderr, "kernel_launch: occupancy query says %d blocks/CU\n", per_cu);
        grid = cus;
    }
    if (grid < 0) return;
    hipMemsetAsync((char*)d_ws + WS_CTL, 0, CTL_BYTES, stream);
    Args a{};
    for (int i = 0; i < 20; ++i) a.in[i] = (const float*)d_in[i];
    a.out = (float*)d_out; a.ws = (unsigned char*)d_ws;
    void* params[] = {&a};
    hipError_t e = hipLaunchCooperativeKernel((const void*)fwd_kernel, dim3(grid), dim3(512), params, LDS_BYTES, stream);
    if (e != hipSuccess) fprintf(stderr, "kernel_launch: cooperative launch failed: %s (grid %d)\n", hipGetErrorString(e), grid);
}
```

```cpp
#include <hip/hip_runtime.h>
#include <hip/hip_cooperative_groups.h>
#include <cstdio>
#include <cstdint>
namespace cg = cooperative_groups;
namespace pg8 {
#define PG8_LAS __attribute__((address_space(3)))
typedef unsigned short bf16_t;
typedef short bf16x8 __attribute__((ext_vector_type(8)));
typedef float f32x4 __attribute__((ext_vector_type(4)));
typedef unsigned u32x4 __attribute__((ext_vector_type(4)));
constexpr int BM = 256, BK = 64, HALF = 128, HTB = HALF * BK * 2  , STAGE_BYTES = 8 * HTB, NXCD = 8, WGM = 4;

__host__ __device__ __forceinline__ int lds_byte(int r, int c) { const int st = (r >> 4) * 2 + (c >> 5), rr = r & 15, cc = c & 31, ob = rr * 64 + cc * 2; return st * 1024 + (ob ^ (((ob >> 9) & 1) << 5)); }
__host__ __device__ __forceinline__ void stage_rc(int b, int& R, int& C) { const int st = b / 1024, sb = b % 1024, swz = sb ^ (((sb >> 9) & 1) << 5); R = (st >> 1) * 16 + swz / 64; C = (st & 1) * 32 + (swz % 64) / 2; }
__host__ __device__ __forceinline__ int perm32(int rho) { const int n = rho >> 4, i = rho & 15; return 8 * (i >> 2) + 4 * n + (i & 3); }

struct Unit { int pm, pn; };
struct Gemm { const bf16_t* A; const bf16_t* Bt; int M, N, K; };

struct StaticOrder {
    int nM, nN, nwg, G, c;
    __host__ __device__ void init(int M, int N, int G_, int c_) { nM = M / BM; nN = N / BM; nwg = nM * nN; G = G_; c = c_; }
    __host__ __device__ bool next(int i, Unit& u) const {
        const long L = (long)i * G + c; if (L >= nwg) return false;
        int wgid = (int)L; { const int q = nwg / NXCD, r = nwg % NXCD, xcd = wgid % NXCD, off = wgid / NXCD; wgid = (xcd < r ? xcd * (q + 1) : r * (q + 1) + (xcd - r) * q) + off; }
        const int nig = WGM * nN, gid = wgid / nig, fm = gid * WGM, gsz = (nM - fm) < WGM ? (nM - fm) : WGM;
        u.pm = fm + ((wgid % nig) % gsz); u.pn = (wgid % nig) / gsz; return true;
    }
    __device__ __forceinline__ void a_ready(const Unit&) const {}
    __device__ __forceinline__ void done(const Unit&) const {}
};

__device__ __forceinline__ unsigned cvt_pk_bf16(float lo, float hi) { unsigned r; asm volatile("v_cvt_pk_bf16_f32 %0, %1, %2" : "=v"(r) : "v"(lo), "v"(hi)); return r; }
typedef float f32x2 __attribute__((ext_vector_type(2)));
template <class Epi, class Sched, bool ALIGN_EPI = false, bool SP2 = false>
__device__ __forceinline__ void gemm_phase(PG8_LAS unsigned char* lds, const Gemm g, const Sched& S, const Epi& E) {
    int tid = threadIdx.x; asm volatile("" : "+v"(tid));
    const int wid = __builtin_amdgcn_readfirstlane(tid >> 6), lane = tid & 63, wr = wid >> 2, wc = wid & 3, fr = lane & 15, fq = lane >> 4;
    const int K = g.K, nt = K / BK;
    unsigned voffA[2], voffB[2];
#pragma unroll
    for (int i = 0; i < 2; ++i) { int R, C; stage_rc(tid * 16 + i * 8192, R, C); const int Rb = Epi::PERM ? ((R & ~31) + perm32(R & 31)) : R;
        voffA[i] = (unsigned)(R * K + C) * 2u; voffB[i] = (unsigned)(Rb * K + C) * 2u; }
    const size_t kstep = (size_t)(BK * 2);
    const size_t hstep = (size_t)HALF * K * 2;
    const size_t tstep = 2 * hstep;
    const unsigned ldsw = (unsigned)wid * 1024u;
    const int aoff = lds_byte(wr * 64 + fr, fq * 8), boff = lds_byte(wc * 32 + fr, fq * 8);
#define PG8_SA(b, h) (((b) * 2 + (h)) * HTB)
#define PG8_SB(b, h) ((4 + (b) * 2 + (h)) * HTB)
#define PG8_STAGE(bufoff, gbase, voff) do { _Pragma("unroll") for (int _i = 0; _i < 2; ++_i) \
        __builtin_amdgcn_global_load_lds((const unsigned*)((const char*)(gbase) + (voff)[_i]), (PG8_LAS unsigned*)(lds + (bufoff) + ldsw + _i * 8192), 16, 0, 0); } while (0)
#define PG8_LDA(dst, b, h) do { _Pragma("unroll") for (int m = 0; m < 4; ++m) _Pragma("unroll") for (int k = 0; k < 2; ++k) dst[m][k] = *(const PG8_LAS bf16x8*)(lds + PG8_SA(b, h) + aoff + m * 2048 + k * 1024); } while (0)
#define PG8_LDB(dst, b, h) do { _Pragma("unroll") for (int n = 0; n < 2; ++n) _Pragma("unroll") for (int k = 0; k < 2; ++k) dst[n][k] = *(const PG8_LAS bf16x8*)(lds + PG8_SB(b, h) + boff + n * 2048 + k * 1024); } while (0)
#define PG8_MMA(ai, bj, At, Bt) do { __builtin_amdgcn_s_setprio(1); _Pragma("unroll") for (int m = 0; m < 4; ++m) _Pragma("unroll") for (int n = 0; n < 2; ++n) _Pragma("unroll") for (int k = 0; k < 2; ++k) \
        acc[ai][bj][m][n] = __builtin_amdgcn_mfma_f32_16x16x32_bf16(Bt[n][k], At[m][k], acc[ai][bj][m][n], 0, 0, 0); __builtin_amdgcn_s_setprio(0); } while (0)
#define PG8_WAIT_V(n) asm volatile("s_waitcnt vmcnt(" #n ")" ::: "memory")
#define PG8_WAIT_L(n) asm volatile("s_waitcnt lgkmcnt(" #n ")" ::: "memory")
#define PG8_BAR __builtin_amdgcn_s_barrier()
#define PG8_SCHED __builtin_amdgcn_sched_barrier(0)
    Unit cur, nxt; int ui = 0;
    if (!S.next(0, cur)) return;
    f32x4 acc[2][2][4][2];
#pragma unroll
    for (int a = 0; a < 2; ++a)
#pragma unroll
        for (int b = 0; b < 2; ++b)
#pragma unroll
            for (int m = 0; m < 4; ++m)
#pragma unroll
                for (int n = 0; n < 2; ++n) acc[a][b][m][n] = (f32x4){0.f, 0.f, 0.f, 0.f};
    bf16x8 At[4][2], B0[2][2], B1[2][2];
    const char* cA = (const char*)g.A + (size_t)cur.pm * tstep; const char* cB = (const char*)g.Bt + (size_t)cur.pn * tstep;
    S.a_ready(cur);
    if constexpr (SP2) {
        PG8_STAGE(PG8_SB(0, 0), cB, voffB); PG8_STAGE(PG8_SB(0, 1), cB + hstep, voffB); PG8_STAGE(PG8_SA(0, 0), cA, voffA); PG8_STAGE(PG8_SA(0, 1), cA + hstep, voffA);
        if (wr == 1) PG8_BAR;
        PG8_WAIT_V(2); PG8_BAR;
        PG8_STAGE(PG8_SB(1, 0), cB + kstep, voffB); PG8_STAGE(PG8_SA(1, 0), cA + kstep, voffA); PG8_STAGE(PG8_SB(1, 1), cB + hstep + kstep, voffB);
        PG8_WAIT_V(6); PG8_BAR;
    } else {
        PG8_STAGE(PG8_SB(0, 0), cB, voffB); PG8_STAGE(PG8_SA(0, 0), cA, voffA); PG8_STAGE(PG8_SB(0, 1), cB + hstep, voffB); PG8_STAGE(PG8_SA(0, 1), cA + hstep, voffA);
        if (wr == 1) PG8_BAR;
        PG8_WAIT_V(4); PG8_BAR;
        PG8_STAGE(PG8_SB(1, 0), cB + kstep, voffB); PG8_STAGE(PG8_SA(1, 0), cA + kstep, voffA); PG8_STAGE(PG8_SB(1, 1), cB + hstep + kstep, voffB);
        PG8_WAIT_V(6); PG8_BAR;
    }
    for (;;) {
        const bool has_next = S.next(ui + 1, nxt);
        const char* nA = has_next ? (const char*)g.A + (size_t)nxt.pm * tstep : cA; const char* nB = has_next ? (const char*)g.Bt + (size_t)nxt.pn * tstep : cB;
        for (int t = 0; t < nt; t += 2) {
            const bool last = (t == nt - 2);
            const char* a1 = cA + (size_t)(t + 1) * kstep;
            const char* a2 = last ? nA : cA + (size_t)(t + 2) * kstep; const char* b2 = last ? nB : cB + (size_t)(t + 2) * kstep;
            const char* a3 = a2 + kstep; const char* b3 = b2 + kstep;
            if (last && has_next) S.a_ready(nxt);
            if constexpr (SP2) {
            PG8_LDB(B0, 0, 0); PG8_LDB(B1, 0, 1); PG8_SCHED; PG8_LDA(At, 0, 0); PG8_STAGE(PG8_SA(1, 1), a1 + hstep, voffA);
            PG8_WAIT_V(8); PG8_WAIT_L(0); PG8_BAR; PG8_MMA(0, 0, At, B0); PG8_MMA(0, 1, At, B1); PG8_BAR; PG8_SCHED;
            PG8_LDA(At, 0, 1); PG8_STAGE(PG8_SB(0, 0), b2, voffB); PG8_STAGE(PG8_SB(0, 1), b2 + hstep, voffB); PG8_STAGE(PG8_SA(0, 0), a2, voffA);
            PG8_WAIT_V(8); PG8_WAIT_L(0); PG8_BAR; PG8_MMA(1, 0, At, B0); PG8_MMA(1, 1, At, B1); PG8_BAR; PG8_SCHED;
            PG8_LDB(B0, 1, 0); PG8_LDB(B1, 1, 1); PG8_SCHED; PG8_LDA(At, 1, 0); PG8_STAGE(PG8_SA(0, 1), a2 + hstep, voffA);
            PG8_WAIT_V(8); PG8_WAIT_L(0); PG8_BAR; PG8_MMA(0, 0, At, B0); PG8_MMA(0, 1, At, B1); PG8_BAR; PG8_SCHED;
            PG8_LDA(At, 1, 1); PG8_STAGE(PG8_SB(1, 0), b3, voffB); PG8_STAGE(PG8_SB(1, 1), b3 + hstep, voffB); PG8_STAGE(PG8_SA(1, 0), a3, voffA);
            PG8_WAIT_V(8); PG8_WAIT_L(0); PG8_BAR; PG8_MMA(1, 0, At, B0); PG8_MMA(1, 1, At, B1); PG8_BAR; PG8_SCHED;
            } else {
            PG8_LDB(B0, 0, 0); PG8_SCHED; PG8_LDA(At, 0, 0); PG8_STAGE(PG8_SA(1, 1), a1 + hstep, voffA);
            PG8_WAIT_L(8); PG8_BAR; PG8_WAIT_L(0); PG8_MMA(0, 0, At, B0); PG8_BAR; PG8_SCHED;
            PG8_LDB(B1, 0, 1); PG8_STAGE(PG8_SB(0, 0), b2, voffB);
            PG8_BAR; PG8_WAIT_L(0); PG8_MMA(0, 1, At, B1); PG8_BAR;
            PG8_LDA(At, 0, 1); PG8_STAGE(PG8_SA(0, 0), a2, voffA);
            PG8_BAR; PG8_WAIT_L(0); PG8_MMA(1, 0, At, B0); PG8_BAR; PG8_SCHED;
            PG8_STAGE(PG8_SB(0, 1), b2 + hstep, voffB);
            PG8_WAIT_V(6); PG8_BAR; PG8_MMA(1, 1, At, B1); PG8_BAR;
            PG8_LDB(B0, 1, 0); PG8_SCHED; PG8_LDA(At, 1, 0); PG8_STAGE(PG8_SA(0, 1), a2 + hstep, voffA);
            PG8_WAIT_L(8); PG8_BAR; PG8_WAIT_L(0); PG8_MMA(0, 0, At, B0); PG8_BAR; PG8_SCHED;
            PG8_LDB(B1, 1, 1); PG8_STAGE(PG8_SB(1, 0), b3, voffB);
            PG8_BAR; PG8_WAIT_L(0); PG8_MMA(0, 1, At, B1); PG8_BAR;
            PG8_LDA(At, 1, 1); PG8_STAGE(PG8_SA(1, 0), a3, voffA);
            PG8_BAR; PG8_WAIT_L(0); PG8_MMA(1, 0, At, B0); PG8_BAR; PG8_SCHED;
            PG8_STAGE(PG8_SB(1, 1), b3 + hstep, voffB);
            PG8_WAIT_V(6); PG8_BAR; PG8_MMA(1, 1, At, B1); PG8_BAR;
            }
        }
        if constexpr (ALIGN_EPI) { if (wr == 0) PG8_BAR; }
        if constexpr (!Epi::AFTER_DRAIN) { E(acc, cur, wr, wc, fr, fq); S.done(cur); }
        if (!has_next) break;
#pragma unroll
        for (int a = 0; a < 2; ++a)
#pragma unroll
            for (int b = 0; b < 2; ++b)
#pragma unroll
                for (int m = 0; m < 4; ++m)
#pragma unroll
                    for (int n = 0; n < 2; ++n) acc[a][b][m][n] = (f32x4){0.f, 0.f, 0.f, 0.f};
        cur = nxt; cA = nA; cB = nB; ++ui;
        if constexpr (ALIGN_EPI) { if (wr == 1) PG8_BAR; }
    }
    PG8_WAIT_V(0);
    if constexpr (!ALIGN_EPI) { if (wr == 0) PG8_BAR; }
    PG8_BAR;
    if constexpr (Epi::AFTER_DRAIN) { E.fused(acc, cur, wr, wc, fr, fq, lds, wid, lane); S.done(cur); }
#undef PG8_SA
#undef PG8_SB
#undef PG8_STAGE
#undef PG8_LDA
#undef PG8_LDB
#undef PG8_MMA
#undef PG8_WAIT_V
#undef PG8_WAIT_L
#undef PG8_BAR
#undef PG8_SCHED
}
}
#define LAS __attribute__((address_space(3)))
typedef unsigned short bf16;
typedef unsigned v4u __attribute__((ext_vector_type(4)));
typedef unsigned v2u __attribute__((ext_vector_type(2)));
typedef float f32x4 __attribute__((ext_vector_type(4)));
typedef short bf16x8 __attribute__((ext_vector_type(8)));
constexpr int DM = 1024, SEQ = 2048, MP = 16384, NS = 128, MV = MP + NS, MPAD = 16640;
constexpr int DQKV = 3072, INCOLS = 10256, NIN = 10240;
constexpr float EPS = 1e-6f;
constexpr size_t KiB = 1024, MiB = 1u << 20;
constexpr size_t WS_CTL = 0, CTL_BYTES = 64 * KiB;
constexpr size_t WS_MOD = 64 * KiB;
constexpr size_t WS_BA = 2 * MiB;
constexpr size_t WS_GL = 3 * MiB + 256 * KiB;
constexpr size_t WS_WA = 3 * MiB + 512 * KiB, WS_WB = WS_WA + 2 * MiB, WS_WO = WS_WB + 2 * MiB, WS_WIN = WS_WO + 2 * MiB;
constexpr size_t WS_BUF = WS_WIN + 20 * MiB;
constexpr size_t BUF_BYTES = (size_t)MV * 1024 * 2;
constexpr size_t WS_END = WS_BUF + 7 * BUF_BYTES + 512 * KiB;
static_assert(WS_END <= 256 * MiB, "ws map");
constexpr size_t O_YP = 0, O_YS = 16777216, O_NCAP = O_YS + 131072, O_NCQP = O_NCAP + 16384, O_NDP = O_NCQP + 73728,
                 O_NCAS = O_NDP + 1048576, O_NCQS = O_NCAS + 262144, O_NDS = O_NCQS + 1179648, O_END = O_NDS + 16777216;
constexpr int CW_BAR = 4096;
constexpr int LDS_BYTES = 163840, MISC_OFF = LDS_BYTES - 64;

typedef float f32x2v __attribute__((ext_vector_type(2)));
typedef __bf16 bf16x2v __attribute__((ext_vector_type(2)));
__device__ __forceinline__ unsigned pkbf(float lo, float hi) { return pg8::cvt_pk_bf16(lo, hi); }
__device__ __forceinline__ unsigned pk2(float lo, float hi) { const f32x2v v = {lo, hi}; return __builtin_bit_cast(unsigned, __builtin_convertvector(v, bf16x2v)); }
__device__ __forceinline__ float bflo(unsigned u) { return __uint_as_float(u << 16); }
__device__ __forceinline__ float bfhi(unsigned u) { return __uint_as_float(u & 0xffff0000u); }
__device__ __forceinline__ float bf1(unsigned short b) { return __uint_as_float((unsigned)b << 16); }
__device__ __forceinline__ unsigned short f2bf1(float f) { return (unsigned short)(pkbf(f, 0.f) & 0xffffu); }
__device__ __forceinline__ float sigm(float x) { return __builtin_amdgcn_rcpf(1.f + __expf(-x)); }
__device__ __forceinline__ float silu(float x) { return x * sigm(x); }
__device__ __forceinline__ f32x4 silu4(f32x4 v) { return (f32x4){silu(v[0]), silu(v[1]), silu(v[2]), silu(v[3])}; }
__device__ __forceinline__ f32x4 sigm4(f32x4 v) { return (f32x4){sigm(v[0]), sigm(v[1]), sigm(v[2]), sigm(v[3])}; }
__device__ __forceinline__ void unpack8(v4u u, float* f) { f[0] = bflo(u.x); f[1] = bfhi(u.x); f[2] = bflo(u.y); f[3] = bfhi(u.y); f[4] = bflo(u.z); f[5] = bfhi(u.z); f[6] = bflo(u.w); f[7] = bfhi(u.w); }
__device__ __forceinline__ v4u pack8(const float* f) { v4u o; o.x = pkbf(f[0], f[1]); o.y = pkbf(f[2], f[3]); o.z = pkbf(f[4], f[5]); o.w = pkbf(f[6], f[7]); return o; }
__device__ __forceinline__ v2u pack4(f32x4 v) { v2u o; o.x = pkbf(v[0], v[1]); o.y = pkbf(v[2], v[3]); return o; }
__device__ __forceinline__ float dpp_row_shr(float v, int n) {
    const int iv = __builtin_bit_cast(int, v); int r;
    switch (n) { case 1: r = __builtin_amdgcn_update_dpp(0, iv, 0x111, 0xf, 0xf, true); break; case 2: r = __builtin_amdgcn_update_dpp(0, iv, 0x112, 0xf, 0xf, true); break;
                 case 4: r = __builtin_amdgcn_update_dpp(0, iv, 0x114, 0xf, 0xf, true); break; default: r = __builtin_amdgcn_update_dpp(0, iv, 0x118, 0xf, 0xf, true); break; }
    return __builtin_bit_cast(float, r);
}
__device__ __forceinline__ float wave_sum(float v) {
    v += dpp_row_shr(v, 1); v += dpp_row_shr(v, 2); v += dpp_row_shr(v, 4); v += dpp_row_shr(v, 8);
    v += __builtin_bit_cast(float, __builtin_amdgcn_update_dpp(0, __builtin_bit_cast(int, v), 0x142, 0xa, 0xf, false));
    v += __builtin_bit_cast(float, __builtin_amdgcn_update_dpp(0, __builtin_bit_cast(int, v), 0x143, 0xc, 0xf, false));
    return __uint_as_float(__builtin_amdgcn_readlane(__float_as_uint(v), 63));
}
__device__ __forceinline__ float row16_sum(float v) {
    v += __builtin_bit_cast(float, __builtin_amdgcn_update_dpp(0, __builtin_bit_cast(int, v), 0xB1, 0xf, 0xf, false));
    v += __builtin_bit_cast(float, __builtin_amdgcn_update_dpp(0, __builtin_bit_cast(int, v), 0x4E, 0xf, 0xf, false));
    v += __builtin_bit_cast(float, __builtin_amdgcn_update_dpp(0, __builtin_bit_cast(int, v), 0x141, 0xf, 0xf, false));
    v += __builtin_bit_cast(float, __builtin_amdgcn_update_dpp(0, __builtin_bit_cast(int, v), 0x140, 0xf, 0xf, false));
    return v;
}
#define LDS_WAIT() asm volatile("s_waitcnt lgkmcnt(0)" ::: "memory")

struct EpiIn {
    static constexpr bool PERM = true, AFTER_DRAIN = false;
    bf16 *U, *GA, *QKV, *ZB, *SGA, *SGB, *UH;
    __device__ __forceinline__ void operator()(const f32x4 (&acc)[2][2][4][2], const pg8::Unit& u, int wr, int wc, int fr, int fq) const {
        const int row0 = u.pm * 256 + wr * 64 + fr, cl = wc * 32 + 8 * fq, pn = u.pn;
        if (pn < 16) {
            bf16* base = (pn < 8 ? U : GA) + 128 * (pn & 7) + cl;
#pragma unroll
            for (int ai = 0; ai < 2; ++ai)
#pragma unroll
                for (int m = 0; m < 4; ++m) {
                    const int row = row0 + ai * 128 + m * 16;
                    if (row < MV) {
                        f32x4 a0 = acc[ai][0][m][0], a1 = acc[ai][0][m][1], b0 = acc[ai][1][m][0], b1 = acc[ai][1][m][1];
                        if (pn >= 8) { b0 = silu4(b0); b1 = silu4(b1); }
                        a0 = a0 * b0; a1 = a1 * b1;
                        v4u w; w.x = pkbf(a0[0], a0[1]); w.y = pkbf(a0[2], a0[3]); w.z = pkbf(a1[0], a1[1]); w.w = pkbf(a1[2], a1[3]);
                        *(v4u*)(base + (size_t)row * 1024) = w;
                        if (pn < 8 && (row & 7) >= 6 && row < MP) *(v4u*)(UH + ((size_t)(row >> 3) * 2 + ((row & 7) - 6)) * 1024 + 128 * (pn & 7) + cl) = w;
                    }
                }
        } else {
            bf16* base; int ldc, act;
            if (pn < 28) { base = QKV + 256 * (pn - 16); ldc = 3072; act = 0; }
            else if (pn < 32) { base = ZB + 256 * (pn - 28); ldc = 1024; act = 1; }
            else if (pn < 36) { base = SGA + 256 * (pn - 32); ldc = 1024; act = 2; }
            else { base = SGB + 256 * (pn - 36); ldc = 1024; act = 2; }
            base += cl;
#pragma unroll
            for (int ai = 0; ai < 2; ++ai)
#pragma unroll
                for (int m = 0; m < 4; ++m) {
                    const int row = row0 + ai * 128 + m * 16;
                    if (row < MV) {
#pragma unroll
                        for (int bj = 0; bj < 2; ++bj) {
                            f32x4 v0 = acc[ai][bj][m][0], v1 = acc[ai][bj][m][1];
                            if (act == 1) { v0 = silu4(v0); v1 = silu4(v1); } else if (act == 2) { v0 = sigm4(v0); v1 = sigm4(v1); }
                            v4u w; w.x = pkbf(v0[0], v0[1]); w.y = pkbf(v0[2], v0[3]); w.z = pkbf(v1[0], v1[1]); w.w = pkbf(v1[2], v1[3]);
                            *(v4u*)(base + (size_t)row * ldc + bj * 128) = w;
                        }
                    }
                }
        }
    }
};
template <class F> struct EpiEl {
    static constexpr bool PERM = true, AFTER_DRAIN = false;
    F f;
    __device__ __forceinline__ void operator()(const f32x4 (&acc)[2][2][4][2], const pg8::Unit& u, int wr, int wc, int fr, int fq) const {
        const int row0 = u.pm * 256 + wr * 64 + fr, col0 = u.pn * 256 + wc * 32 + 8 * fq;
#pragma unroll
        for (int ai = 0; ai < 2; ++ai) {
            typename F::Ops ops[4][2];
#pragma unroll
            for (int m = 0; m < 4; ++m)
#pragma unroll
                for (int bj = 0; bj < 2; ++bj) ops[m][bj] = f.load8(row0 + ai * 128 + m * 16, col0 + bj * 128);
#pragma unroll
            for (int m = 0; m < 4; ++m)
#pragma unroll
                for (int bj = 0; bj < 2; ++bj) f.store8(row0 + ai * 128 + m * 16, col0 + bj * 128, acc[ai][bj][m][0], acc[ai][bj][m][1], ops[m][bj]);
        }
    }
};
struct FOutA { const bf16* SG; bf16* TMP;
    struct Ops { v4u sg; };
    __device__ __forceinline__ Ops load8(int row, int col) const { Ops o; o.sg = *(const v4u*)(SG + (size_t)row * 1024 + col); return o; }
    __device__ __forceinline__ void store8(int row, int col, f32x4 v0, f32x4 v1, const Ops& p) const { float sg[8]; unpack8(p.sg, sg);
        const float r[8] = {sg[0] * v0[0], sg[1] * v0[1], sg[2] * v0[2], sg[3] * v0[3], sg[4] * v1[0], sg[5] * v1[1], sg[6] * v1[2], sg[7] * v1[3]}; *(v4u*)(TMP + (size_t)row * 1024 + col) = pack8(r); }
    __device__ __forceinline__ void operator()(int row, int col, f32x4 v) const { const size_t o = (size_t)row * 1024 + col; const v2u s = *(const v2u*)(SG + o);
        f32x4 r = {bflo(s.x) * v[0], bfhi(s.x) * v[1], bflo(s.y) * v[2], bfhi(s.y) * v[3]}; *(v2u*)(TMP + o) = pack4(r); } };
struct FOutB { const bf16* SG; const bf16* TIN; bf16* TMP;
    struct Ops { v4u sg, t; };
    __device__ __forceinline__ Ops load8(int row, int col) const { Ops o; o.sg = *(const v4u*)(SG + (size_t)row * 1024 + col); o.t = *(const v4u*)(TIN + (size_t)row * 1024 + col); return o; }
    __device__ __forceinline__ void store8(int row, int col, f32x4 v0, f32x4 v1, const Ops& p) const { float sg[8], t[8]; unpack8(p.sg, sg); unpack8(p.t, t);
        const float r[8] = {t[0] + sg[0] * v0[0], t[1] + sg[1] * v0[1], t[2] + sg[2] * v0[2], t[3] + sg[3] * v0[3], t[4] + sg[4] * v1[0], t[5] + sg[5] * v1[1], t[6] + sg[6] * v1[2], t[7] + sg[7] * v1[3]}; *(v4u*)(TMP + (size_t)row * 1024 + col) = pack8(r); }
    __device__ __forceinline__ void operator()(int row, int col, f32x4 v) const { const size_t o = (size_t)row * 1024 + col; const v2u s = *(const v2u*)(SG + o); const v2u t = *(const v2u*)(TIN + o);
        f32x4 r = {bflo(t.x) + bflo(s.x) * v[0], bfhi(t.x) + bfhi(s.x) * v[1], bflo(t.y) + bflo(s.y) * v[2], bfhi(t.y) + bfhi(s.y) * v[3]}; *(v2u*)(TMP + o) = pack4(r); } };
struct FPlain { bf16* T;
    struct Ops { int dummy; };
    __device__ __forceinline__ Ops load8(int, int) const { return Ops{0}; }
    __device__ __forceinline__ void store8(int row, int col, f32x4 v0, f32x4 v1, const Ops&) const { const float r[8] = {v0[0], v0[1], v0[2], v0[3], v1[0], v1[1], v1[2], v1[3]}; *(v4u*)(T + (size_t)row * 1024 + col) = pack8(r); }
    __device__ __forceinline__ void operator()(int row, int col, f32x4 v) const { *(v2u*)(T + (size_t)row * 1024 + col) = pack4(v); } };


template <class F> __device__ __forceinline__ void small_gemm_wg(LAS unsigned char* L, const bf16* A, const bf16* Bt, int rowbase, const F& f, int wg, int nwg, int tid) {
    const int lane = tid & 63, w = tid >> 6;
    LAS f32x4* part = (LAS f32x4*)L;
    for (int tile = wg; tile < 512; tile += nwg) {
        const int rt = tile & 7, ct = tile >> 3;
        const bf16* ap = A + (size_t)(rowbase + rt * 16 + (lane & 15)) * 1024 + 8 * (lane >> 4) + 128 * w;
        const bf16* bp = Bt + (size_t)(ct * 16 + (lane & 15)) * 1024 + 8 * (lane >> 4) + 128 * w;
        bf16x8 a[4], b[4];
#pragma unroll
        for (int s = 0; s < 4; ++s) { a[s] = *(const bf16x8*)(ap + 32 * s); b[s] = *(const bf16x8*)(bp + 32 * s); }
        f32x4 acc = {0.f, 0.f, 0.f, 0.f};
#pragma unroll
        for (int s = 0; s < 4; ++s) acc = __builtin_amdgcn_mfma_f32_16x16x32_bf16(b[s], a[s], acc, 0, 0, 0);
        part[w * 64 + lane] = acc;
        __syncthreads();
        if (w == 0) { f32x4 t = part[lane];
#pragma unroll
            for (int ww = 1; ww < 8; ++ww) t += part[ww * 64 + lane];
            f(rowbase + rt * 16 + (lane & 15), ct * 16 + 4 * (lane >> 4), t); }
        __syncthreads();
    }
}
template <class F> __device__ __forceinline__ void small_gemm(const bf16* A, const bf16* Bt, int rowbase, const F& f, int gw, int NGW, int lane) {
    for (int task = gw; task < 512; task += NGW) {
        const int rt = task & 7, ct = task >> 3;
        const bf16* ap = A + (size_t)(rowbase + rt * 16 + (lane & 15)) * 1024 + 8 * (lane >> 4);
        const bf16* bp = Bt + (size_t)(ct * 16 + (lane & 15)) * 1024 + 8 * (lane >> 4);
        f32x4 acc = {0.f, 0.f, 0.f, 0.f};
#pragma unroll 8
        for (int s = 0; s < 32; ++s) { const bf16x8 a = *(const bf16x8*)(ap + 32 * s), b = *(const bf16x8*)(bp + 32 * s); acc = __builtin_amdgcn_mfma_f32_16x16x32_bf16(b, a, acc, 0, 0, 0); }
        f(rowbase + rt * 16 + (lane & 15), ct * 16 + 4 * (lane >> 4), acc);
    }
}
#define XB_TMO      128
#define XB_XCNT(j)  (256  + 64 * (j))
#define XB_XSUB(j)  (1280 + 64 * (j))
#define XB_XGEN(j)  (2304 + 64 * (j))
#define XB_TOP      3328
#define XB_TOPGEN   3392
#define XCD_BAR_WORDS 3456
#define XB_SPIN_CAP (1u << 18)

__device__ __forceinline__ unsigned xb_ld(unsigned* p)              { return __hip_atomic_load(p, __ATOMIC_RELAXED, __HIP_MEMORY_SCOPE_AGENT); }
__device__ __forceinline__ unsigned xb_add(unsigned* p, unsigned v) { return __hip_atomic_fetch_add(p, v, __ATOMIC_RELAXED, __HIP_MEMORY_SCOPE_AGENT); }
__device__ __forceinline__ unsigned xb_xcc_id() { return (unsigned)__builtin_amdgcn_s_getreg((3 << 11) | 20) & 0xFu; }
#define XB_SPIN(cond, bar) do { unsigned _sp = 0; while (cond) { __builtin_amdgcn_s_sleep(1); \
    if ((++_sp & 255u) == 0u) { if (xb_ld(&(bar)[XB_TMO])) break; if (_sp > XB_SPIN_CAP) { atomicAdd(&(bar)[XB_TMO], 1u); break; } } } } while (0)

struct XcdBarrier {
    unsigned* bar; unsigned x;
    volatile LAS unsigned* st;
};

__device__ __forceinline__ XcdBarrier xcd_barrier_post(unsigned* bar, volatile LAS unsigned* st) {
    XcdBarrier b; b.bar = bar; b.x = xb_xcc_id(); b.st = st;
    if (threadIdx.x == 0) (void)xb_add(&bar[XB_XCNT(b.x)], 1u);
    return b;
}
__device__ __forceinline__ void xcd_barrier_complete(unsigned* bar, unsigned x, unsigned& nloc, unsigned& nx) {
    const unsigned G = gridDim.x * gridDim.y * gridDim.z;
    unsigned sum, cnt, mine, sp = 0u;
    for (;;) {
        sum = 0u; cnt = 0u; mine = 0u;
#pragma unroll
        for (unsigned j = 0; j < 16; ++j) { const unsigned c = xb_ld(&bar[XB_XCNT(j)]); sum += c; cnt += (c > 0u) ? 1u : 0u; mine = (j == x) ? c : mine; }
        if (sum == G) break;
        __builtin_amdgcn_s_sleep(1);
        if ((++sp & 255u) == 0u) { if (xb_ld(&bar[XB_TMO])) break; if (sp > XB_SPIN_CAP) { atomicAdd(&bar[XB_TMO], 1u); break; } }
    }
    nloc = mine > 0u ? mine : 1u; nx = cnt > 0u ? cnt : 1u;
}

__device__ __forceinline__ void xcd_barrier(const XcdBarrier& b) {
    asm volatile("s_waitcnt vmcnt(0)" ::: "memory");
    __syncthreads();
    if (threadIdx.x == 0) {
        unsigned* bar = b.bar;
        __builtin_amdgcn_s_waitcnt(0);
        unsigned nloc = b.st[0], nx = b.st[1];
        if (nloc == 0u) { xcd_barrier_complete(bar, b.x, nloc, nx); b.st[0] = nloc; b.st[1] = nx; }
        const unsigned old = xb_add(&bar[XB_XSUB(b.x)], 1u);
        const unsigned gen = old / nloc;
        if (old + 1u == (gen + 1u) * nloc) {
            __builtin_amdgcn_fence(__ATOMIC_RELEASE, "agent");
            asm volatile("s_waitcnt vmcnt(0)" ::: "memory");
            const unsigned og = xb_add(&bar[XB_TOP], 1u);
            const unsigned tg = og / nx;
            if (og + 1u == (tg + 1u) * nx) xb_add(&bar[XB_TOPGEN], 1u);
            else XB_SPIN(xb_ld(&bar[XB_TOPGEN]) == tg, bar);
            __builtin_amdgcn_fence(__ATOMIC_ACQUIRE, "agent");
            xb_add(&bar[XB_XGEN(b.x)], 1u);
            asm volatile("s_waitcnt vmcnt(0)" ::: "memory");
        } else {
            XB_SPIN(xb_ld(&bar[XB_XGEN(b.x)]) == gen, bar);
            __builtin_amdgcn_fence(__ATOMIC_ACQUIRE, "agent");
            asm volatile("s_waitcnt vmcnt(0)" ::: "memory");
        }
    }
    __syncthreads();
}
__device__ __forceinline__ void p0_transpose_item(const float* W, int ldw, int srccol0, int k0, bf16* WT, int K, int dstrow0, LAS float* scr, int lane) {
    float tv[32];
#pragma unroll
    for (int i = 0; i < 32; ++i) tv[i] = __builtin_nontemporal_load(W + (size_t)(k0 + 2 * i + (lane >> 5)) * ldw + srccol0 + (lane & 31));
#pragma unroll
    for (int i = 0; i < 32; ++i) scr[(2 * i + (lane >> 5)) * 33 + (lane & 31)] = tv[i];
    LDS_WAIT();
    const int c = lane & 7;
#pragma unroll
    for (int j = 0; j < 4; ++j) { const int n = (lane >> 3) + 8 * j; const LAS float* s = scr + (8 * c) * 33 + n;
        v4u o; o.x = pkbf(s[0 * 33], s[1 * 33]); o.y = pkbf(s[2 * 33], s[3 * 33]); o.z = pkbf(s[4 * 33], s[5 * 33]); o.w = pkbf(s[6 * 33], s[7 * 33]);
        *(v4u*)(WT + (size_t)(dstrow0 + n) * K + k0 + 8 * c) = o; }
    LDS_WAIT();
}
__device__ __forceinline__ int win_src_col(int n0) {
    if (n0 < 4096) { const int t = n0 >> 8, half = (n0 >> 7) & 1, ch = 128 * (t & 7) + (n0 & 127); const int blk = (t < 8) ? half : 2 + half; return blk * 1024 + ch; }
    if (n0 < 8192) return n0;
    return n0 + 16;
}
__device__ __forceinline__ void p0_mod_task(const float* cp, const float* cs, const float* ada_w, const float* ada_b, float* MOD, LAS float* sc, int task, int lane) {
    const int cgi = task % 48, rgi = task / 48, col = cgi * 64 + lane, r0 = rgi * 17;
    float acc[17];
#pragma unroll
    for (int r = 0; r < 17; ++r) acc[r] = 0.f;
    for (int k0 = 0; k0 < 1024; k0 += 128) {
        for (int i = 0; i < 34; ++i) { const int idx = i * 64 + lane, r = idx >> 7, kk = idx & 127, rr = r0 + r;
            const float* crow = rr < 8 ? cp + rr * 1024 : cs + (rr - 8) * 1024; const float v = crow[k0 + kk]; sc[idx] = silu(v); }
        LDS_WAIT();
        for (int kk = 0; kk < 128; kk += 4) {
            const float* wp = ada_w + (size_t)(k0 + kk) * 3072 + col;
            const float w0 = wp[0], w1 = wp[3072], w2 = wp[2 * 3072], w3 = wp[3 * 3072];
#pragma unroll
            for (int r = 0; r < 17; ++r) { const f32x4 c4 = *(const LAS f32x4*)(sc + r * 128 + kk); acc[r] += (c4[0] * w0 + c4[1] * w1) + (c4[2] * w2 + c4[3] * w3); }
        }
        LDS_WAIT();
    }
    const float bb = ada_b[col];
#pragma unroll
    for (int r = 0; r < 17; ++r) MOD[(size_t)(r0 + r) * 3072 + col] = acc[r] + bb;
}

__device__ __forceinline__ void phase_mod(const float* const* in, unsigned char* ws, int gwave, int nwaves, int lane) {
    const float* cp = in[2]; const float* cs = in[3]; const float* ada_w = in[7]; const float* ada_b = in[8]; float* MOD = (float*)(ws + WS_MOD);
    const int g = lane >> 4, col = lane & 15;
    for (int task = gwave; task < 576; task += nwaves) {
        const int nt = task % 192, mg = task / 192;
        f32x4 acc[3]; const float* arow[3]; bool av[3];
#pragma unroll
        for (int t = 0; t < 3; ++t) { acc[t] = (f32x4){0.f, 0.f, 0.f, 0.f}; const int row = 48 * mg + 16 * t + col; av[t] = row < 136; const int rr = av[t] ? row : 0; arow[t] = rr < 8 ? cp + rr * 1024 : cs + (rr - 8) * 1024; }
#pragma unroll 2
        for (int s = 0; s < 32; ++s) {
            const int k = 32 * s + 8 * g; float wv[8];
#pragma unroll
            for (int j = 0; j < 8; ++j) wv[j] = ada_w[(size_t)(k + j) * 3072 + 16 * nt + col];
            v4u bt; bt.x = pk2(wv[0], wv[1]); bt.y = pk2(wv[2], wv[3]); bt.z = pk2(wv[4], wv[5]); bt.w = pk2(wv[6], wv[7]);
            const bf16x8 bfrag = __builtin_bit_cast(bf16x8, bt);
#pragma unroll
            for (int t = 0; t < 3; ++t) { f32x4 a0 = *(const f32x4*)(arow[t] + k), a1 = *(const f32x4*)(arow[t] + k + 4);
                a0 = silu4(a0); a1 = silu4(a1); if (!av[t]) { a0 = (f32x4){0.f, 0.f, 0.f, 0.f}; a1 = a0; }
                v4u at; at.x = pk2(a0[0], a0[1]); at.y = pk2(a0[2], a0[3]); at.z = pk2(a1[0], a1[1]); at.w = pk2(a1[2], a1[3]);
                acc[t] = __builtin_amdgcn_mfma_f32_16x16x32_bf16(__builtin_bit_cast(bf16x8, at), bfrag, acc[t], 0, 0, 0); }
        }
        const float bb = ada_b[16 * nt + col];
#pragma unroll
        for (int t = 0; t < 3; ++t)
#pragma unroll
            for (int r = 0; r < 4; ++r) { const int row = 48 * mg + 16 * t + 4 * g + r; if (row < 136) MOD[(size_t)row * 3072 + 16 * nt + col] = acc[t][r] + bb; }
    }
}
__device__ __forceinline__ void phase0(LAS unsigned char* L, const float* const* in, unsigned char* ws, int vcu, int G, int tid) {
    const int lane = tid & 63, wave = __builtin_amdgcn_readfirstlane(tid >> 6);
    LAS float* scr = (LAS float*)(L + wave * 16384);
    const int ntask_w2 = 576 - 2 * G;
    if (wave < 2 || (wave == 2 && vcu < ntask_w2)) return;
    const int gw = (wave >= 3) ? (wave - 3) * G + vcu : 5 * G + (vcu - ntask_w2), NGW = 5 * G + (G - ntask_w2);
    constexpr int I_IN = 16 * 320, I_SQ = 16 * 32;
    for (int it = gw; it < I_IN + 3 * I_SQ; it += NGW) {
        int r = it;
        if (r < I_IN) { const int kb = r / 320, nb = r % 320; p0_transpose_item(in[10], INCOLS, win_src_col(nb * 32), kb * 64, (bf16*)(ws + WS_WIN), 1024, nb * 32, scr, lane); continue; }
        r -= I_IN; const int which = r / I_SQ; r -= which * I_SQ; const int kb = r / 32, nb = r % 32;
        const float* W = which == 0 ? in[16] : (which == 1 ? in[17] : in[18]);
        bf16* WT = (bf16*)(ws + (which == 0 ? WS_WA : (which == 1 ? WS_WB : WS_WO)));
        p0_transpose_item(W, 1024, nb * 32, kb * 64, WT, 1024, nb * 32, scr, lane);
    }
}
__device__ __forceinline__ void phase1(LAS unsigned char* L, const float* const* in, unsigned char* ws, int vcu, int G, int tid) {
    const int lane = tid & 63, wave = tid >> 6;
    LAS float* wba = (LAS float*)L;
    const float* w_in = in[10];
    {
        f32x4 wv[8];
#pragma unroll
        for (int i = 0; i < 8; ++i) { const int idx = tid + 512 * i, k = idx >> 2, q = idx & 3; wv[i] = *(const f32x4*)(w_in + (size_t)k * INCOLS + 8192 + 4 * q); }
#pragma unroll
        for (int i = 0; i < 8; ++i) { const int idx = tid + 512 * i, k = idx >> 2, q = idx & 3;
#pragma unroll
            for (int e = 0; e < 4; ++e) wba[(4 * q + e) * 1024 + k] = wv[i][e]; }
    }
    __syncthreads();
    const float* MOD = (const float*)(ws + WS_MOD); float* BA = (float*)(ws + WS_BA); bf16* H = (bf16*)(ws + WS_BUF);
    const float* npre = in[9];
    float alog = 0.f, dtb = 0.f; if (lane >= 8 && lane < 16) { alog = in[13][lane - 8]; dtb = in[14][lane - 8]; }
    const int gw = vcu * 8 + wave, NGW = G * 8;
    f32x4 np[4];
#pragma unroll
    for (int j = 0; j < 4; ++j) np[j] = *(const f32x4*)(npre + 4 * lane + 256 * j);
    const int nblk = MP / 8;
    for (int blk = gw; blk < nblk + 16 * NS; blk += NGW) {
        const bool samp = blk >= nblk;
        if (samp && ((blk - nblk) & 15)) continue;
        const int sidx = (blk - nblk) >> 4;
        const int m0 = samp ? MP + sidx : blk * 8, nrow = samp ? 1 : 8;
        const int mr = samp ? 8 + sidx : (m0 >> 11);
        const float* xr = samp ? in[1] + (size_t)sidx * 1024 : in[0] + (size_t)m0 * 1024;
        f32x4 sh[4], sc[4], nx[4];
#pragma unroll
        for (int j = 0; j < 4; ++j) { const int k = 4 * lane + 256 * j; nx[j] = __builtin_nontemporal_load((const f32x4*)(xr + k)); sh[j] = *(const f32x4*)(MOD + (size_t)mr * 3072 + k); sc[j] = (*(const f32x4*)(MOD + (size_t)mr * 3072 + 1024 + k) + 1.f) * np[j]; }
        for (int r = 0; r < nrow; ++r) {
            const int m = m0 + r;
            f32x4 v[4]; float ss = 0.f;
#pragma unroll
            for (int j = 0; j < 4; ++j) { v[j] = nx[j]; ss += (v[j][0] * v[j][0] + v[j][1] * v[j][1]) + (v[j][2] * v[j][2] + v[j][3] * v[j][3]); }
            { const int rn = (r + 1 < nrow) ? r + 1 : r;
#pragma unroll
                for (int j = 0; j < 4; ++j) nx[j] = __builtin_nontemporal_load((const f32x4*)(xr + (size_t)rn * 1024 + 4 * lane + 256 * j)); }
            const float rstd = rsqrtf(wave_sum(ss) * (1.f / 1024.f) + EPS);
#pragma unroll
            for (int j = 0; j < 4; ++j) { const int k = 4 * lane + 256 * j; v[j] = v[j] * rstd * sc[j] + sh[j]; *(v2u*)(H + (size_t)m * 1024 + k) = pack4(v[j]); }
            float mine = 0.f;
#pragma unroll
            for (int c = 0; c < 16; ++c) { float p = 0.f;
#pragma unroll
                for (int j = 0; j < 4; ++j) { const f32x4 w4 = *(const LAS f32x4*)(wba + c * 1024 + 4 * lane + 256 * j); p += (v[j][0] * w4[0] + v[j][1] * w4[1]) + (v[j][2] * w4[2] + v[j][3] * w4[3]); }
                p = wave_sum(p); if (lane == c) mine = p; }
            if (lane < 8) BA[(size_t)m * 16 + lane] = sigm(mine);
            else if (lane < 16) { const float xx = mine + dtb; const float sp = fmaxf(xx, 0.f) + log1pf(__expf(-fabsf(xx))); BA[(size_t)m * 16 + lane] = -__expf(alog) * sp; }
        }
    }
}
__device__ __forceinline__ void branch_a_rest(const bf16* U, bf16* GA, const bf16* UH, const float* caw, int bx, int tid) {
    const bool dry = false; (void)dry;
    {
        const int cgp = tid & 127, col = cgp * 8, q = tid >> 7;
        float w0[8], w1[8], w2[8];
#pragma unroll
        for (int e = 0; e < 8; ++e) { w0[e] = caw[col + e]; w1[e] = caw[1024 + col + e]; w2[e] = caw[2048 + col + e]; }
        for (int kk = 0; kk < 4; ++kk) {
            const int kq = 1 + q + 2 * kk; if (kq > 7) break;
            const int i = bx + 256 * kq;
            const int r0 = i * 8; const bool zh = (r0 & 2047) == 0;
            float um2[8], um1[8];
            if (zh) {
#pragma unroll
                for (int e = 0; e < 8; ++e) { um2[e] = 0.f; um1[e] = 0.f; }
            } else { unpack8(*(const v4u*)(UH + ((size_t)(i - 1) * 2) * 1024 + col), um2); unpack8(*(const v4u*)(UH + ((size_t)(i - 1) * 2 + 1) * 1024 + col), um1); }
            v4u ur[8], gr[8];
#pragma unroll
            for (int r = 0; r < 8; ++r) { ur[r] = *(const v4u*)(U + (size_t)(r0 + r) * 1024 + col); gr[r] = *(const v4u*)(GA + (size_t)(r0 + r) * 1024 + col); }
#pragma unroll
            for (int r = 0; r < 8; ++r) { float uc[8], ga[8], o[8]; unpack8(ur[r], uc); unpack8(gr[r], ga);
#pragma unroll
                for (int e = 0; e < 8; ++e) { o[e] = ga[e] * (um2[e] * w0[e] + um1[e] * w1[e] + uc[e] * w2[e]); um2[e] = um1[e]; um1[e] = uc[e]; }
                *(v4u*)(GA + (size_t)(r0 + r) * 1024 + col) = pack8(o); }
        }
    }
}
__device__ __forceinline__ void phase3(const float* const* in, unsigned char* ws, float* out, int vcu, int G, int bx, int tid, bool dry = false) {
    const bf16* UH = (const bf16*)(out + O_NDS);
    const bf16* U = (const bf16*)(ws + WS_BUF + 1 * BUF_BYTES); bf16* GA = (bf16*)(ws + WS_BUF + 2 * BUF_BYTES); const bf16* QKV = (const bf16*)(ws + WS_BUF + 3 * BUF_BYTES);
    const float* caw = in[11];
    {
        const int cgp = tid & 127, col = cgp * 8, q = tid >> 7;
        float w0[8], w1[8], w2[8];
#pragma unroll
        for (int e = 0; e < 8; ++e) { w0[e] = caw[col + e]; w1[e] = caw[1024 + col + e]; w2[e] = caw[2048 + col + e]; }
        for (int kk = 0; kk < 1; ++kk) {
            const int i = bx; if (q != 0) break;
            const int r0 = i * 8; const bool zh = (r0 & 2047) == 0;
            float um2[8], um1[8];
            if (zh) {
#pragma unroll
                for (int e = 0; e < 8; ++e) { um2[e] = 0.f; um1[e] = 0.f; }
            } else { unpack8(*(const v4u*)(UH + ((size_t)(i - 1) * 2) * 1024 + col), um2); unpack8(*(const v4u*)(UH + ((size_t)(i - 1) * 2 + 1) * 1024 + col), um1); }
            v4u ur[8], gr[8];
#pragma unroll
            for (int r = 0; r < 8; ++r) { ur[r] = *(const v4u*)(U + (size_t)(r0 + r) * 1024 + col); gr[r] = *(const v4u*)(GA + (size_t)(r0 + r) * 1024 + col); }
#pragma unroll
            for (int r = 0; r < 8; ++r) { float uc[8], ga[8], o[8]; unpack8(ur[r], uc); unpack8(gr[r], ga);
#pragma unroll
                for (int e = 0; e < 8; ++e) { o[e] = ga[e] * (um2[e] * w0[e] + um1[e] * w1[e] + uc[e] * w2[e]); um2[e] = um1[e]; um1[e] = uc[e]; }
                *(v4u*)(GA + (size_t)(r0 + r) * 1024 + col) = pack8(o); }
        }
    }
    const int gt = vcu * 512 + tid, NT = G * 512;
    const float* sca = in[4]; const float* scq = in[5];
    for (int idx = gt; idx < 128 * 1024; idx += NT) {
        const int s = idx >> 10, ch = idx & 1023; const size_t ro = (size_t)(MP + s) * 1024 + ch;
        const float uc = bf1(U[ro]), ga = bf1(GA[ro]);
        const float s0 = sca[(size_t)(s * 2) * 1024 + ch], s1 = sca[(size_t)(s * 2 + 1) * 1024 + ch];
        const float o = ga * (s0 * caw[ch] + s1 * caw[1024 + ch] + uc * caw[2048 + ch]);
        out[O_NCAS + (size_t)(s * 2) * 1024 + ch] = s1; out[O_NCAS + (size_t)(s * 2 + 1) * 1024 + ch] = uc;
        if (!dry) GA[ro] = f2bf1(o);
    }
    for (int idx = gt; idx < 8 * 2 * 128; idx += NT) {
        const int col = (idx & 127) * 8, j = (idx >> 7) & 1, b = idx >> 8; float uc[8]; unpack8(*(const v4u*)(UH + ((size_t)(b * 256 + 255) * 2 + j) * 1024 + col), uc);
#pragma unroll
        for (int e = 0; e < 8; ++e) out[O_NCAP + (size_t)(b * 2 + j) * 1024 + col + e] = uc[e];
    }
}
__device__ __forceinline__ void phase3b(const float* const* in, unsigned char* ws, float* out, int gt, int NT) {
    const bf16* QKV = (const bf16*)(ws + WS_BUF + 3 * BUF_BYTES); const float* scq = in[5];
    for (int idx = gt; idx < 8 * 3 * 384; idx += NT) {
        const int cgq = idx % 384, j = (idx / 384) % 3, b = idx / 1152, col = cgq * 8; float uc[8]; unpack8(*(const v4u*)(QKV + (size_t)(b * 2048 + 2045 + j) * 3072 + col), uc);
#pragma unroll
        for (int e = 0; e < 8; ++e) out[O_NCQP + (size_t)(b * 3 + j) * 3072 + col + e] = uc[e];
    }
    for (int idx = gt; idx < 128 * 3 * 384; idx += NT) {
        const int cgq = idx % 384, j = (idx / 384) % 3, s = idx / 1152, col = cgq * 8; float uc[8];
        if (j < 2) {
#pragma unroll
            for (int e = 0; e < 8; ++e) uc[e] = scq[(size_t)(s * 3 + j + 1) * 3072 + col + e];
        } else unpack8(*(const v4u*)(QKV + (size_t)(MP + s) * 3072 + col), uc);
#pragma unroll
        for (int e = 0; e < 8; ++e) out[O_NCQS + (size_t)(s * 3 + j) * 3072 + col + e] = uc[e];
    }
}
__device__ __forceinline__ size_t qkv_gran(int t0, int h, int i) { const int row = i / 48, j = i - row * 48; return (size_t)(t0 + row) * 3072 + (j >> 4) * 1024 + h * 128 + (j & 15) * 8; }
__device__ __forceinline__ void stage_a(LAS unsigned char* L, int item, const bf16* QKV, const float* BA, const float* cbw,
                                        bf16* NW, bf16* QD, bf16* KDT, bf16* UD, bf16* AQK, float* GLv, int tid_in) {
    int tid = tid_in; asm volatile("" : "+v"(tid));
    const int lane = tid & 63, wid = tid >> 6;
    const int c = item & 31, h = (item >> 5) & 7, b = item >> 8, t0 = b * 2048 + c * 64;
    LAS float* sGC = (LAS float*)(L + 0); LAS float* sBETA = (LAS float*)(L + 256); LAS float* sEGC = (LAS float*)(L + 512); LAS float* sKDS = (LAS float*)(L + 768);
    LAS bf16* sQb = (LAS bf16*)(L + 1024);
    LAS bf16* sKb = (LAS bf16*)(L + 18432);
    LAS float* sRHS = (LAS float*)(L + 35840);
    LAS bf16* sKD = (LAS bf16*)(L + 101376);
    LAS float* sA = (LAS float*)(L + 118016);
    LAS bf16* sAQ = (LAS bf16*)(L + 134400);
    if (tid < 64) {
        const float g = BA[(size_t)(t0 + tid) * 16 + 8 + h], be = BA[(size_t)(t0 + tid) * 16 + h];
        float gc = g;
#pragma unroll
        for (int o = 1; o < 64; o <<= 1) { const float n = __shfl_up(gc, o); if (lane >= o) gc += n; }
        const float gl = __uint_as_float(__builtin_amdgcn_readlane(__float_as_uint(gc), 63));
        sGC[tid] = gc; sBETA[tid] = be; sEGC[tid] = __expf(gc); sKDS[tid] = __expf(gl - gc);
        if (tid == 0) GLv[item] = __expf(gl);
    }
    __syncthreads();
    if (tid < 384) {
        const int cg_ = tid % 48, strip = tid / 48, tensor = cg_ >> 4, c8 = (cg_ & 15) * 8;
        const int gcol = tensor * 1024 + h * 128 + c8, rl0 = strip * 8;
        float w[4][8];
#pragma unroll
        for (int j = 0; j < 4; ++j)
#pragma unroll
            for (int e = 0; e < 8; ++e) w[j][e] = cbw[j * 3072 + gcol + e];
        float xw[3][8];
#pragma unroll
        for (int j = 0; j < 3; ++j) { const int rr = rl0 - 3 + j;
            if (c > 0 || rr >= 0) unpack8(*(const v4u*)(QKV + (size_t)(t0 + rr) * 3072 + gcol), xw[j]);
            else {
#pragma unroll
                for (int e = 0; e < 8; ++e) xw[j][e] = 0.f; } }
        v4u rowv[8];
#pragma unroll
        for (int r = 0; r < 8; ++r) rowv[r] = *(const v4u*)(QKV + (size_t)(t0 + rl0 + r) * 3072 + gcol);
#pragma unroll
        for (int r = 0; r < 8; ++r) {
            const int tok = rl0 + r; float cur[8], y[8]; unpack8(rowv[r], cur);
            float ss = 0.f;
#pragma unroll
            for (int e = 0; e < 8; ++e) { y[e] = silu(w[0][e] * xw[0][e] + w[1][e] * xw[1][e] + w[2][e] * xw[2][e] + w[3][e] * cur[e]); ss += y[e] * y[e];
                xw[0][e] = xw[1][e]; xw[1][e] = xw[2][e]; xw[2][e] = cur[e]; }
            ss = row16_sum(ss);
            const float rstd = rsqrtf(ss + EPS);
            if (tensor == 0) {
                const float sc = rstd * 0.08838834764831845f, eg = sEGC[tok]; float qn[8], qd[8];
#pragma unroll
                for (int e = 0; e < 8; ++e) { qn[e] = y[e] * sc; qd[e] = qn[e] * eg; }
                *(LAS v4u*)(sQb + tok * 136 + c8) = pack8(qn);
                const int m = tok >> 4, s = c8 >> 5, jh = (c8 >> 4) & 1, g0 = (c8 & 15) >> 2;
                bf16* dst = QD + (size_t)item * 8192 + ((m * 4 + s) * 64 + 16 * g0 + (tok & 15)) * 8 + 4 * jh;
                v2u p0, p1; p0.x = pkbf(qd[0], qd[1]); p0.y = pkbf(qd[2], qd[3]); p1.x = pkbf(qd[4], qd[5]); p1.y = pkbf(qd[6], qd[7]);
                *(v2u*)dst = p0; *(v2u*)(dst + 16 * 8) = p1;
            } else if (tensor == 1) {
                const float be = sBETA[tok] * sEGC[tok], kd = sKDS[tok]; float kn[8], t8[8];
#pragma unroll
                for (int e = 0; e < 8; ++e) kn[e] = y[e] * rstd;
                *(LAS v4u*)(sKb + tok * 136 + c8) = pack8(kn);
#pragma unroll
                for (int e = 0; e < 8; ++e) t8[e] = kn[e] * be;
                *(LAS f32x4*)(sRHS + tok * 256 + 128 + c8) = (f32x4){t8[0], t8[1], t8[2], t8[3]}; *(LAS f32x4*)(sRHS + tok * 256 + 128 + c8 + 4) = (f32x4){t8[4], t8[5], t8[6], t8[7]};
                LAS unsigned* kdp = (LAS unsigned*)(sKD + tok * 130 + c8);
#pragma unroll
                for (int e = 0; e < 4; ++e) kdp[e] = pkbf(kn[2 * e] * kd, kn[2 * e + 1] * kd);
            } else {
                const float be = sBETA[tok];
                *(LAS f32x4*)(sRHS + tok * 256 + c8) = (f32x4){y[0] * be, y[1] * be, y[2] * be, y[3] * be}; *(LAS f32x4*)(sRHS + tok * 256 + c8 + 4) = (f32x4){y[4] * be, y[5] * be, y[6] * be, y[7] * be};
            }
        }
    }
    __syncthreads();
    {
        const int mat = wid >> 2, wr_ = wid & 3, fr = lane & 15, fq = lane >> 4;
        const LAS bf16* Am = mat ? sQb : sKb;
        f32x4 acc[4];
#pragma unroll
        for (int n = 0; n < 4; ++n) acc[n] = (f32x4){0.f, 0.f, 0.f, 0.f};
#pragma unroll
        for (int s = 0; s < 4; ++s) { const bf16x8 a = *(const LAS bf16x8*)(Am + (16 * wr_ + fr) * 136 + 32 * s + 8 * fq);
#pragma unroll
            for (int n = 0; n < 4; ++n) { const bf16x8 bb = *(const LAS bf16x8*)(sKb + (16 * n + fr) * 136 + 32 * s + 8 * fq); acc[n] = __builtin_amdgcn_mfma_f32_16x16x32_bf16(a, bb, acc[n], 0, 0, 0); } }
#pragma unroll
        for (int n = 0; n < 4; ++n)
#pragma unroll
            for (int r = 0; r < 4; ++r) { const int i = 16 * wr_ + 4 * fq + r, j = 16 * n + fr; const float d = acc[n][r], dec = __expf(sGC[i] - sGC[j]);
                if (mat == 0) sA[i * 64 + j] = (i > j) ? sBETA[i] * d * dec : 0.f;
                else { const float v = (i >= j) ? d * dec : 0.f; const int m = i >> 4, s2 = j >> 5, jj = 4 * ((j >> 4) & 1) + (j & 3), lp = 16 * ((j & 15) >> 2) + (i & 15);
                    sAQ[((m * 2 + s2) * 64 + lp) * 8 + jj] = f2bf1(v); } }
    }
    __syncthreads();
    float x[64];
    if (tid < 256) {
        int zoff; asm volatile("v_mov_b32 %0, 0" : "=v"(zoff));
#pragma unroll
        for (int i = 0; i < 64; ++i) x[i] = sRHS[i * 256 + tid];
#pragma unroll
        for (int i = 1; i < 64; ++i) {
#pragma unroll
            for (int jb = 0; jb < (i + 3) / 4; ++jb) { const f32x4 a4 = *(const LAS f32x4*)(sA + zoff + i * 64 + 4 * jb);
                x[i] -= a4[0] * x[4 * jb]; x[i] -= a4[1] * x[4 * jb + 1]; x[i] -= a4[2] * x[4 * jb + 2]; x[i] -= a4[3] * x[4 * jb + 3]; }
            if ((i & 1) == 1) asm volatile("" : "+v"(zoff), "+v"(x[i]));
        }
    } else {
        const int t2 = tid - 256;
#pragma unroll
        for (int q = 0; q < 4; ++q) { const int p = t2 + 256 * q, l = p & 63, fs = p >> 6, i = fs >> 1, s2 = fs & 1, dk = 16 * i + (l & 15), g = l >> 4; unsigned short v8[8];
#pragma unroll
            for (int j = 0; j < 8; ++j) { const int tok = 32 * s2 + 16 * (j >> 2) + 4 * g + (j & 3); v8[j] = sKD[tok * 130 + dk]; }
            v4u o; o.x = v8[0] | ((unsigned)v8[1] << 16); o.y = v8[2] | ((unsigned)v8[3] << 16); o.z = v8[4] | ((unsigned)v8[5] << 16); o.w = v8[6] | ((unsigned)v8[7] << 16);
            *(v4u*)(KDT + qkv_gran(t0, h, p)) = o; }
#pragma unroll
        for (int q = 0; q < 2; ++q) { const int p = t2 + 256 * q; *(v4u*)(AQK + (size_t)item * 4096 + p * 8) = *(const LAS v4u*)(sAQ + p * 8); }
    }
    __syncthreads();
    LAS bf16* stg = (LAS bf16*)sRHS;
    if (tid < 128) {
        const int dv = tid, w_ = dv >> 4;
#pragma unroll
        for (int m = 0; m < 4; ++m)
#pragma unroll
            for (int g = 0; g < 4; ++g) { v2u p; p.x = pkbf(x[16 * m + 4 * g], x[16 * m + 4 * g + 1]); p.y = pkbf(x[16 * m + 4 * g + 2], x[16 * m + 4 * g + 3]);
                { const int e = ((w_ * 4 + m) * 64 + 16 * g + (dv & 15)) * 4; *(v2u*)(UD + qkv_gran(t0, h, 1024 + (e >> 3)) + (e & 7)) = p; } }
    } else if (tid < 256) {
        const int dk = tid - 128, s = dk >> 5, jh = (dk >> 4) & 1, g = (dk & 15) >> 2, j = 4 * jh + (dk & 3);
#pragma unroll
        for (int tok = 0; tok < 64; ++tok) stg[(((tok >> 4) * 4 + s) * 64 + 16 * g + (tok & 15)) * 8 + j] = f2bf1(-x[tok]);
    }
    __syncthreads();
#pragma unroll
    for (int q = 0; q < 2; ++q) { const int p = tid + 512 * q; *(v4u*)(NW + (size_t)item * 8192 + p * 8) = *(const LAS v4u*)(stg + p * 8); }
    __syncthreads();
}

constexpr int SAP_SETB = 68608, SAP_A = 2 * SAP_SETB, SAP_AQ = SAP_A + 16384;
__device__ __forceinline__ void sap_scan(LAS unsigned char* S, int item, const float* BA, float* GLv, int lane) {
    const int c = item & 31, h = (item >> 5) & 7, b = item >> 8, t0 = b * 2048 + c * 64;
    LAS float* sGC = (LAS float*)S;
    const float g = BA[(size_t)(t0 + lane) * 16 + 8 + h], be = BA[(size_t)(t0 + lane) * 16 + h];
    float gc = g;
#pragma unroll
    for (int o = 1; o < 64; o <<= 1) { const float n = __shfl_up(gc, o); if (lane >= o) gc += n; }
    const float gl = __uint_as_float(__builtin_amdgcn_readlane(__float_as_uint(gc), 63));
    sGC[lane] = gc; sGC[64 + lane] = be; sGC[128 + lane] = __expf(gc); sGC[192 + lane] = __expf(gl - gc);
    if (lane == 0) GLv[item] = __expf(gl);
}
struct SapIn { float w[4][8]; float xw[3][8]; v4u rowv[13]; };
__device__ __forceinline__ void sap_conv_load(SapIn& I, int item, const bf16* QKV, const float* cbw, int ct) {
    const int c = item & 31, h = (item >> 5) & 7, b = item >> 8, t0 = b * 2048 + c * 64;
    const int cg_ = ct % 48, strip = ct / 48, tensor = cg_ >> 4, c8 = (cg_ & 15) * 8;
    const int gcol = tensor * 1024 + h * 128 + c8, rl0 = strip * 13, nr = (strip == 4) ? 12 : 13;
#pragma unroll
    for (int j = 0; j < 4; ++j)
#pragma unroll
        for (int e = 0; e < 8; ++e) I.w[j][e] = cbw[j * 3072 + gcol + e];
#pragma unroll
    for (int j = 0; j < 3; ++j) { const int rr = rl0 - 3 + j;
        if (c > 0 || rr >= 0) unpack8(*(const v4u*)(QKV + (size_t)(t0 + rr) * 3072 + gcol), I.xw[j]);
        else {
#pragma unroll
            for (int e = 0; e < 8; ++e) I.xw[j][e] = 0.f; } }
#pragma unroll
    for (int r = 0; r < 13; ++r) I.rowv[r] = __builtin_nontemporal_load((const v4u*)(QKV + (size_t)(t0 + (r < nr ? rl0 + r : rl0)) * 3072 + gcol));
}
__device__ __forceinline__ void sap_conv(LAS unsigned char* S, int item, SapIn& I, bf16* QD, int ct) {
    const int c = item & 31, h = (item >> 5) & 7, b = item >> 8, t0 = b * 2048 + c * 64; (void)c; (void)h; (void)b; (void)t0;
    LAS float* sGC = (LAS float*)S; LAS bf16* sQb = (LAS bf16*)(S + 1024); LAS bf16* sKb = (LAS bf16*)(S + 18432); LAS bf16* sRH = (LAS bf16*)(S + 35840);
    const int cg_ = ct % 48, strip = ct / 48, tensor = cg_ >> 4, c8 = (cg_ & 15) * 8;
    const int rl0 = strip * 13, nr = (strip == 4) ? 12 : 13;
    float (&w)[4][8] = I.w; float (&xw)[3][8] = I.xw; v4u (&rowv)[13] = I.rowv;
#pragma unroll
    for (int r = 0; r < 13; ++r) if (r < nr) {
        const int tok = rl0 + r; float cur[8], y[8]; unpack8(rowv[r], cur);
        float ss = 0.f;
#pragma unroll
        for (int e = 0; e < 8; ++e) { y[e] = silu(w[0][e] * xw[0][e] + w[1][e] * xw[1][e] + w[2][e] * xw[2][e] + w[3][e] * cur[e]); ss += y[e] * y[e];
            xw[0][e] = xw[1][e]; xw[1][e] = xw[2][e]; xw[2][e] = cur[e]; }
        ss = row16_sum(ss);
        const float rstd = rsqrtf(ss + EPS);
        if (tensor == 0) {
            const float sc = rstd * 0.08838834764831845f, eg = sGC[128 + tok]; float qn[8], qd[8];
#pragma unroll
            for (int e = 0; e < 8; ++e) { qn[e] = y[e] * sc; qd[e] = qn[e] * eg; }
            *(LAS v4u*)(sQb + tok * 136 + c8) = pack8(qn);
            const int m = tok >> 4, s = c8 >> 5, jh = (c8 >> 4) & 1, g0 = (c8 & 15) >> 2;
            bf16* dst = QD + (size_t)item * 8192 + ((m * 4 + s) * 64 + 16 * g0 + (tok & 15)) * 8 + 4 * jh;
            v2u p0, p1; p0.x = pkbf(qd[0], qd[1]); p0.y = pkbf(qd[2], qd[3]); p1.x = pkbf(qd[4], qd[5]); p1.y = pkbf(qd[6], qd[7]);
            *(v2u*)dst = p0; *(v2u*)(dst + 16 * 8) = p1;
        } else if (tensor == 1) {
            const float be = sGC[64 + tok] * sGC[128 + tok]; float kn[8], t8[8];
#pragma unroll
            for (int e = 0; e < 8; ++e) { kn[e] = y[e] * rstd; t8[e] = kn[e] * be; }
            *(LAS v4u*)(sKb + tok * 136 + c8) = pack8(kn);
            *(LAS v4u*)(sRH + tok * 256 + 128 + c8) = pack8(t8);
        } else {
            const float be = sGC[64 + tok]; float t8[8];
#pragma unroll
            for (int e = 0; e < 8; ++e) t8[e] = y[e] * be;
            *(LAS v4u*)(sRH + tok * 256 + c8) = pack8(t8);
        }
    }
}
__device__ __forceinline__ void stage_a_pipe(LAS unsigned char* L, int first, int stride, int nitems, const bf16* QKV, const float* BA, const float* cbw,
                                             bf16* NW, bf16* QD, bf16* KDT, bf16* UD, bf16* AQK, float* GLv, int tid_in,
                                             const bf16* Ubuf, bf16* GAbuf, const bf16* UHbuf, const float* caw) {
    LAS float* sA = (LAS float*)(L + SAP_A); LAS bf16* sAQ = (LAS bf16*)(L + SAP_AQ); LAS bf16* stg = (LAS bf16*)(L + SAP_A);
    { int tid = tid_in; asm volatile("" : "+v"(tid)); const int wid = tid >> 6, lane = tid & 63;
      if (wid == 7) sap_scan(L, first, BA, GLv, lane);
      __syncthreads();
      if (wid >= 4 && tid - 256 < 240) { SapIn I; sap_conv_load(I, first, QKV, cbw, tid - 256); sap_conv(L, first, I, QD, tid - 256); }
      else if (wid < 4) branch_a_rest(Ubuf, GAbuf, UHbuf, caw, first, tid);
      __syncthreads(); }
    for (int k = 0; k < nitems; ++k) {
        int tid = tid_in; asm volatile("" : "+v"(tid));
        const int wid = tid >> 6, lane = tid & 63;
        const int item = first + k * stride, nxt = item + stride; const bool has_next = (k + 1 < nitems);
        LAS unsigned char* S = L + (k & 1) * SAP_SETB; LAS unsigned char* Sn = L + ((k + 1) & 1) * SAP_SETB;
        const int c = item & 31, h = (item >> 5) & 7, b = item >> 8, t0 = b * 2048 + c * 64;
        LAS float* sGC = (LAS float*)S; LAS bf16* sQb = (LAS bf16*)(S + 1024); LAS bf16* sKb = (LAS bf16*)(S + 18432); LAS bf16* sRH = (LAS bf16*)(S + 35840);
        if (wid < 4) {
            {
            const int fr = lane & 15, fq = lane >> 4;
#pragma unroll
            for (int mat = 0; mat < 2; ++mat) {
                const LAS bf16* Am = mat ? sQb : sKb;
                f32x4 acc[4];
#pragma unroll
                for (int n = 0; n < 4; ++n) acc[n] = (f32x4){0.f, 0.f, 0.f, 0.f};
#pragma unroll
                for (int s = 0; s < 4; ++s) { const bf16x8 a = *(const LAS bf16x8*)(Am + (16 * wid + fr) * 136 + 32 * s + 8 * fq);
#pragma unroll
                    for (int n = 0; n < 4; ++n) { const bf16x8 bb = *(const LAS bf16x8*)(sKb + (16 * n + fr) * 136 + 32 * s + 8 * fq); acc[n] = __builtin_amdgcn_mfma_f32_16x16x32_bf16(a, bb, acc[n], 0, 0, 0); } }
#pragma unroll
                for (int n = 0; n < 4; ++n)
#pragma unroll
                    for (int r = 0; r < 4; ++r) { const int i = 16 * wid + 4 * fq + r, j = 16 * n + fr; const float d = acc[n][r], dec = __expf(sGC[i] - sGC[j]);
                        if (mat == 0) sA[j * 64 + i] = (i > j) ? sGC[64 + i] * d * dec : 0.f;
                        else { const float v = (i >= j) ? d * dec : 0.f; const int m = i >> 4, s2 = j >> 5, jj = 4 * ((j >> 4) & 1) + (j & 3), lp = 16 * ((j & 15) >> 2) + (i & 15);
                            sAQ[((m * 2 + s2) * 64 + lp) * 8 + jj] = f2bf1(v); } }
            }
            }
            __syncthreads();
            f32x2v x2[32];
            {
            int zoff; asm volatile("v_mov_b32 %0, 0" : "=v"(zoff));
#pragma unroll
            for (int i = 0; i < 32; ++i) x2[i] = (f32x2v){bf1(sRH[(2 * i) * 256 + tid]), bf1(sRH[(2 * i + 1) * 256 + tid])};
#pragma unroll
            for (int j = 0; j < 63; ++j) {
                const float xj = (j & 1) ? x2[j >> 1][1] : x2[j >> 1][0];
                const f32x2v xjj = {xj, xj};
#pragma unroll
                for (int ib = (j + 1) / 4; ib < 16; ++ib) { const f32x4 a4 = *(const LAS f32x4*)(sA + zoff + j * 64 + 4 * ib);
                    x2[2 * ib] = x2[2 * ib] - (f32x2v){a4[0], a4[1]} * xjj; x2[2 * ib + 1] = x2[2 * ib + 1] - (f32x2v){a4[2], a4[3]} * xjj; }
                if ((j & 1) == 1) asm volatile("" : "+v"(zoff), "+v"(x2[(j + 1) >> 1]));
            }
            }
            float x[64];
#pragma unroll
            for (int i = 0; i < 32; ++i) { x[2 * i] = x2[i][0]; x[2 * i + 1] = x2[i][1]; }
            __syncthreads();
            if (tid < 128) {
                const int dv = tid, w_ = dv >> 4;
#pragma unroll
                for (int m = 0; m < 4; ++m)
#pragma unroll
                    for (int g = 0; g < 4; ++g) { v2u p; p.x = pkbf(x[16 * m + 4 * g], x[16 * m + 4 * g + 1]); p.y = pkbf(x[16 * m + 4 * g + 2], x[16 * m + 4 * g + 3]);
                        const int e = ((w_ * 4 + m) * 64 + 16 * g + (dv & 15)) * 4; *(v2u*)(UD + qkv_gran(t0, h, 1024 + (e >> 3)) + (e & 7)) = p; }
            } else {
                const int dk = tid - 128, s = dk >> 5, jh = (dk >> 4) & 1, g = (dk & 15) >> 2, j = 4 * jh + (dk & 3);
#pragma unroll
                for (int tok = 0; tok < 64; ++tok) stg[(((tok >> 4) * 4 + s) * 64 + 16 * g + (tok & 15)) * 8 + j] = f2bf1(-x[tok]);
            }
#pragma unroll
            for (int q = 0; q < 4; ++q) { const int p = tid + 256 * q, l = p & 63, fs = p >> 6, i = fs >> 1, s2 = fs & 1, dk = 16 * i + (l & 15), g = l >> 4; float v8[8];
#pragma unroll
                for (int j = 0; j < 8; ++j) { const int tok = 32 * s2 + 16 * (j >> 2) + 4 * g + (j & 3); v8[j] = bf1(sKb[tok * 136 + dk]) * sGC[192 + tok]; }
                *(v4u*)(KDT + qkv_gran(t0, h, p)) = pack8(v8); }
#pragma unroll
            for (int q = 0; q < 2; ++q) { const int p = tid + 256 * q; *(v4u*)(AQK + (size_t)item * 4096 + p * 8) = *(const LAS v4u*)(sAQ + p * 8); }
            __syncthreads();
#pragma unroll
            for (int q = 0; q < 4; ++q) { const int p = tid + 256 * q; *(v4u*)(NW + (size_t)item * 8192 + p * 8) = *(const LAS v4u*)(stg + p * 8); }
            __syncthreads();
        } else {
            SapIn I;
            if (tid - 256 < 240 && has_next) sap_conv_load(I, nxt, QKV, cbw, tid - 256);
            if (wid == 7 && has_next) sap_scan(Sn, nxt, BA, GLv, lane);
            __syncthreads();
            if (tid - 256 < 240 && has_next) sap_conv(Sn, nxt, I, QD, tid - 256);
            __syncthreads();
            __syncthreads();
            __syncthreads();
        }
    }
}
__device__ __forceinline__ void stage_b(LAS unsigned char* L, int bh, const bf16* NW, const bf16* QD, const bf16* KDT, const bf16* UD, const bf16* AQK,
                                        const float* GLv, bf16* ZBO, const float* onw, float* ndp, int tid, bool dry = false) {
    const int lane = tid & 63, w = tid >> 6, g = lane >> 4, colx = lane & 15, dv = 16 * w + colx, b = bh >> 3, h = bh & 7;
    LAS float* red = (LAS float*)(L + 114688);
    f32x4 S[8];
#pragma unroll
    for (int i = 0; i < 8; ++i) S[i] = (f32x4){0.f, 0.f, 0.f, 0.f};
    const float ow = onw[dv];
    v4u R[7];
    int kdo[2], udo[4], zbo[4][4];
#pragma unroll
    for (int q = 0; q < 2; ++q) { const int i = tid + 512 * q, row = i / 48, j = i - row * 48; kdo[q] = row * 3072 + (j >> 4) * 1024 + (j & 15) * 8; }
#pragma unroll
    for (int m = 0; m < 4; ++m) { const int e_ = ((w * 4 + m) * 64 + lane) * 4, i = 1024 + (e_ >> 3), row = i / 48, j = i - row * 48; udo[m] = row * 3072 + (j >> 4) * 1024 + (j & 15) * 8 + (e_ & 7);
#pragma unroll
        for (int r = 0; r < 4; ++r) zbo[m][r] = (16 * m + 4 * g + r) * 1024 + dv; }
#define SB_ISSUE(item_) do { const bf16* nwb_ = NW + (size_t)(item_) * 8192; const bf16* qdb_ = QD + (size_t)(item_) * 8192; const bf16* aqb_ = AQK + (size_t)(item_) * 4096; \
        const bf16* kdb_ = KDT + (size_t)(b * 2048 + ((item_) & 31) * 64) * 3072 + h * 128; \
        R[0] = __builtin_nontemporal_load((const v4u*)(nwb_ + tid * 8)); R[1] = __builtin_nontemporal_load((const v4u*)(nwb_ + (tid + 512) * 8)); R[2] = __builtin_nontemporal_load((const v4u*)(qdb_ + tid * 8)); R[3] = __builtin_nontemporal_load((const v4u*)(qdb_ + (tid + 512) * 8)); \
        R[4] = __builtin_nontemporal_load((const v4u*)(kdb_ + kdo[0])); R[5] = __builtin_nontemporal_load((const v4u*)(kdb_ + kdo[1])); R[6] = __builtin_nontemporal_load((const v4u*)(aqb_ + tid * 8)); } while (0)
#define SB_COMMIT(bufi_) do { _Pragma("unroll") for (int q = 0; q < 7; ++q) { const int p = tid + 512 * q; *(LAS v4u*)(L + (bufi_) * 57344 + p * 16) = R[q]; } } while (0)
    SB_ISSUE(bh * 32); SB_COMMIT(0);
    v2u udn[4]; unsigned short zbn[4][4];
#define SB_PRE(item_, t0_) do { const bf16* udb_ = UD + (size_t)(t0_) * 3072 + h * 128; const bf16* zbb_ = ZBO + (size_t)(t0_) * 1024 + h * 128; \
        _Pragma("unroll") for (int m = 0; m < 4; ++m) { udn[m] = *(const v2u*)(udb_ + udo[m]); \
        _Pragma("unroll") for (int r = 0; r < 4; ++r) zbn[m][r] = zbb_[zbo[m][r]]; } } while (0)
    SB_PRE(bh * 32, b * 2048);
    float gln = GLv[bh * 32];
    __syncthreads();
    for (int c = 0; c < 32; ++c) {
        const int item = bh * 32 + c, cur = c & 1, t0 = b * 2048 + c * 64;
        LAS unsigned char* B = L + cur * 57344;
        const int nitem = (c + 1 < 32) ? item + 1 : item, nt0 = (c + 1 < 32) ? t0 + 64 : t0;
        SB_ISSUE(nitem);
        f32x4 vn[4]; unsigned short zb[4][4];
#pragma unroll
        for (int m = 0; m < 4; ++m) { const v2u u2 = udn[m]; vn[m] = (f32x4){bflo(u2.x), bfhi(u2.x), bflo(u2.y), bfhi(u2.y)};
#pragma unroll
            for (int r = 0; r < 4; ++r) zb[m][r] = zbn[m][r]; }
        const float gl = gln;
        gln = GLv[nitem]; SB_PRE(nitem, nt0);
        bf16x8 Sb[4];
#pragma unroll
        for (int s = 0; s < 4; ++s) { v4u t; t.x = pk2(S[2 * s][0], S[2 * s][1]); t.y = pk2(S[2 * s][2], S[2 * s][3]); t.z = pk2(S[2 * s + 1][0], S[2 * s + 1][1]); t.w = pk2(S[2 * s + 1][2], S[2 * s + 1][3]); Sb[s] = __builtin_bit_cast(bf16x8, t); }
        f32x4 o[4];
#pragma unroll
        for (int m = 0; m < 4; ++m) o[m] = (f32x4){0.f, 0.f, 0.f, 0.f};
#pragma unroll
        for (int s = 0; s < 4; ++s)
#pragma unroll
            for (int m = 0; m < 4; ++m) { const bf16x8 a = *(const LAS bf16x8*)(B + ((m * 4 + s) * 64 + lane) * 16); vn[m] = __builtin_amdgcn_mfma_f32_16x16x32_bf16(a, Sb[s], vn[m], 0, 0, 0);
                const bf16x8 a2 = *(const LAS bf16x8*)(B + 16384 + ((m * 4 + s) * 64 + lane) * 16); o[m] = __builtin_amdgcn_mfma_f32_16x16x32_bf16(a2, Sb[s], o[m], 0, 0, 0); }
        bf16x8 vb[2];
#pragma unroll
        for (int s = 0; s < 2; ++s) { v4u t; t.x = pk2(vn[2 * s][0], vn[2 * s][1]); t.y = pk2(vn[2 * s][2], vn[2 * s][3]); t.z = pk2(vn[2 * s + 1][0], vn[2 * s + 1][1]); t.w = pk2(vn[2 * s + 1][2], vn[2 * s + 1][3]); vb[s] = __builtin_bit_cast(bf16x8, t); }
#pragma unroll
        for (int s = 0; s < 2; ++s)
#pragma unroll
            for (int m = 0; m < 4; ++m) { const bf16x8 a = *(const LAS bf16x8*)(B + 49152 + ((m * 2 + s) * 64 + lane) * 16); o[m] = __builtin_amdgcn_mfma_f32_16x16x32_bf16(a, vb[s], o[m], 0, 0, 0); }
#pragma unroll
        for (int ih = 0; ih < 2; ++ih) {
#pragma unroll
            for (int i = 4 * ih; i < 4 * ih + 4; ++i) S[i] = S[i] * gl;
#pragma unroll
            for (int s = 0; s < 2; ++s)
#pragma unroll
                for (int i = 4 * ih; i < 4 * ih + 4; ++i) { const bf16x8 a = *(const LAS bf16x8*)(B + 32768 + ((i * 2 + s) * 64 + lane) * 16); S[i] = __builtin_amdgcn_mfma_f32_16x16x32_bf16(a, vb[s], S[i], 0, 0, 0); }
        }
#pragma unroll
        for (int m = 0; m < 4; ++m)
#pragma unroll
            for (int r = 0; r < 4; ++r) { float q = row16_sum(o[m][r] * o[m][r]);
                if (colx == 0) red[(cur * 64 + 16 * m + 4 * g + r) * 8 + w] = q; }
        SB_COMMIT(cur ^ 1);
        __syncthreads();
        {
            LAS float* rs = red + 1024 + (cur * 8 + w) * 64;
            bf16* zst = ZBO + (size_t)t0 * 1024 + h * 128;
            const f32x4 p0 = *(const LAS f32x4*)(red + (cur * 64 + lane) * 8), p1 = *(const LAS f32x4*)(red + (cur * 64 + lane) * 8 + 4);
            rs[lane] = rsqrtf((((p0[0] + p0[1]) + (p0[2] + p0[3])) + ((p1[0] + p1[1]) + (p1[2] + p1[3]))) * (1.f / 128.f) + EPS);
#pragma unroll
            for (int m = 0; m < 4; ++m) { const f32x4 r4 = *(const LAS f32x4*)(rs + 16 * m + 4 * g);
#pragma unroll
                for (int r = 0; r < 4; ++r) { const int tok = 16 * m + 4 * g + r;
                    (void)tok; if (!dry) zst[zbo[m][r]] = f2bf1(o[m][r] * r4[r] * ow * bf1(zb[m][r])); } }
        }
    }
#pragma unroll
    for (int i = 0; i < 8; ++i)
#pragma unroll
        for (int r = 0; r < 4; ++r) if (!dry) ndp[((size_t)bh * 128 + 16 * i + 4 * g + r) * 128 + dv] = S[i][r];
    __syncthreads();
}
__device__ __forceinline__ void sample_delta(LAS unsigned char* L, int item, const float* const* in, unsigned char* ws, float* out, int tid, bool dry = false) {
    const int lane = tid & 63, wid = tid >> 6, s = item >> 3, h = item & 7;
    LAS float* vals = (LAS float*)L; LAS float* part = (LAS float*)(L + 2048); LAS float* misc = (LAS float*)(L + 4096);
    const bf16* QKV = (const bf16*)(ws + WS_BUF + 3 * BUF_BYTES); const float* BA = (const float*)(ws + WS_BA); bf16* ZBO = (bf16*)(ws + WS_BUF + 6 * BUF_BYTES);
    const float* scq = in[5]; const float* cbw = in[12]; const float* sd = in[6];
    if (tid < 384) { const int tensor = tid >> 7, d = tid & 127, colg = tensor * 1024 + h * 128 + d; const float* st = scq + (size_t)(s * 3) * 3072 + colg;
        const float y = cbw[colg] * st[0] + cbw[3072 + colg] * st[3072] + cbw[2 * 3072 + colg] * st[2 * 3072] + cbw[3 * 3072 + colg] * bf1(QKV[(size_t)(MP + s) * 3072 + colg]);
        vals[tid] = silu(y); }
    __syncthreads();
    if (wid < 2) { const float a0 = vals[wid * 128 + lane], a1 = vals[wid * 128 + 64 + lane]; const float ss = wave_sum(a0 * a0 + a1 * a1);
        if (lane == 0) misc[wid] = rsqrtf(ss + EPS) * (wid == 0 ? 0.08838834764831845f : 1.f); }
    __syncthreads();
    const int dv = tid & 127, grp = tid >> 7, dk0 = 32 * grp;
    const float a = __expf(BA[(size_t)(MP + s) * 16 + 8 + h]), beta = BA[(size_t)(MP + s) * 16 + h], rq = misc[0], rk = misc[1];
    const float* S0 = sd + (size_t)item * 16384; float* S1 = out + O_NDS + (size_t)item * 16384;
    float Sr[32]; float ks = 0.f;
#pragma unroll
    for (int i = 0; i < 32; ++i) { Sr[i] = __builtin_nontemporal_load(S0 + (dk0 + i) * 128 + dv); }
#pragma unroll
    for (int i = 0; i < 32; ++i) ks += vals[128 + dk0 + i] * Sr[i];
    part[grp * 128 + dv] = ks;
    __syncthreads();
    const float kS = a * rk * (part[dv] + part[128 + dv] + part[256 + dv] + part[384 + dv]);
    const float vnew = beta * (vals[256 + dv] - kS);
    float po = 0.f;
#pragma unroll
    for (int i = 0; i < 32; ++i) { const float sn = a * Sr[i] + (vals[128 + dk0 + i] * rk) * vnew; if (!dry) S1[(dk0 + i) * 128 + dv] = sn; po += vals[dk0 + i] * sn; }
    __syncthreads();
    part[grp * 128 + dv] = po;
    __syncthreads();
    const float o = rq * (part[dv] + part[128 + dv] + part[256 + dv] + part[384 + dv]);
    if (wid < 2) { const float ss = wave_sum(o * o); if (lane == 0) misc[2 + wid] = ss; }
    __syncthreads();
    if (tid < 128) { const float rstd = rsqrtf((misc[2] + misc[3]) * (1.f / 128.f) + EPS); const size_t oi = (size_t)(MP + s) * 1024 + h * 128 + dv;
        if (!dry) ZBO[oi] = f2bf1(o * rstd * in[15][dv] * bf1(ZBO[oi])); }
    __syncthreads();
}

__device__ __forceinline__ void seq_full(LAS unsigned char* L, int bh, const bf16* QKV, const float* BA, const float* cbw, bf16* ZBO, const float* onw, float* ndp, int tid) {
    const int lane = tid & 63, wid = tid >> 6, b = bh >> 3, h = bh & 7;
    LAS float* vals = (LAS float*)L; LAS float* part = (LAS float*)(L + 2048); LAS float* misc = (LAS float*)(L + 4096);
    const int dv = tid & 127, grp = tid >> 7, dk0 = 32 * grp;
    float Sr[32];
#pragma unroll
    for (int i = 0; i < 32; ++i) Sr[i] = 0.f;
    const float ow = onw[dv];
    for (int t = 0; t < 2048; ++t) {
        const size_t row = (size_t)b * 2048 + t;
        if (tid < 384) { const int tensor = tid >> 7, d = tid & 127, colg = tensor * 1024 + h * 128 + d; float y = 0.f;
#pragma unroll
            for (int j = 0; j < 4; ++j) { if (t - 3 + j >= 0) y += cbw[j * 3072 + colg] * bf1(QKV[(row - 3 + j) * 3072 + colg]); }
            vals[tid] = silu(y); }
        __syncthreads();
        if (wid < 2) { const float a0 = vals[wid * 128 + lane], a1 = vals[wid * 128 + 64 + lane]; const float ss = wave_sum(a0 * a0 + a1 * a1); if (lane == 0) misc[wid] = rsqrtf(ss + EPS) * (wid == 0 ? 0.08838834764831845f : 1.f); }
        __syncthreads();
        const float a = __expf(BA[row * 16 + 8 + h]), beta = BA[row * 16 + h], rq = misc[0], rk = misc[1];
        float ks = 0.f;
#pragma unroll
        for (int i = 0; i < 32; ++i) ks += vals[128 + dk0 + i] * Sr[i];
        part[grp * 128 + dv] = ks;
        __syncthreads();
        const float kS = a * rk * (part[dv] + part[128 + dv] + part[256 + dv] + part[384 + dv]);
        const float vnew = beta * (vals[256 + dv] - kS);
        float po = 0.f;
#pragma unroll
        for (int i = 0; i < 32; ++i) { Sr[i] = a * Sr[i] + (vals[128 + dk0 + i] * rk) * vnew; po += vals[dk0 + i] * Sr[i]; }
        __syncthreads();
        part[grp * 128 + dv] = po;
        __syncthreads();
        const float o = rq * (part[dv] + part[128 + dv] + part[256 + dv] + part[384 + dv]);
        if (wid < 2) { const float ss = wave_sum(o * o); if (lane == 0) misc[2 + wid] = ss; }
        __syncthreads();
        if (tid < 128) { const float rstd = rsqrtf((misc[2] + misc[3]) * (1.f / 128.f) + EPS); const size_t oi = row * 1024 + h * 128 + dv; ZBO[oi] = f2bf1(o * rstd * ow * bf1(ZBO[oi])); }
        __syncthreads();
    }
#pragma unroll
    for (int i = 0; i < 32; ++i) ndp[((size_t)bh * 128 + dk0 + i) * 128 + dv] = Sr[i];
}
__device__ __forceinline__ void phase_final(const float* const* in, unsigned char* ws, float* out, int vcu, int G, int tid) {
    const int lane = tid & 63, wave = tid >> 6, gw = vcu * 8 + wave, NGW = G * 8;
    const bf16* T = (const bf16*)(ws + WS_BUF + 4 * BUF_BYTES); const float* MOD = (const float*)(ws + WS_MOD); const float* npost = in[19];
    f32x4 np[2][2];
#pragma unroll
    for (int j = 0; j < 2; ++j)
#pragma unroll
        for (int q = 0; q < 2; ++q) np[j][q] = *(const f32x4*)(npost + 512 * j + 8 * lane + 4 * q);
    const int nblk = MP / 8;
    for (int blk = gw; blk < nblk + 16 * NS; blk += NGW) {
        const bool samp = blk >= nblk;
        if (samp && ((blk - nblk) & 15)) continue;
        const int sidx = (blk - nblk) >> 4;
        const int m0 = samp ? MP + sidx : blk * 8, nrow = samp ? 1 : 8, mr = samp ? 8 + sidx : (m0 >> 11);
        const float* xr = samp ? in[1] + (size_t)sidx * 1024 : in[0] + (size_t)m0 * 1024;
        f32x4 gn[2][2];
#pragma unroll
        for (int j = 0; j < 2; ++j)
#pragma unroll
            for (int q = 0; q < 2; ++q) gn[j][q] = *(const f32x4*)(MOD + (size_t)mr * 3072 + 2048 + 512 * j + 8 * lane + 4 * q) * np[j][q];
        v4u tn[2]; f32x4 xn[2][2];
#pragma unroll
        for (int j = 0; j < 2; ++j) { tn[j] = __builtin_nontemporal_load((const v4u*)(T + (size_t)m0 * 1024 + 512 * j + 8 * lane));
#pragma unroll
            for (int q = 0; q < 2; ++q) xn[j][q] = __builtin_nontemporal_load((const f32x4*)(xr + 512 * j + 8 * lane + 4 * q)); }
        for (int r = 0; r < nrow; ++r) {
            const int m = m0 + r;
            float t[2][8]; f32x4 xv[2][2]; float ss = 0.f;
#pragma unroll
            for (int j = 0; j < 2; ++j) { unpack8(tn[j], t[j]);
#pragma unroll
                for (int q = 0; q < 2; ++q) xv[j][q] = xn[j][q];
#pragma unroll
                for (int e = 0; e < 8; ++e) ss += t[j][e] * t[j][e]; }
            { const int rn = (r + 1 < nrow) ? r + 1 : r;
#pragma unroll
                for (int j = 0; j < 2; ++j) { tn[j] = __builtin_nontemporal_load((const v4u*)(T + (size_t)(m0 + rn) * 1024 + 512 * j + 8 * lane));
#pragma unroll
                    for (int q = 0; q < 2; ++q) xn[j][q] = __builtin_nontemporal_load((const f32x4*)(xr + (size_t)rn * 1024 + 512 * j + 8 * lane + 4 * q)); } }
            const float rstd = rsqrtf(wave_sum(ss) * (1.f / 1024.f) + EPS);
#pragma unroll
            for (int j = 0; j < 2; ++j)
#pragma unroll
                for (int q = 0; q < 2; ++q) { const int k = 512 * j + 8 * lane + 4 * q;
                    f32x4 tv = {t[j][4 * q], t[j][4 * q + 1], t[j][4 * q + 2], t[j][4 * q + 3]};
                    *(f32x4*)(out + (size_t)m * 1024 + k) = xv[j][q] + gn[j][q] * (tv * rstd); }
        }
    }
}
struct Args { const float* in[20]; float* out; unsigned char* ws; };
__global__ void __launch_bounds__(512, 2) fwd_kernel(Args args) {
    extern __shared__ __attribute__((aligned(16))) unsigned char lds_raw[];
    LAS unsigned char* L = (LAS unsigned char*)lds_raw;
#define FRESH_TID() ({ int t_ = threadIdx.x; asm volatile("" : "+v"(t_)); t_; })
#define FRESH_WAVE() __builtin_amdgcn_readfirstlane(FRESH_TID() >> 6)
    const int G = gridDim.x, bx = blockIdx.x; const int vcu = (G % 8 == 0) ? (bx % 8) * (G / 8) + bx / 8 : bx;
    unsigned char* ws = args.ws; float* out = args.out;
    if (gridDim.x > 65536u) cg::this_grid().sync();
    volatile LAS unsigned* MISC = (volatile LAS unsigned*)(L + MISC_OFF);
    if (threadIdx.x < 16) MISC[threadIdx.x] = 0u;
    __syncthreads();
    XcdBarrier bar = xcd_barrier_post((unsigned*)(ws + WS_CTL) + CW_BAR, MISC + 8);
    const int NGW = G * 8;
    bf16* B0 = (bf16*)(ws + WS_BUF); bf16* B1 = (bf16*)(ws + WS_BUF + 1 * BUF_BYTES); bf16* B2 = (bf16*)(ws + WS_BUF + 2 * BUF_BYTES); bf16* B3 = (bf16*)(ws + WS_BUF + 3 * BUF_BYTES);
    bf16* B4 = (bf16*)(ws + WS_BUF + 4 * BUF_BYTES); bf16* B6 = (bf16*)(ws + WS_BUF + 6 * BUF_BYTES);
    bf16* D0 = (bf16*)out; bf16* D1 = D0 + (size_t)MV * 1024; bf16* D2 = (bf16*)(out + O_NDS); bf16* D3 = D2 + (size_t)MP * 1024;
    bf16* WIN = (bf16*)(ws + WS_WIN); bf16* WA = (bf16*)(ws + WS_WA); bf16* WB = (bf16*)(ws + WS_WB); bf16* WO = (bf16*)(ws + WS_WO);
    float* GLv = (float*)(ws + WS_GL);

    phase_mod(args.in, ws, FRESH_WAVE() * G + vcu, NGW, FRESH_TID() & 63);
    phase0(L, args.in, ws, vcu, G, FRESH_TID());
    xcd_barrier(bar);
#ifdef DBL_P0
    phase0(L, args.in, ws, vcu, G, FRESH_TID());
#endif
    phase1(L, args.in, ws, vcu, G, FRESH_TID());
#ifdef DBL_P1
    __syncthreads();
    phase1(L, args.in, ws, vcu, G, FRESH_TID());
#endif
    xcd_barrier(bar);
    {   pg8::Gemm g{B0, WIN, MPAD, NIN, 1024}; pg8::StaticOrder S; S.init(MPAD, NIN, G, bx);
        EpiIn E{B1, B2, B3, B6, D0, D1, D2};
        pg8::gemm_phase<EpiIn, pg8::StaticOrder, true, true>(L, g, S, E);
#ifdef DBL_P2
        pg8::gemm_phase<EpiIn, pg8::StaticOrder, true, true>(L, g, S, E);
#endif
 }
    xcd_barrier(bar);
    phase3(args.in, ws, out, vcu, G, bx, FRESH_TID());
    __syncthreads();
    stage_a_pipe(L, bx, G, (2048 - bx + G - 1) / G, B3, (const float*)(ws + WS_BA), args.in[12], B0, B1, B3, B3, WIN, GLv, FRESH_TID(), B1, B2, D2, args.in[11]);
    xcd_barrier(bar);
#ifndef USE_SEQ
#ifdef DBL_P5
    if (bx < 64) { _Pragma("nounroll") for (int rep = 0; rep < 2; ++rep) stage_b(L, bx, B0, B1, B3, B3, WIN, GLv, B6, args.in[15], out + O_NDP, FRESH_TID(), rep == 0); }
    else {
        pg8::StaticOrder S; S.init(MP, 1024, G - 64, bx - 64); pg8::Gemm g{B2, WA, MP, 1024, 1024}; EpiEl<FOutA> E{FOutA{D0, D0}};
        pg8::gemm_phase<EpiEl<FOutA>, pg8::StaticOrder, true, true>(L, g, S, E); small_gemm_wg(L, B2, WA, MP, E.f, bx - 64, G - 64, FRESH_TID());
        for (int it = bx - 64; it < 1024; it += G - 64) sample_delta(L, it, args.in, ws, out, FRESH_TID()); }
#else
    if (bx < 64) stage_b(L, bx, B0, B1, B3, B3, WIN, GLv, B6, args.in[15], out + O_NDP, FRESH_TID());
    else {
        phase3b(args.in, ws, out, (bx - 64) * 512 + FRESH_TID(), (G - 64) * 512);
        pg8::StaticOrder S; S.init(MP, 1024, G - 64, bx - 64); pg8::Gemm g{B2, WA, MP, 1024, 1024}; EpiEl<FOutA> E{FOutA{D0, D0}};
        pg8::gemm_phase<EpiEl<FOutA>, pg8::StaticOrder, true, true>(L, g, S, E); small_gemm_wg(L, B2, WA, MP, E.f, bx - 64, G - 64, FRESH_TID());
        if (bx >= 128) { for (int it = bx - 128; it < 832; it += 128) sample_delta(L, it, args.in, ws, out, FRESH_TID()); }
        else { for (int it = 832 + (bx - 64); it < 1024; it += 64) sample_delta(L, it, args.in, ws, out, FRESH_TID()); } }
#endif
#else
    if (bx < 64) seq_full(L, bx, B3, (const float*)(ws + WS_BA), args.in[12], B6, args.in[15], out + O_NDP, FRESH_TID());
#endif
    xcd_barrier(bar);
#ifdef DBL_P6
    _Pragma("nounroll") for (int rep = 0; rep < 2; ++rep)
#endif
    {   pg8::StaticOrder S; S.init(MP, 1024, G, bx);
        { pg8::Gemm g{B6, WB, MP, 1024, 1024}; EpiEl<FOutB> E{FOutB{D1, D0, B3}}; pg8::gemm_phase<EpiEl<FOutB>, pg8::StaticOrder, true, true>(L, g, S, E); small_gemm_wg(L, B6, WB, MP, E.f, bx, G, FRESH_TID()); } }
    xcd_barrier(bar);
#ifdef DBL_P7
    _Pragma("nounroll") for (int rep = 0; rep < 2; ++rep)
#endif
    {   pg8::StaticOrder S; S.init(MP, 1024, G, bx); pg8::Gemm g{B3, WO, MP, 1024, 1024}; EpiEl<FPlain> E{FPlain{B4}};
        pg8::gemm_phase<EpiEl<FPlain>, pg8::StaticOrder, true, true>(L, g, S, E); small_gemm_wg(L, B3, WO, MP, E.f, bx, G, FRESH_TID()); }
    xcd_barrier(bar);
    phase_final(args.in, ws, out, vcu, G, FRESH_TID());
#ifdef DBL_P8
    phase_final(args.in, ws, out, vcu, G, FRESH_TID());
#endif
}

extern "C" void kernel_launch(void* const* d_in, const int* in_sizes, int n_in, void* d_out, int out_size, void* d_ws, size_t ws_size, hipStream_t stream) {
    static int grid = 0;
    if (grid == 0) {
        if (n_in != 20 || (size_t)out_size != O_END || ws_size < WS_END) { fprintf(stderr, "kernel_launch: unexpected shapes: n_in %d out %d ws %zu\n", n_in, out_size, ws_size); grid = -1; return; }
        int dev = 0, cus = 0, per_cu = 0;
        hipGetDevice(&dev); hipDeviceGetAttribute(&cus, hipDeviceAttributeMultiprocessorCount, dev);
        if (hipFuncSetAttribute((const void*)fwd_kernel, hipFuncAttributeMaxDynamicSharedMemorySize, LDS_BYTES) != hipSuccess) { fprintf(stderr, "kernel_launch: hipFuncSetAttribute failed\n"); grid = -1; return; }
        hipOccupancyMaxActiveBlocksPerMultiprocessor(&per_cu, (const void*)fwd_kernel, 512, LDS_BYTES);
        (void)hipGetLastError();
        if (per_cu < 1) fprintf(stderr, "kernel_launch: occupancy query says %d blocks/CU\n", per_cu);
        grid = cus;
    }
    if (grid < 0) return;
    hipMemsetAsync((char*)d_ws + WS_CTL, 0, CTL_BYTES, stream);
    Args a{};
    for (int i = 0; i < 20; ++i) a.in[i] = (const float*)d_in[i];
    a.out = (float*)d_out; a.ws = (unsigned char*)d_ws;
    void* params[] = {&a};
    hipError_t e = hipLaunchCooperativeKernel((const void*)fwd_kernel, dim3(grid), dim3(512), params, LDS_BYTES, stream);
    if (e != hipSuccess) fprintf(stderr, "kernel_launch: cooperative launch failed: %s (grid %d)\n", hipGetErrorString(e), grid);
}
```

```cpp
#include <hip/hip_runtime.h>
#include <hip/hip_cooperative_groups.h>
#include <cstdio>
#include <cstdint>
namespace cg = cooperative_groups;
namespace pg8 {
#define PG8_LAS __attribute__((address_space(3)))
typedef unsigned short bf16_t;
typedef short bf16x8 __attribute__((ext_vector_type(8)));
typedef float f32x4 __attribute__((ext_vector_type(4)));
typedef unsigned u32x4 __attribute__((ext_vector_type(4)));
constexpr int BM = 256, BK = 64, HALF = 128, HTB = HALF * BK * 2  , STAGE_BYTES = 8 * HTB, NXCD = 8, WGM = 4;

__host__ __device__ __forceinline__ int lds_byte(int r, int c) { const int st = (r >> 4) * 2 + (c >> 5), rr = r & 15, cc = c & 31, ob = rr * 64 + cc * 2; return st * 1024 + (ob ^ (((ob >> 9) & 1) << 5)); }
__host__ __device__ __forceinline__ void stage_rc(int b, int& R, int& C) { const int st = b / 1024, sb = b % 1024, swz = sb ^ (((sb >> 9) & 1) << 5); R = (st >> 1) * 16 + swz / 64; C = (st & 1) * 32 + (swz % 64) / 2; }
__host__ __device__ __forceinline__ int perm32(int rho) { const int n = rho >> 4, i = rho & 15; return 8 * (i >> 2) + 4 * n + (i & 3); }

struct Unit { int pm, pn; };
struct Gemm { const bf16_t* A; const bf16_t* Bt; int M, N, K; };

struct StaticOrder {
    int nM, nN, nwg, G, c;
    __host__ __device__ void init(int M, int N, int G_, int c_) { nM = M / BM; nN = N / BM; nwg = nM * nN; G = G_; c = c_; }
    __host__ __device__ bool next(int i, Unit& u) const {
        const long L = (long)i * G + c; if (L >= nwg) return false;
        int wgid = (int)L; { const int q = nwg / NXCD, r = nwg % NXCD, xcd = wgid % NXCD, off = wgid / NXCD; wgid = (xcd < r ? xcd * (q + 1) : r * (q + 1) + (xcd - r) * q) + off; }
        const int nig = WGM * nN, gid = wgid / nig, fm = gid * WGM, gsz = (nM - fm) < WGM ? (nM - fm) : WGM;
        u.pm = fm + ((wgid % nig) % gsz); u.pn = (wgid % nig) / gsz; return true;
    }
    __device__ __forceinline__ void a_ready(const Unit&) const {}
    __device__ __forceinline__ void done(const Unit&) const {}
};

__device__ __forceinline__ unsigned cvt_pk_bf16(float lo, float hi) { unsigned r; asm volatile("v_cvt_pk_bf16_f32 %0, %1, %2" : "=v"(r) : "v"(lo), "v"(hi)); return r; }
typedef float f32x2 __attribute__((ext_vector_type(2)));
template <class Epi, class Sched, bool ALIGN_EPI = false, bool SP2 = false>
__device__ __forceinline__ void gemm_phase(PG8_LAS unsigned char* lds, const Gemm g, const Sched& S, const Epi& E) {
    int tid = threadIdx.x; asm volatile("" : "+v"(tid));
    const int wid = __builtin_amdgcn_readfirstlane(tid >> 6), lane = tid & 63, wr = wid >> 2, wc = wid & 3, fr = lane & 15, fq = lane >> 4;
    const int K = g.K, nt = K / BK;
    unsigned voffA[2], voffB[2];
#pragma unroll
    for (int i = 0; i < 2; ++i) { int R, C; stage_rc(tid * 16 + i * 8192, R, C); const int Rb = Epi::PERM ? ((R & ~31) + perm32(R & 31)) : R;
        voffA[i] = (unsigned)(R * K + C) * 2u; voffB[i] = (unsigned)(Rb * K + C) * 2u; }
    const size_t kstep = (size_t)(BK * 2);
    const size_t hstep = (size_t)HALF * K * 2;
    const size_t tstep = 2 * hstep;
    const unsigned ldsw = (unsigned)wid * 1024u;
    const int aoff = lds_byte(wr * 64 + fr, fq * 8), boff = lds_byte(wc * 32 + fr, fq * 8);
#define PG8_SA(b, h) (((b) * 2 + (h)) * HTB)
#define PG8_SB(b, h) ((4 + (b) * 2 + (h)) * HTB)
#define PG8_STAGE(bufoff, gbase, voff) do { _Pragma("unroll") for (int _i = 0; _i < 2; ++_i) \
        __builtin_amdgcn_global_load_lds((const unsigned*)((const char*)(gbase) + (voff)[_i]), (PG8_LAS unsigned*)(lds + (bufoff) + ldsw + _i * 8192), 16, 0, 0); } while (0)
#define PG8_LDA(dst, b, h) do { _Pragma("unroll") for (int m = 0; m < 4; ++m) _Pragma("unroll") for (int k = 0; k < 2; ++k) dst[m][k] = *(const PG8_LAS bf16x8*)(lds + PG8_SA(b, h) + aoff + m * 2048 + k * 1024); } while (0)
#define PG8_LDB(dst, b, h) do { _Pragma("unroll") for (int n = 0; n < 2; ++n) _Pragma("unroll") for (int k = 0; k < 2; ++k) dst[n][k] = *(const PG8_LAS bf16x8*)(lds + PG8_SB(b, h) + boff + n * 2048 + k * 1024); } while (0)
#define PG8_MMA(ai, bj, At, Bt) do { __builtin_amdgcn_s_setprio(1); _Pragma("unroll") for (int m = 0; m < 4; ++m) _Pragma("unroll") for (int n = 0; n < 2; ++n) _Pragma("unroll") for (int k = 0; k < 2; ++k) \
        acc[ai][bj][m][n] = __builtin_amdgcn_mfma_f32_16x16x32_bf16(Bt[n][k], At[m][k], acc[ai][bj][m][n], 0, 0, 0); __builtin_amdgcn_s_setprio(0); } while (0)
#define PG8_WAIT_V(n) asm volatile("s_waitcnt vmcnt(" #n ")" ::: "memory")
#define PG8_WAIT_L(n) asm volatile("s_waitcnt lgkmcnt(" #n ")" ::: "memory")
#define PG8_BAR __builtin_amdgcn_s_barrier()
#define PG8_SCHED __builtin_amdgcn_sched_barrier(0)
    Unit cur, nxt; int ui = 0;
    if (!S.next(0, cur)) return;
    f32x4 acc[2][2][4][2];
#pragma unroll
    for (int a = 0; a < 2; ++a)
#pragma unroll
        for (int b = 0; b < 2; ++b)
#pragma unroll
            for (int m = 0; m < 4; ++m)
#pragma unroll
                for (int n = 0; n < 2; ++n) acc[a][b][m][n] = (f32x4){0.f, 0.f, 0.f, 0.f};
    bf16x8 At[4][2], B0[2][2], B1[2][2];
    const char* cA = (const char*)g.A + (size_t)cur.pm * tstep; const char* cB = (const char*)g.Bt + (size_t)cur.pn * tstep;
    S.a_ready(cur);
    if constexpr (SP2) {
        PG8_STAGE(PG8_SB(0, 0), cB, voffB); PG8_STAGE(PG8_SB(0, 1), cB + hstep, voffB); PG8_STAGE(PG8_SA(0, 0), cA, voffA); PG8_STAGE(PG8_SA(0, 1), cA + hstep, voffA);
        if (wr == 1) PG8_BAR;
        PG8_WAIT_V(2); PG8_BAR;
        PG8_STAGE(PG8_SB(1, 0), cB + kstep, voffB); PG8_STAGE(PG8_SA(1, 0), cA + kstep, voffA); PG8_STAGE(PG8_SB(1, 1), cB + hstep + kstep, voffB);
        PG8_WAIT_V(6); PG8_BAR;
    } else {
        PG8_STAGE(PG8_SB(0, 0), cB, voffB); PG8_STAGE(PG8_SA(0, 0), cA, voffA); PG8_STAGE(PG8_SB(0, 1), cB + hstep, voffB); PG8_STAGE(PG8_SA(0, 1), cA + hstep, voffA);
        if (wr == 1) PG8_BAR;
        PG8_WAIT_V(4); PG8_BAR;
        PG8_STAGE(PG8_SB(1, 0), cB + kstep, voffB); PG8_STAGE(PG8_SA(1, 0), cA + kstep, voffA); PG8_STAGE(PG8_SB(1, 1), cB + hstep + kstep, voffB);
        PG8_WAIT_V(6); PG8_BAR;
    }
    for (;;) {
        const bool has_next = S.next(ui + 1, nxt);
        const char* nA = has_next ? (const char*)g.A + (size_t)nxt.pm * tstep : cA; const char* nB = has_next ? (const char*)g.Bt + (size_t)nxt.pn * tstep : cB;
        for (int t = 0; t < nt; t += 2) {
            const bool last = (t == nt - 2);
            const char* a1 = cA + (size_t)(t + 1) * kstep;
            const char* a2 = last ? nA : cA + (size_t)(t + 2) * kstep; const char* b2 = last ? nB : cB + (size_t)(t + 2) * kstep;
            const char* a3 = a2 + kstep; const char* b3 = b2 + kstep;
            if (last && has_next) S.a_ready(nxt);
            if constexpr (SP2) {
            PG8_LDB(B0, 0, 0); PG8_LDB(B1, 0, 1); PG8_SCHED; PG8_LDA(At, 0, 0); PG8_STAGE(PG8_SA(1, 1), a1 + hstep, voffA);
            PG8_WAIT_V(8); PG8_WAIT_L(0); PG8_BAR; PG8_MMA(0, 0, At, B0); PG8_MMA(0, 1, At, B1); PG8_BAR; PG8_SCHED;
            PG8_LDA(At, 0, 1); PG8_STAGE(PG8_SB(0, 0), b2, voffB); PG8_STAGE(PG8_SB(0, 1), b2 + hstep, voffB); PG8_STAGE(PG8_SA(0, 0), a2, voffA);
            PG8_WAIT_V(8); PG8_WAIT_L(0); PG8_BAR; PG8_MMA(1, 0, At, B0); PG8_MMA(1, 1, At, B1); PG8_BAR; PG8_SCHED;
            PG8_LDB(B0, 1, 0); PG8_LDB(B1, 1, 1); PG8_SCHED; PG8_LDA(At, 1, 0); PG8_STAGE(PG8_SA(0, 1), a2 + hstep, voffA);
            PG8_WAIT_V(8); PG8_WAIT_L(0); PG8_BAR; PG8_MMA(0, 0, At, B0); PG8_MMA(0, 1, At, B1); PG8_BAR; PG8_SCHED;
            PG8_LDA(At, 1, 1); PG8_STAGE(PG8_SB(1, 0), b3, voffB); PG8_STAGE(PG8_SB(1, 1), b3 + hstep, voffB); PG8_STAGE(PG8_SA(1, 0), a3, voffA);
            PG8_WAIT_V(8); PG8_WAIT_L(0); PG8_BAR; PG8_MMA(1, 0, At, B0); PG8_MMA(1, 1, At, B1); PG8_BAR; PG8_SCHED;
            } else {
            PG8_LDB(B0, 0, 0); PG8_SCHED; PG8_LDA(At, 0, 0); PG8_STAGE(PG8_SA(1, 1), a1 + hstep, voffA);
            PG8_WAIT_L(8); PG8_BAR; PG8_WAIT_L(0); PG8_MMA(0, 0, At, B0); PG8_BAR; PG8_SCHED;
            PG8_LDB(B1, 0, 1); PG8_STAGE(PG8_SB(0, 0), b2, voffB);
            PG8_BAR; PG8_WAIT_L(0); PG8_MMA(0, 1, At, B1); PG8_BAR;
            PG8_LDA(At, 0, 1); PG8_STAGE(PG8_SA(0, 0), a2, voffA);
            PG8_BAR; PG8_WAIT_L(0); PG8_MMA(1, 0, At, B0); PG8_BAR; PG8_SCHED;
            PG8_STAGE(PG8_SB(0, 1), b2 + hstep, voffB);
            PG8_WAIT_V(6); PG8_BAR; PG8_MMA(1, 1, At, B1); PG8_BAR;
            PG8_LDB(B0, 1, 0); PG8_SCHED; PG8_LDA(At, 1, 0); PG8_STAGE(PG8_SA(0, 1), a2 + hstep, voffA);
            PG8_WAIT_L(8); PG8_BAR; PG8_WAIT_L(0); PG8_MMA(0, 0, At, B0); PG8_BAR; PG8_SCHED;
            PG8_LDB(B1, 1, 1); PG8_STAGE(PG8_SB(1, 0), b3, voffB);
            PG8_BAR; PG8_WAIT_L(0); PG8_MMA(0, 1, At, B1); PG8_BAR;
            PG8_LDA(At, 1, 1); PG8_STAGE(PG8_SA(1, 0), a3, voffA);
            PG8_BAR; PG8_WAIT_L(0); PG8_MMA(1, 0, At, B0); PG8_BAR; PG8_SCHED;
            PG8_STAGE(PG8_SB(1, 1), b3 + hstep, voffB);
            PG8_WAIT_V(6); PG8_BAR; PG8_MMA(1, 1, At, B1); PG8_BAR;
            }
        }
        if constexpr (ALIGN_EPI) { if (wr == 0) PG8_BAR; }
        if constexpr (!Epi::AFTER_DRAIN) { E(acc, cur, wr, wc, fr, fq); S.done(cur); }
        if (!has_next) break;
#pragma unroll
        for (int a = 0; a < 2; ++a)
#pragma unroll
            for (int b = 0; b < 2; ++b)
#pragma unroll
                for (int m = 0; m < 4; ++m)
#pragma unroll
                    for (int n = 0; n < 2; ++n) acc[a][b][m][n] = (f32x4){0.f, 0.f, 0.f, 0.f};
        cur = nxt; cA = nA; cB = nB; ++ui;
        if constexpr (ALIGN_EPI) { if (wr == 1) PG8_BAR; }
    }
    PG8_WAIT_V(0);
    if constexpr (!ALIGN_EPI) { if (wr == 0) PG8_BAR; }
    PG8_BAR;
    if constexpr (Epi::AFTER_DRAIN) { E.fused(acc, cur, wr, wc, fr, fq, lds, wid, lane); S.done(cur); }
#undef PG8_SA
#undef PG8_SB
#undef PG8_STAGE
#undef PG8_LDA
#undef PG8_LDB
#undef PG8_MMA
#undef PG8_WAIT_V
#undef PG8_WAIT_L
#undef PG8_BAR
#undef PG8_SCHED
}
}
#define LAS __attribute__((address_space(3)))
typedef unsigned short bf16;
typedef unsigned v4u __attribute__((ext_vector_type(4)));
typedef unsigned v2u __attribute__((ext_vector_type(2)));
typedef float f32x4 __attribute__((ext_vector_type(4)));
typedef short bf16x8 __attribute__((ext_vector_type(8)));
constexpr int DM = 1024, SEQ = 2048, MP = 16384, NS = 128, MV = MP + NS, MPAD = 16640;
constexpr int DQKV = 3072, INCOLS = 10256, NIN = 10240;
constexpr float EPS = 1e-6f;
constexpr size_t KiB = 1024, MiB = 1u << 20;
constexpr size_t WS_CTL = 0, CTL_BYTES = 64 * KiB;
constexpr size_t WS_MOD = 64 * KiB;
constexpr size_t WS_BA = 2 * MiB;
constexpr size_t WS_GL = 3 * MiB + 256 * KiB;
constexpr size_t WS_WA = 3 * MiB + 512 * KiB, WS_WB = WS_WA + 2 * MiB, WS_WO = WS_WB + 2 * MiB, WS_WIN = WS_WO + 2 * MiB;
constexpr size_t WS_BUF = WS_WIN + 20 * MiB;
constexpr size_t BUF_BYTES = (size_t)MV * 1024 * 2;
constexpr size_t WS_END = WS_BUF + 7 * BUF_BYTES + 512 * KiB;
static_assert(WS_END <= 256 * MiB, "ws map");
constexpr size_t O_YP = 0, O_YS = 16777216, O_NCAP = O_YS + 131072, O_NCQP = O_NCAP + 16384, O_NDP = O_NCQP + 73728,
                 O_NCAS = O_NDP + 1048576, O_NCQS = O_NCAS + 262144, O_NDS = O_NCQS + 1179648, O_END = O_NDS + 16777216;
constexpr int CW_BAR = 4096;
constexpr int LDS_BYTES = 163840, MISC_OFF = LDS_BYTES - 64;

typedef float f32x2v __attribute__((ext_vector_type(2)));
typedef __bf16 bf16x2v __attribute__((ext_vector_type(2)));
__device__ __forceinline__ unsigned pkbf(float lo, float hi) { return pg8::cvt_pk_bf16(lo, hi); }
__device__ __forceinline__ unsigned pk2(float lo, float hi) { const f32x2v v = {lo, hi}; return __builtin_bit_cast(unsigned, __builtin_convertvector(v, bf16x2v)); }
__device__ __forceinline__ float bflo(unsigned u) { return __uint_as_float(u << 16); }
__device__ __forceinline__ float bfhi(unsigned u) { return __uint_as_float(u & 0xffff0000u); }
__device__ __forceinline__ float bf1(unsigned short b) { return __uint_as_float((unsigned)b << 16); }
__device__ __forceinline__ unsigned short f2bf1(float f) { return (unsigned short)(pkbf(f, 0.f) & 0xffffu); }
__device__ __forceinline__ float sigm(float x) { return __builtin_amdgcn_rcpf(1.f + __expf(-x)); }
__device__ __forceinline__ float silu(float x) { return x * sigm(x); }
__device__ __forceinline__ f32x4 silu4(f32x4 v) { return (f32x4){silu(v[0]), silu(v[1]), silu(v[2]), silu(v[3])}; }
__device__ __forceinline__ f32x4 sigm4(f32x4 v) { return (f32x4){sigm(v[0]), sigm(v[1]), sigm(v[2]), sigm(v[3])}; }
__device__ __forceinline__ void unpack8(v4u u, float* f) { f[0] = bflo(u.x); f[1] = bfhi(u.x); f[2] = bflo(u.y); f[3] = bfhi(u.y); f[4] = bflo(u.z); f[5] = bfhi(u.z); f[6] = bflo(u.w); f[7] = bfhi(u.w); }
__device__ __forceinline__ v4u pack8(const float* f) { v4u o; o.x = pkbf(f[0], f[1]); o.y = pkbf(f[2], f[3]); o.z = pkbf(f[4], f[5]); o.w = pkbf(f[6], f[7]); return o; }
__device__ __forceinline__ v2u pack4(f32x4 v) { v2u o; o.x = pkbf(v[0], v[1]); o.y = pkbf(v[2], v[3]); return o; }
__device__ __forceinline__ float dpp_row_shr(float v, int n) {
    const int iv = __builtin_bit_cast(int, v); int r;
    switch (n) { case 1: r = __builtin_amdgcn_update_dpp(0, iv, 0x111, 0xf, 0xf, true); break; case 2: r = __builtin_amdgcn_update_dpp(0, iv, 0x112, 0xf, 0xf, true); break;
                 case 4: r = __builtin_amdgcn_update_dpp(0, iv, 0x114, 0xf, 0xf, true); break; default: r = __builtin_amdgcn_update_dpp(0, iv, 0x118, 0xf, 0xf, true); break; }
    return __builtin_bit_cast(float, r);
}
__device__ __forceinline__ float wave_sum(float v) {
    v += dpp_row_shr(v, 1); v += dpp_row_shr(v, 2); v += dpp_row_shr(v, 4); v += dpp_row_shr(v, 8);
    v += __builtin_bit_cast(float, __builtin_amdgcn_update_dpp(0, __builtin_bit_cast(int, v), 0x142, 0xa, 0xf, false));
    v += __builtin_bit_cast(float, __builtin_amdgcn_update_dpp(0, __builtin_bit_cast(int, v), 0x143, 0xc, 0xf, false));
    return __uint_as_float(__builtin_amdgcn_readlane(__float_as_uint(v), 63));
}
__device__ __forceinline__ float row16_sum(float v) {
    v += __builtin_bit_cast(float, __builtin_amdgcn_update_dpp(0, __builtin_bit_cast(int, v), 0xB1, 0xf, 0xf, false));
    v += __builtin_bit_cast(float, __builtin_amdgcn_update_dpp(0, __builtin_bit_cast(int, v), 0x4E, 0xf, 0xf, false));
    v += __builtin_bit_cast(float, __builtin_amdgcn_update_dpp(0, __builtin_bit_cast(int, v), 0x141, 0xf, 0xf, false));
    v += __builtin_bit_cast(float, __builtin_amdgcn_update_dpp(0, __builtin_bit_cast(int, v), 0x140, 0xf, 0xf, false));
    return v;
}
#define LDS_WAIT() asm volatile("s_waitcnt lgkmcnt(0)" ::: "memory")

struct EpiIn {
    static constexpr bool PERM = true, AFTER_DRAIN = false;
    bf16 *U, *GA, *QKV, *ZB, *SGA, *SGB, *UH;
    __device__ __forceinline__ void operator()(const f32x4 (&acc)[2][2][4][2], const pg8::Unit& u, int wr, int wc, int fr, int fq) const {
        const int row0 = u.pm * 256 + wr * 64 + fr, cl = wc * 32 + 8 * fq, pn = u.pn;
        if (pn < 16) {
            bf16* base = (pn < 8 ? U : GA) + 128 * (pn & 7) + cl;
#pragma unroll
            for (int ai = 0; ai < 2; ++ai)
#pragma unroll
                for (int m = 0; m < 4; ++m) {
                    const int row = row0 + ai * 128 + m * 16;
                    if (row < MV) {
                        f32x4 a0 = acc[ai][0][m][0], a1 = acc[ai][0][m][1], b0 = acc[ai][1][m][0], b1 = acc[ai][1][m][1];
                        if (pn >= 8) { b0 = silu4(b0); b1 = silu4(b1); }
                        a0 = a0 * b0; a1 = a1 * b1;
                        v4u w; w.x = pkbf(a0[0], a0[1]); w.y = pkbf(a0[2], a0[3]); w.z = pkbf(a1[0], a1[1]); w.w = pkbf(a1[2], a1[3]);
                        *(v4u*)(base + (size_t)row * 1024) = w;
                        if (pn < 8 && (row & 7) >= 6 && row < MP) *(v4u*)(UH + ((size_t)(row >> 3) * 2 + ((row & 7) - 6)) * 1024 + 128 * (pn & 7) + cl) = w;
                    }
                }
        } else {
            bf16* base; int ldc, act;
            if (pn < 28) { base = QKV + 256 * (pn - 16); ldc = 3072; act = 0; }
            else if (pn < 32) { base = ZB + 256 * (pn - 28); ldc = 1024; act = 1; }
            else if (pn < 36) { base = SGA + 256 * (pn - 32); ldc = 1024; act = 2; }
            else { base = SGB + 256 * (pn - 36); ldc = 1024; act = 2; }
            base += cl;
#pragma unroll
            for (int ai = 0; ai < 2; ++ai)
#pragma unroll
                for (int m = 0; m < 4; ++m) {
                    const int row = row0 + ai * 128 + m * 16;
                    if (row < MV) {
#pragma unroll
                        for (int bj = 0; bj < 2; ++bj) {
                            f32x4 v0 = acc[ai][bj][m][0], v1 = acc[ai][bj][m][1];
                            if (act == 1) { v0 = silu4(v0); v1 = silu4(v1); } else if (act == 2) { v0 = sigm4(v0); v1 = sigm4(v1); }
                            v4u w; w.x = pkbf(v0[0], v0[1]); w.y = pkbf(v0[2], v0[3]); w.z = pkbf(v1[0], v1[1]); w.w = pkbf(v1[2], v1[3]);
                            *(v4u*)(base + (size_t)row * ldc + bj * 128) = w;
                        }
                    }
                }
        }
    }
};
template <class F> struct EpiEl {
    static constexpr bool PERM = true, AFTER_DRAIN = false;
    F f;
    __device__ __forceinline__ void operator()(const f32x4 (&acc)[2][2][4][2], const pg8::Unit& u, int wr, int wc, int fr, int fq) const {
        const int row0 = u.pm * 256 + wr * 64 + fr, col0 = u.pn * 256 + wc * 32 + 8 * fq;
#pragma unroll
        for (int ai = 0; ai < 2; ++ai) {
            typename F::Ops ops[4][2];
#pragma unroll
            for (int m = 0; m < 4; ++m)
#pragma unroll
                for (int bj = 0; bj < 2; ++bj) ops[m][bj] = f.load8(row0 + ai * 128 + m * 16, col0 + bj * 128);
#pragma unroll
            for (int m = 0; m < 4; ++m)
#pragma unroll
                for (int bj = 0; bj < 2; ++bj) f.store8(row0 + ai * 128 + m * 16, col0 + bj * 128, acc[ai][bj][m][0], acc[ai][bj][m][1], ops[m][bj]);
        }
    }
};
struct FOutA { const bf16* SG; bf16* TMP;
    struct Ops { v4u sg; };
    __device__ __forceinline__ Ops load8(int row, int col) const { Ops o; o.sg = *(const v4u*)(SG + (size_t)row * 1024 + col); return o; }
    __device__ __forceinline__ void store8(int row, int col, f32x4 v0, f32x4 v1, const Ops& p) const { float sg[8]; unpack8(p.sg, sg);
        const float r[8] = {sg[0] * v0[0], sg[1] * v0[1], sg[2] * v0[2], sg[3] * v0[3], sg[4] * v1[0], sg[5] * v1[1], sg[6] * v1[2], sg[7] * v1[3]}; *(v4u*)(TMP + (size_t)row * 1024 + col) = pack8(r); }
    __device__ __forceinline__ void operator()(int row, int col, f32x4 v) const { const size_t o = (size_t)row * 1024 + col; const v2u s = *(const v2u*)(SG + o);
        f32x4 r = {bflo(s.x) * v[0], bfhi(s.x) * v[1], bflo(s.y) * v[2], bfhi(s.y) * v[3]}; *(v2u*)(TMP + o) = pack4(r); } };
struct FOutB { const bf16* SG; const bf16* TIN; bf16* TMP;
    struct Ops { v4u sg, t; };
    __device__ __forceinline__ Ops load8(int row, int col) const { Ops o; o.sg = *(const v4u*)(SG + (size_t)row * 1024 + col); o.t = *(const v4u*)(TIN + (size_t)row * 1024 + col); return o; }
    __device__ __forceinline__ void store8(int row, int col, f32x4 v0, f32x4 v1, const Ops& p) const { float sg[8], t[8]; unpack8(p.sg, sg); unpack8(p.t, t);
        const float r[8] = {t[0] + sg[0] * v0[0], t[1] + sg[1] * v0[1], t[2] + sg[2] * v0[2], t[3] + sg[3] * v0[3], t[4] + sg[4] * v1[0], t[5] + sg[5] * v1[1], t[6] + sg[6] * v1[2], t[7] + sg[7] * v1[3]}; *(v4u*)(TMP + (size_t)row * 1024 + col) = pack8(r); }
    __device__ __forceinline__ void operator()(int row, int col, f32x4 v) const { const size_t o = (size_t)row * 1024 + col; const v2u s = *(const v2u*)(SG + o); const v2u t = *(const v2u*)(TIN + o);
        f32x4 r = {bflo(t.x) + bflo(s.x) * v[0], bfhi(t.x) + bfhi(s.x) * v[1], bflo(t.y) + bflo(s.y) * v[2], bfhi(t.y) + bfhi(s.y) * v[3]}; *(v2u*)(TMP + o) = pack4(r); } };
struct FPlain { bf16* T;
    struct Ops { int dummy; };
    __device__ __forceinline__ Ops load8(int, int) const { return Ops{0}; }
    __device__ __forceinline__ void store8(int row, int col, f32x4 v0, f32x4 v1, const Ops&) const { const float r[8] = {v0[0], v0[1], v0[2], v0[3], v1[0], v1[1], v1[2], v1[3]}; *(v4u*)(T + (size_t)row * 1024 + col) = pack8(r); }
    __device__ __forceinline__ void operator()(int row, int col, f32x4 v) const { *(v2u*)(T + (size_t)row * 1024 + col) = pack4(v); } };


template <class F> __device__ __forceinline__ void small_gemm_wg(LAS unsigned char* L, const bf16* A, const bf16* Bt, int rowbase, const F& f, int wg, int nwg, int tid) {
    const int lane = tid & 63, w = tid >> 6;
    LAS f32x4* part = (LAS f32x4*)L;
    for (int tile = wg; tile < 512; tile += nwg) {
        const int rt = tile & 7, ct = tile >> 3;
        const bf16* ap = A + (size_t)(rowbase + rt * 16 + (lane & 15)) * 1024 + 8 * (lane >> 4) + 128 * w;
        const bf16* bp = Bt + (size_t)(ct * 16 + (lane & 15)) * 1024 + 8 * (lane >> 4) + 128 * w;
        bf16x8 a[4], b[4];
#pragma unroll
        for (int s = 0; s < 4; ++s) { a[s] = *(const bf16x8*)(ap + 32 * s); b[s] = *(const bf16x8*)(bp + 32 * s); }
        f32x4 acc = {0.f, 0.f, 0.f, 0.f};
#pragma unroll
        for (int s = 0; s < 4; ++s) acc = __builtin_amdgcn_mfma_f32_16x16x32_bf16(b[s], a[s], acc, 0, 0, 0);
        part[w * 64 + lane] = acc;
        __syncthreads();
        if (w == 0) { f32x4 t = part[lane];
#pragma unroll
            for (int ww = 1; ww < 8; ++ww) t += part[ww * 64 + lane];
            f(rowbase + rt * 16 + (lane & 15), ct * 16 + 4 * (lane >> 4), t); }
        __syncthreads();
    }
}
template <class F> __device__ __forceinline__ void small_gemm(const bf16* A, const bf16* Bt, int rowbase, const F& f, int gw, int NGW, int lane) {
    for (int task = gw; task < 512; task += NGW) {
        const int rt = task & 7, ct = task >> 3;
        const bf16* ap = A + (size_t)(rowbase + rt * 16 + (lane & 15)) * 1024 + 8 * (lane >> 4);
        const bf16* bp = Bt + (size_t)(ct * 16 + (lane & 15)) * 1024 + 8 * (lane >> 4);
        f32x4 acc = {0.f, 0.f, 0.f, 0.f};
#pragma unroll 8
        for (int s = 0; s < 32; ++s) { const bf16x8 a = *(const bf16x8*)(ap + 32 * s), b = *(const bf16x8*)(bp + 32 * s); acc = __builtin_amdgcn_mfma_f32_16x16x32_bf16(b, a, acc, 0, 0, 0); }
        f(rowbase + rt * 16 + (lane & 15), ct * 16 + 4 * (lane >> 4), acc);
    }
}
#define XB_TMO      128
#define XB_XCNT(j)  (256  + 64 * (j))
#define XB_XSUB(j)  (1280 + 64 * (j))
#define XB_XGEN(j)  (2304 + 64 * (j))
#define XB_TOP      3328
#define XB_TOPGEN   3392
#define XCD_BAR_WORDS 3456
#define XB_SPIN_CAP (1u << 18)

__device__ __forceinline__ unsigned xb_ld(unsigned* p)              { return __hip_atomic_load(p, __ATOMIC_RELAXED, __HIP_MEMORY_SCOPE_AGENT); }
__device__ __forceinline__ unsigned xb_add(unsigned* p, unsigned v) { return __hip_atomic_fetch_add(p, v, __ATOMIC_RELAXED, __HIP_MEMORY_SCOPE_AGENT); }
__device__ __forceinline__ unsigned xb_xcc_id() { return (unsigned)__builtin_amdgcn_s_getreg((3 << 11) | 20) & 0xFu; }
#define XB_SPIN(cond, bar) do { unsigned _sp = 0; while (cond) { __builtin_amdgcn_s_sleep(1); \
    if ((++_sp & 255u) == 0u) { if (xb_ld(&(bar)[XB_TMO])) break; if (_sp > XB_SPIN_CAP) { atomicAdd(&(bar)[XB_TMO], 1u); break; } } } } while (0)

struct XcdBarrier {
    unsigned* bar; unsigned x;
    volatile LAS unsigned* st;
};

__device__ __forceinline__ XcdBarrier xcd_barrier_post(unsigned* bar, volatile LAS unsigned* st) {
    XcdBarrier b; b.bar = bar; b.x = xb_xcc_id(); b.st = st;
    if (threadIdx.x == 0) (void)xb_add(&bar[XB_XCNT(b.x)], 1u);
    return b;
}
__device__ __forceinline__ void xcd_barrier_complete(unsigned* bar, unsigned x, unsigned& nloc, unsigned& nx) {
    const unsigned G = gridDim.x * gridDim.y * gridDim.z;
    unsigned sum, cnt, mine, sp = 0u;
    for (;;) {
        sum = 0u; cnt = 0u; mine = 0u;
#pragma unroll
        for (unsigned j = 0; j < 16; ++j) { const unsigned c = xb_ld(&bar[XB_XCNT(j)]); sum += c; cnt += (c > 0u) ? 1u : 0u; mine = (j == x) ? c : mine; }
        if (sum == G) break;
        __builtin_amdgcn_s_sleep(1);
        if ((++sp & 255u) == 0u) { if (xb_ld(&bar[XB_TMO])) break; if (sp > XB_SPIN_CAP) { atomicAdd(&bar[XB_TMO], 1u); break; } }
    }
    nloc = mine > 0u ? mine : 1u; nx = cnt > 0u ? cnt : 1u;
}

__device__ __forceinline__ void xcd_barrier(const XcdBarrier& b) {
    asm volatile("s_waitcnt vmcnt(0)" ::: "memory");
    __syncthreads();
    if (threadIdx.x == 0) {
        unsigned* bar = b.bar;
        __builtin_amdgcn_s_waitcnt(0);
        unsigned nloc = b.st[0], nx = b.st[1];
        if (nloc == 0u) { xcd_barrier_complete(bar, b.x, nloc, nx); b.st[0] = nloc; b.st[1] = nx; }
        const unsigned old = xb_add(&bar[XB_XSUB(b.x)], 1u);
        const unsigned gen = old / nloc;
        if (old + 1u == (gen + 1u) * nloc) {
            __builtin_amdgcn_fence(__ATOMIC_RELEASE, "agent");
            asm volatile("s_waitcnt vmcnt(0)" ::: "memory");
            const unsigned og = xb_add(&bar[XB_TOP], 1u);
            const unsigned tg = og / nx;
            if (og + 1u == (tg + 1u) * nx) xb_add(&bar[XB_TOPGEN], 1u);
            else XB_SPIN(xb_ld(&bar[XB_TOPGEN]) == tg, bar);
            __builtin_amdgcn_fence(__ATOMIC_ACQUIRE, "agent");
            xb_add(&bar[XB_XGEN(b.x)], 1u);
            asm volatile("s_waitcnt vmcnt(0)" ::: "memory");
        } else {
            XB_SPIN(xb_ld(&bar[XB_XGEN(b.x)]) == gen, bar);
            __builtin_amdgcn_fence(__ATOMIC_ACQUIRE, "agent");
            asm volatile("s_waitcnt vmcnt(0)" ::: "memory");
        }
    }
    __syncthreads();
}
__device__ __forceinline__ void p0_transpose_item(const float* W, int ldw, int srccol0, int k0, bf16* WT, int K, int dstrow0, LAS float* scr, int lane) {
    float tv[32];
#pragma unroll
    for (int i = 0; i < 32; ++i) tv[i] = __builtin_nontemporal_load(W + (size_t)(k0 + 2 * i + (lane >> 5)) * ldw + srccol0 + (lane & 31));
#pragma unroll
    for (int i = 0; i < 32; ++i) scr[(2 * i + (lane >> 5)) * 33 + (lane & 31)] = tv[i];
    LDS_WAIT();
    const int c = lane & 7;
#pragma unroll
    for (int j = 0; j < 4; ++j) { const int n = (lane >> 3) + 8 * j; const LAS float* s = scr + (8 * c) * 33 + n;
        v4u o; o.x = pkbf(s[0 * 33], s[1 * 33]); o.y = pkbf(s[2 * 33], s[3 * 33]); o.z = pkbf(s[4 * 33], s[5 * 33]); o.w = pkbf(s[6 * 33], s[7 * 33]);
        *(v4u*)(WT + (size_t)(dstrow0 + n) * K + k0 + 8 * c) = o; }
    LDS_WAIT();
}
__device__ __forceinline__ int win_src_col(int n0) {
    if (n0 < 4096) { const int t = n0 >> 8, half = (n0 >> 7) & 1, ch = 128 * (t & 7) + (n0 & 127); const int blk = (t < 8) ? half : 2 + half; return blk * 1024 + ch; }
    if (n0 < 8192) return n0;
    return n0 + 16;
}
__device__ __forceinline__ void p0_mod_task(const float* cp, const float* cs, const float* ada_w, const float* ada_b, float* MOD, LAS float* sc, int task, int lane) {
    const int cgi = task % 48, rgi = task / 48, col = cgi * 64 + lane, r0 = rgi * 17;
    float acc[17];
#pragma unroll
    for (int r = 0; r < 17; ++r) acc[r] = 0.f;
    for (int k0 = 0; k0 < 1024; k0 += 128) {
        for (int i = 0; i < 34; ++i) { const int idx = i * 64 + lane, r = idx >> 7, kk = idx & 127, rr = r0 + r;
            const float* crow = rr < 8 ? cp + rr * 1024 : cs + (rr - 8) * 1024; const float v = crow[k0 + kk]; sc[idx] = silu(v); }
        LDS_WAIT();
        for (int kk = 0; kk < 128; kk += 4) {
            const float* wp = ada_w + (size_t)(k0 + kk) * 3072 + col;
            const float w0 = wp[0], w1 = wp[3072], w2 = wp[2 * 3072], w3 = wp[3 * 3072];
#pragma unroll
            for (int r = 0; r < 17; ++r) { const f32x4 c4 = *(const LAS f32x4*)(sc + r * 128 + kk); acc[r] += (c4[0] * w0 + c4[1] * w1) + (c4[2] * w2 + c4[3] * w3); }
        }
        LDS_WAIT();
    }
    const float bb = ada_b[col];
#pragma unroll
    for (int r = 0; r < 17; ++r) MOD[(size_t)(r0 + r) * 3072 + col] = acc[r] + bb;
}

__device__ __forceinline__ void phase_mod(const float* const* in, unsigned char* ws, int gwave, int nwaves, int lane) {
    const float* cp = in[2]; const float* cs = in[3]; const float* ada_w = in[7]; const float* ada_b = in[8]; float* MOD = (float*)(ws + WS_MOD);
    const int g = lane >> 4, col = lane & 15;
    for (int task = gwave; task < 576; task += nwaves) {
        const int nt = task % 192, mg = task / 192;
        f32x4 acc[3]; const float* arow[3]; bool av[3];
#pragma unroll
        for (int t = 0; t < 3; ++t) { acc[t] = (f32x4){0.f, 0.f, 0.f, 0.f}; const int row = 48 * mg + 16 * t + col; av[t] = row < 136; const int rr = av[t] ? row : 0; arow[t] = rr < 8 ? cp + rr * 1024 : cs + (rr - 8) * 1024; }
#pragma unroll 2
        for (int s = 0; s < 32; ++s) {
            const int k = 32 * s + 8 * g; float wv[8];
#pragma unroll
            for (int j = 0; j < 8; ++j) wv[j] = ada_w[(size_t)(k + j) * 3072 + 16 * nt + col];
            v4u bt; bt.x = pk2(wv[0], wv[1]); bt.y = pk2(wv[2], wv[3]); bt.z = pk2(wv[4], wv[5]); bt.w = pk2(wv[6], wv[7]);
            const bf16x8 bfrag = __builtin_bit_cast(bf16x8, bt);
#pragma unroll
            for (int t = 0; t < 3; ++t) { f32x4 a0 = *(const f32x4*)(arow[t] + k), a1 = *(const f32x4*)(arow[t] + k + 4);
                a0 = silu4(a0); a1 = silu4(a1); if (!av[t]) { a0 = (f32x4){0.f, 0.f, 0.f, 0.f}; a1 = a0; }
                v4u at; at.x = pk2(a0[0], a0[1]); at.y = pk2(a0[2], a0[3]); at.z = pk2(a1[0], a1[1]); at.w = pk2(a1[2], a1[3]);
                acc[t] = __builtin_amdgcn_mfma_f32_16x16x32_bf16(__builtin_bit_cast(bf16x8, at), bfrag, acc[t], 0, 0, 0); }
        }
        const float bb = ada_b[16 * nt + col];
#pragma unroll
        for (int t = 0; t < 3; ++t)
#pragma unroll
            for (int r = 0; r < 4; ++r) { const int row = 48 * mg + 16 * t + 4 * g + r; if (row < 136) MOD[(size_t)row * 3072 + 16 * nt + col] = acc[t][r] + bb; }
    }
}
__device__ __forceinline__ void phase0(LAS unsigned char* L, const float* const* in, unsigned char* ws, int vcu, int G, int tid) {
    const int lane = tid & 63, wave = __builtin_amdgcn_readfirstlane(tid >> 6);
    LAS float* scr = (LAS float*)(L + wave * 16384);
    const int ntask_w2 = 576 - 2 * G;
    if (wave < 2 || (wave == 2 && vcu < ntask_w2)) return;
    const int gw = (wave >= 3) ? (wave - 3) * G + vcu : 5 * G + (vcu - ntask_w2), NGW = 5 * G + (G - ntask_w2);
    constexpr int I_IN = 16 * 320, I_SQ = 16 * 32;
    for (int it = gw; it < I_IN + 3 * I_SQ; it += NGW) {
        int r = it;
        if (r < I_IN) { const int kb = r / 320, nb = r % 320; p0_transpose_item(in[10], INCOLS, win_src_col(nb * 32), kb * 64, (bf16*)(ws + WS_WIN), 1024, nb * 32, scr, lane); continue; }
        r -= I_IN; const int which = r / I_SQ; r -= which * I_SQ; const int kb = r / 32, nb = r % 32;
        const float* W = which == 0 ? in[16] : (which == 1 ? in[17] : in[18]);
        bf16* WT = (bf16*)(ws + (which == 0 ? WS_WA : (which == 1 ? WS_WB : WS_WO)));
        p0_transpose_item(W, 1024, nb * 32, kb * 64, WT, 1024, nb * 32, scr, lane);
    }
}
__device__ __forceinline__ void phase1(LAS unsigned char* L, const float* const* in, unsigned char* ws, int vcu, int G, int tid) {
    const int lane = tid & 63, wave = tid >> 6;
    LAS float* wba = (LAS float*)L;
    const float* w_in = in[10];
    {
        f32x4 wv[8];
#pragma unroll
        for (int i = 0; i < 8; ++i) { const int idx = tid + 512 * i, k = idx >> 2, q = idx & 3; wv[i] = *(const f32x4*)(w_in + (size_t)k * INCOLS + 8192 + 4 * q); }
#pragma unroll
        for (int i = 0; i < 8; ++i) { const int idx = tid + 512 * i, k = idx >> 2, q = idx & 3;
#pragma unroll
            for (int e = 0; e < 4; ++e) wba[(4 * q + e) * 1024 + k] = wv[i][e]; }
    }
    __syncthreads();
    const float* MOD = (const float*)(ws + WS_MOD); float* BA = (float*)(ws + WS_BA); bf16* H = (bf16*)(ws + WS_BUF);
    const float* npre = in[9];
    float alog = 0.f, dtb = 0.f; if (lane >= 8 && lane < 16) { alog = in[13][lane - 8]; dtb = in[14][lane - 8]; }
    const int gw = vcu * 8 + wave, NGW = G * 8;
    f32x4 np[4];
#pragma unroll
    for (int j = 0; j < 4; ++j) np[j] = *(const f32x4*)(npre + 4 * lane + 256 * j);
    const int nblk = MP / 8;
    for (int blk = gw; blk < nblk + 16 * NS; blk += NGW) {
        const bool samp = blk >= nblk;
        if (samp && ((blk - nblk) & 15)) continue;
        const int sidx = (blk - nblk) >> 4;
        const int m0 = samp ? MP + sidx : blk * 8, nrow = samp ? 1 : 8;
        const int mr = samp ? 8 + sidx : (m0 >> 11);
        const float* xr = samp ? in[1] + (size_t)sidx * 1024 : in[0] + (size_t)m0 * 1024;
        f32x4 sh[4], sc[4], nx[4];
#pragma unroll
        for (int j = 0; j < 4; ++j) { const int k = 4 * lane + 256 * j; nx[j] = __builtin_nontemporal_load((const f32x4*)(xr + k)); sh[j] = *(const f32x4*)(MOD + (size_t)mr * 3072 + k); sc[j] = (*(const f32x4*)(MOD + (size_t)mr * 3072 + 1024 + k) + 1.f) * np[j]; }
        for (int r = 0; r < nrow; ++r) {
            const int m = m0 + r;
            f32x4 v[4]; float ss = 0.f;
#pragma unroll
            for (int j = 0; j < 4; ++j) { v[j] = nx[j]; ss += (v[j][0] * v[j][0] + v[j][1] * v[j][1]) + (v[j][2] * v[j][2] + v[j][3] * v[j][3]); }
            { const int rn = (r + 1 < nrow) ? r + 1 : r;
#pragma unroll
                for (int j = 0; j < 4; ++j) nx[j] = __builtin_nontemporal_load((const f32x4*)(xr + (size_t)rn * 1024 + 4 * lane + 256 * j)); }
            const float rstd = rsqrtf(wave_sum(ss) * (1.f / 1024.f) + EPS);
#pragma unroll
            for (int j = 0; j < 4; ++j) { const int k = 4 * lane + 256 * j; v[j] = v[j] * rstd * sc[j] + sh[j]; *(v2u*)(H + (size_t)m * 1024 + k) = pack4(v[j]); }
            float mine = 0.f;
#pragma unroll
            for (int c = 0; c < 16; ++c) { float p = 0.f;
#pragma unroll
                for (int j = 0; j < 4; ++j) { const f32x4 w4 = *(const LAS f32x4*)(wba + c * 1024 + 4 * lane + 256 * j); p += (v[j][0] * w4[0] + v[j][1] * w4[1]) + (v[j][2] * w4[2] + v[j][3] * w4[3]); }
                p = wave_sum(p); if (lane == c) mine = p; }
            if (lane < 8) BA[(size_t)m * 16 + lane] = sigm(mine);
            else if (lane < 16) { const float xx = mine + dtb; const float sp = fmaxf(xx, 0.f) + log1pf(__expf(-fabsf(xx))); BA[(size_t)m * 16 + lane] = -__expf(alog) * sp; }
        }
    }
}
__device__ __forceinline__ void branch_a_rest(const bf16* U, bf16* GA, const bf16* UH, const float* caw, int bx, int tid) {
    const bool dry = false; (void)dry;
    {
        const int cgp = tid & 127, col = cgp * 8, q = tid >> 7;
        float w0[8], w1[8], w2[8];
#pragma unroll
        for (int e = 0; e < 8; ++e) { w0[e] = caw[col + e]; w1[e] = caw[1024 + col + e]; w2[e] = caw[2048 + col + e]; }
        for (int kk = 0; kk < 4; ++kk) {
            const int kq = 1 + q + 2 * kk; if (kq > 7) break;
            const int i = bx + 256 * kq;
            const int r0 = i * 8; const bool zh = (r0 & 2047) == 0;
            float um2[8], um1[8];
            if (zh) {
#pragma unroll
                for (int e = 0; e < 8; ++e) { um2[e] = 0.f; um1[e] = 0.f; }
            } else { unpack8(*(const v4u*)(UH + ((size_t)(i - 1) * 2) * 1024 + col), um2); unpack8(*(const v4u*)(UH + ((size_t)(i - 1) * 2 + 1) * 1024 + col), um1); }
            v4u ur[8], gr[8];
#pragma unroll
            for (int r = 0; r < 8; ++r) { ur[r] = *(const v4u*)(U + (size_t)(r0 + r) * 1024 + col); gr[r] = *(const v4u*)(GA + (size_t)(r0 + r) * 1024 + col); }
#pragma unroll
            for (int r = 0; r < 8; ++r) { float uc[8], ga[8], o[8]; unpack8(ur[r], uc); unpack8(gr[r], ga);
#pragma unroll
                for (int e = 0; e < 8; ++e) { o[e] = ga[e] * (um2[e] * w0[e] + um1[e] * w1[e] + uc[e] * w2[e]); um2[e] = um1[e]; um1[e] = uc[e]; }
                *(v4u*)(GA + (size_t)(r0 + r) * 1024 + col) = pack8(o); }
        }
    }
}
__device__ __forceinline__ void phase3(const float* const* in, unsigned char* ws, float* out, int vcu, int G, int bx, int tid, bool dry = false) {
    const bf16* UH = (const bf16*)(out + O_NDS);
    const bf16* U = (const bf16*)(ws + WS_BUF + 1 * BUF_BYTES); bf16* GA = (bf16*)(ws + WS_BUF + 2 * BUF_BYTES); const bf16* QKV = (const bf16*)(ws + WS_BUF + 3 * BUF_BYTES);
    const float* caw = in[11];
    {
        const int cgp = tid & 127, col = cgp * 8, q = tid >> 7;
        float w0[8], w1[8], w2[8];
#pragma unroll
        for (int e = 0; e < 8; ++e) { w0[e] = caw[col + e]; w1[e] = caw[1024 + col + e]; w2[e] = caw[2048 + col + e]; }
        for (int kk = 0; kk < 1; ++kk) {
            const int i = bx; if (q != 0) break;
            const int r0 = i * 8; const bool zh = (r0 & 2047) == 0;
            float um2[8], um1[8];
            if (zh) {
#pragma unroll
                for (int e = 0; e < 8; ++e) { um2[e] = 0.f; um1[e] = 0.f; }
            } else { unpack8(*(const v4u*)(UH + ((size_t)(i - 1) * 2) * 1024 + col), um2); unpack8(*(const v4u*)(UH + ((size_t)(i - 1) * 2 + 1) * 1024 + col), um1); }
            v4u ur[8], gr[8];
#pragma unroll
            for (int r = 0; r < 8; ++r) { ur[r] = *(const v4u*)(U + (size_t)(r0 + r) * 1024 + col); gr[r] = *(const v4u*)(GA + (size_t)(r0 + r) * 1024 + col); }
#pragma unroll
            for (int r = 0; r < 8; ++r) { float uc[8], ga[8], o[8]; unpack8(ur[r], uc); unpack8(gr[r], ga);
#pragma unroll
                for (int e = 0; e < 8; ++e) { o[e] = ga[e] * (um2[e] * w0[e] + um1[e] * w1[e] + uc[e] * w2[e]); um2[e] = um1[e]; um1[e] = uc[e]; }
                *(v4u*)(GA + (size_t)(r0 + r) * 1024 + col) = pack8(o); }
        }
    }
    const int gt = vcu * 512 + tid, NT = G * 512;
    const float* sca = in[4]; const float* scq = in[5];
    for (int idx = gt; idx < 128 * 1024; idx += NT) {
        const int s = idx >> 10, ch = idx & 1023; const size_t ro = (size_t)(MP + s) * 1024 + ch;
        const float uc = bf1(U[ro]), ga = bf1(GA[ro]);
        const float s0 = sca[(size_t)(s * 2) * 1024 + ch], s1 = sca[(size_t)(s * 2 + 1) * 1024 + ch];
        const float o = ga * (s0 * caw[ch] + s1 * caw[1024 + ch] + uc * caw[2048 + ch]);
        out[O_NCAS + (size_t)(s * 2) * 1024 + ch] = s1; out[O_NCAS + (size_t)(s * 2 + 1) * 1024 + ch] = uc;
        if (!dry) GA[ro] = f2bf1(o);
    }
    for (int idx = ((gt & 63) == 0 ? (gt >> 6) : 8 * 2 * 128); idx < 8 * 2 * 128; idx += (NT >> 6)) {
        const int col = (idx & 127) * 8, j = (idx >> 7) & 1, b = idx >> 8; float uc[8]; unpack8(*(const v4u*)(UH + ((size_t)(b * 256 + 255) * 2 + j) * 1024 + col), uc);
#pragma unroll
        for (int e = 0; e < 8; ++e) out[O_NCAP + (size_t)(b * 2 + j) * 1024 + col + e] = uc[e];
    }
}
__device__ __forceinline__ void phase3b(const float* const* in, unsigned char* ws, float* out, int gt, int NT) {
    const bf16* QKV = (const bf16*)(ws + WS_BUF + 3 * BUF_BYTES); const float* scq = in[5];
    for (int idx = gt; idx < 8 * 3 * 384; idx += NT) {
        const int cgq = idx % 384, j = (idx / 384) % 3, b = idx / 1152, col = cgq * 8; float uc[8]; unpack8(*(const v4u*)(QKV + (size_t)(b * 2048 + 2045 + j) * 3072 + col), uc);
#pragma unroll
        for (int e = 0; e < 8; ++e) out[O_NCQP + (size_t)(b * 3 + j) * 3072 + col + e] = uc[e];
    }
    for (int idx = gt; idx < 128 * 3 * 384; idx += NT) {
        const int cgq = idx % 384, j = (idx / 384) % 3, s = idx / 1152, col = cgq * 8; float uc[8];
        if (j < 2) {
#pragma unroll
            for (int e = 0; e < 8; ++e) uc[e] = scq[(size_t)(s * 3 + j + 1) * 3072 + col + e];
        } else unpack8(*(const v4u*)(QKV + (size_t)(MP + s) * 3072 + col), uc);
#pragma unroll
        for (int e = 0; e < 8; ++e) out[O_NCQS + (size_t)(s * 3 + j) * 3072 + col + e] = uc[e];
    }
}
__device__ __forceinline__ size_t qkv_gran(int t0, int h, int i) { const int row = i / 48, j = i - row * 48; return (size_t)(t0 + row) * 3072 + (j >> 4) * 1024 + h * 128 + (j & 15) * 8; }
__device__ __forceinline__ void stage_a(LAS unsigned char* L, int item, const bf16* QKV, const float* BA, const float* cbw,
                                        bf16* NW, bf16* QD, bf16* KDT, bf16* UD, bf16* AQK, float* GLv, int tid_in) {
    int tid = tid_in; asm volatile("" : "+v"(tid));
    const int lane = tid & 63, wid = tid >> 6;
    const int c = item & 31, h = (item >> 5) & 7, b = item >> 8, t0 = b * 2048 + c * 64;
    LAS float* sGC = (LAS float*)(L + 0); LAS float* sBETA = (LAS float*)(L + 256); LAS float* sEGC = (LAS float*)(L + 512); LAS float* sKDS = (LAS float*)(L + 768);
    LAS bf16* sQb = (LAS bf16*)(L + 1024);
    LAS bf16* sKb = (LAS bf16*)(L + 18432);
    LAS float* sRHS = (LAS float*)(L + 35840);
    LAS bf16* sKD = (LAS bf16*)(L + 101376);
    LAS float* sA = (LAS float*)(L + 118016);
    LAS bf16* sAQ = (LAS bf16*)(L + 134400);
    if (tid < 64) {
        const float g = BA[(size_t)(t0 + tid) * 16 + 8 + h], be = BA[(size_t)(t0 + tid) * 16 + h];
        float gc = g;
#pragma unroll
        for (int o = 1; o < 64; o <<= 1) { const float n = __shfl_up(gc, o); if (lane >= o) gc += n; }
        const float gl = __uint_as_float(__builtin_amdgcn_readlane(__float_as_uint(gc), 63));
        sGC[tid] = gc; sBETA[tid] = be; sEGC[tid] = __expf(gc); sKDS[tid] = __expf(gl - gc);
        if (tid == 0) GLv[item] = __expf(gl);
    }
    __syncthreads();
    if (tid < 384) {
        const int cg_ = tid % 48, strip = tid / 48, tensor = cg_ >> 4, c8 = (cg_ & 15) * 8;
        const int gcol = tensor * 1024 + h * 128 + c8, rl0 = strip * 8;
        float w[4][8];
#pragma unroll
        for (int j = 0; j < 4; ++j)
#pragma unroll
            for (int e = 0; e < 8; ++e) w[j][e] = cbw[j * 3072 + gcol + e];
        float xw[3][8];
#pragma unroll
        for (int j = 0; j < 3; ++j) { const int rr = rl0 - 3 + j;
            if (c > 0 || rr >= 0) unpack8(*(const v4u*)(QKV + (size_t)(t0 + rr) * 3072 + gcol), xw[j]);
            else {
#pragma unroll
                for (int e = 0; e < 8; ++e) xw[j][e] = 0.f; } }
        v4u rowv[8];
#pragma unroll
        for (int r = 0; r < 8; ++r) rowv[r] = *(const v4u*)(QKV + (size_t)(t0 + rl0 + r) * 3072 + gcol);
#pragma unroll
        for (int r = 0; r < 8; ++r) {
            const int tok = rl0 + r; float cur[8], y[8]; unpack8(rowv[r], cur);
            float ss = 0.f;
#pragma unroll
            for (int e = 0; e < 8; ++e) { y[e] = silu(w[0][e] * xw[0][e] + w[1][e] * xw[1][e] + w[2][e] * xw[2][e] + w[3][e] * cur[e]); ss += y[e] * y[e];
                xw[0][e] = xw[1][e]; xw[1][e] = xw[2][e]; xw[2][e] = cur[e]; }
            ss = row16_sum(ss);
            const float rstd = rsqrtf(ss + EPS);
            if (tensor == 0) {
                const float sc = rstd * 0.08838834764831845f, eg = sEGC[tok]; float qn[8], qd[8];
#pragma unroll
                for (int e = 0; e < 8; ++e) { qn[e] = y[e] * sc; qd[e] = qn[e] * eg; }
                *(LAS v4u*)(sQb + tok * 136 + c8) = pack8(qn);
                const int m = tok >> 4, s = c8 >> 5, jh = (c8 >> 4) & 1, g0 = (c8 & 15) >> 2;
                bf16* dst = QD + (size_t)item * 8192 + ((m * 4 + s) * 64 + 16 * g0 + (tok & 15)) * 8 + 4 * jh;
                v2u p0, p1; p0.x = pkbf(qd[0], qd[1]); p0.y = pkbf(qd[2], qd[3]); p1.x = pkbf(qd[4], qd[5]); p1.y = pkbf(qd[6], qd[7]);
                *(v2u*)dst = p0; *(v2u*)(dst + 16 * 8) = p1;
            } else if (tensor == 1) {
                const float be = sBETA[tok] * sEGC[tok], kd = sKDS[tok]; float kn[8], t8[8];
#pragma unroll
                for (int e = 0; e < 8; ++e) kn[e] = y[e] * rstd;
                *(LAS v4u*)(sKb + tok * 136 + c8) = pack8(kn);
#pragma unroll
                for (int e = 0; e < 8; ++e) t8[e] = kn[e] * be;
                *(LAS f32x4*)(sRHS + tok * 256 + 128 + c8) = (f32x4){t8[0], t8[1], t8[2], t8[3]}; *(LAS f32x4*)(sRHS + tok * 256 + 128 + c8 + 4) = (f32x4){t8[4], t8[5], t8[6], t8[7]};
                LAS unsigned* kdp = (LAS unsigned*)(sKD + tok * 130 + c8);
#pragma unroll
                for (int e = 0; e < 4; ++e) kdp[e] = pkbf(kn[2 * e] * kd, kn[2 * e + 1] * kd);
            } else {
                const float be = sBETA[tok];
                *(LAS f32x4*)(sRHS + tok * 256 + c8) = (f32x4){y[0] * be, y[1] * be, y[2] * be, y[3] * be}; *(LAS f32x4*)(sRHS + tok * 256 + c8 + 4) = (f32x4){y[4] * be, y[5] * be, y[6] * be, y[7] * be};
            }
        }
    }
    __syncthreads();
    {
        const int mat = wid >> 2, wr_ = wid & 3, fr = lane & 15, fq = lane >> 4;
        const LAS bf16* Am = mat ? sQb : sKb;
        f32x4 acc[4];
#pragma unroll
        for (int n = 0; n < 4; ++n) acc[n] = (f32x4){0.f, 0.f, 0.f, 0.f};
#pragma unroll
        for (int s = 0; s < 4; ++s) { const bf16x8 a = *(const LAS bf16x8*)(Am + (16 * wr_ + fr) * 136 + 32 * s + 8 * fq);
#pragma unroll
            for (int n = 0; n < 4; ++n) { const bf16x8 bb = *(const LAS bf16x8*)(sKb + (16 * n + fr) * 136 + 32 * s + 8 * fq); acc[n] = __builtin_amdgcn_mfma_f32_16x16x32_bf16(a, bb, acc[n], 0, 0, 0); } }
#pragma unroll
        for (int n = 0; n < 4; ++n)
#pragma unroll
            for (int r = 0; r < 4; ++r) { const int i = 16 * wr_ + 4 * fq + r, j = 16 * n + fr; const float d = acc[n][r], dec = __expf(sGC[i] - sGC[j]);
                if (mat == 0) sA[i * 64 + j] = (i > j) ? sBETA[i] * d * dec : 0.f;
                else { const float v = (i >= j) ? d * dec : 0.f; const int m = i >> 4, s2 = j >> 5, jj = 4 * ((j >> 4) & 1) + (j & 3), lp = 16 * ((j & 15) >> 2) + (i & 15);
                    sAQ[((m * 2 + s2) * 64 + lp) * 8 + jj] = f2bf1(v); } }
    }
    __syncthreads();
    float x[64];
    if (tid < 256) {
        int zoff; asm volatile("v_mov_b32 %0, 0" : "=v"(zoff));
#pragma unroll
        for (int i = 0; i < 64; ++i) x[i] = sRHS[i * 256 + tid];
#pragma unroll
        for (int i = 1; i < 64; ++i) {
#pragma unroll
            for (int jb = 0; jb < (i + 3) / 4; ++jb) { const f32x4 a4 = *(const LAS f32x4*)(sA + zoff + i * 64 + 4 * jb);
                x[i] -= a4[0] * x[4 * jb]; x[i] -= a4[1] * x[4 * jb + 1]; x[i] -= a4[2] * x[4 * jb + 2]; x[i] -= a4[3] * x[4 * jb + 3]; }
            if ((i & 1) == 1) asm volatile("" : "+v"(zoff), "+v"(x[i]));
        }
    } else {
        const int t2 = tid - 256;
#pragma unroll
        for (int q = 0; q < 4; ++q) { const int p = t2 + 256 * q, l = p & 63, fs = p >> 6, i = fs >> 1, s2 = fs & 1, dk = 16 * i + (l & 15), g = l >> 4; unsigned short v8[8];
#pragma unroll
            for (int j = 0; j < 8; ++j) { const int tok = 32 * s2 + 16 * (j >> 2) + 4 * g + (j & 3); v8[j] = sKD[tok * 130 + dk]; }
            v4u o; o.x = v8[0] | ((unsigned)v8[1] << 16); o.y = v8[2] | ((unsigned)v8[3] << 16); o.z = v8[4] | ((unsigned)v8[5] << 16); o.w = v8[6] | ((unsigned)v8[7] << 16);
            *(v4u*)(KDT + qkv_gran(t0, h, p)) = o; }
#pragma unroll
        for (int q = 0; q < 2; ++q) { const int p = t2 + 256 * q; *(v4u*)(AQK + (size_t)item * 4096 + p * 8) = *(const LAS v4u*)(sAQ + p * 8); }
    }
    __syncthreads();
    LAS bf16* stg = (LAS bf16*)sRHS;
    if (tid < 128) {
        const int dv = tid, w_ = dv >> 4;
#pragma unroll
        for (int m = 0; m < 4; ++m)
#pragma unroll
            for (int g = 0; g < 4; ++g) { v2u p; p.x = pkbf(x[16 * m + 4 * g], x[16 * m + 4 * g + 1]); p.y = pkbf(x[16 * m + 4 * g + 2], x[16 * m + 4 * g + 3]);
                { const int e = ((w_ * 4 + m) * 64 + 16 * g + (dv & 15)) * 4; *(v2u*)(UD + qkv_gran(t0, h, 1024 + (e >> 3)) + (e & 7)) = p; } }
    } else if (tid < 256) {
        const int dk = tid - 128, s = dk >> 5, jh = (dk >> 4) & 1, g = (dk & 15) >> 2, j = 4 * jh + (dk & 3);
#pragma unroll
        for (int tok = 0; tok < 64; ++tok) stg[(((tok >> 4) * 4 + s) * 64 + 16 * g + (tok & 15)) * 8 + j] = f2bf1(-x[tok]);
    }
    __syncthreads();
#pragma unroll
    for (int q = 0; q < 2; ++q) { const int p = tid + 512 * q; *(v4u*)(NW + (size_t)item * 8192 + p * 8) = *(const LAS v4u*)(stg + p * 8); }
    __syncthreads();
}

constexpr int SAP_SETB = 68608, SAP_A = 2 * SAP_SETB, SAP_AQ = SAP_A + 16384;
__device__ __forceinline__ void sap_scan(LAS unsigned char* S, int item, const float* BA, float* GLv, int lane) {
    const int c = item & 31, h = (item >> 5) & 7, b = item >> 8, t0 = b * 2048 + c * 64;
    LAS float* sGC = (LAS float*)S;
    const float g = BA[(size_t)(t0 + lane) * 16 + 8 + h], be = BA[(size_t)(t0 + lane) * 16 + h];
    float gc = g;
#pragma unroll
    for (int o = 1; o < 64; o <<= 1) { const float n = __shfl_up(gc, o); if (lane >= o) gc += n; }
    const float gl = __uint_as_float(__builtin_amdgcn_readlane(__float_as_uint(gc), 63));
    sGC[lane] = gc; sGC[64 + lane] = be; sGC[128 + lane] = __expf(gc); sGC[192 + lane] = __expf(gl - gc);
    if (lane == 0) GLv[item] = __expf(gl);
}
struct SapIn { float w[4][8]; float xw[3][8]; v4u rowv[13]; };
__device__ __forceinline__ void sap_conv_load(SapIn& I, int item, const bf16* QKV, const float* cbw, int ct) {
    const int c = item & 31, h = (item >> 5) & 7, b = item >> 8, t0 = b * 2048 + c * 64;
    const int cg_ = ct % 48, strip = ct / 48, tensor = cg_ >> 4, c8 = (cg_ & 15) * 8;
    const int gcol = tensor * 1024 + h * 128 + c8, rl0 = strip * 13, nr = (strip == 4) ? 12 : 13;
#pragma unroll
    for (int j = 0; j < 4; ++j)
#pragma unroll
        for (int e = 0; e < 8; ++e) I.w[j][e] = cbw[j * 3072 + gcol + e];
#pragma unroll
    for (int j = 0; j < 3; ++j) { const int rr = rl0 - 3 + j;
        if (c > 0 || rr >= 0) unpack8(*(const v4u*)(QKV + (size_t)(t0 + rr) * 3072 + gcol), I.xw[j]);
        else {
#pragma unroll
            for (int e = 0; e < 8; ++e) I.xw[j][e] = 0.f; } }
#pragma unroll
    for (int r = 0; r < 13; ++r) I.rowv[r] = __builtin_nontemporal_load((const v4u*)(QKV + (size_t)(t0 + (r < nr ? rl0 + r : rl0)) * 3072 + gcol));
}
__device__ __forceinline__ void sap_conv(LAS unsigned char* S, int item, SapIn& I, bf16* QD, int ct) {
    const int c = item & 31, h = (item >> 5) & 7, b = item >> 8, t0 = b * 2048 + c * 64; (void)c; (void)h; (void)b; (void)t0;
    LAS float* sGC = (LAS float*)S; LAS bf16* sQb = (LAS bf16*)(S + 1024); LAS bf16* sKb = (LAS bf16*)(S + 18432); LAS bf16* sRH = (LAS bf16*)(S + 35840);
    const int cg_ = ct % 48, strip = ct / 48, tensor = cg_ >> 4, c8 = (cg_ & 15) * 8;
    const int rl0 = strip * 13, nr = (strip == 4) ? 12 : 13;
    float (&w)[4][8] = I.w; float (&xw)[3][8] = I.xw; v4u (&rowv)[13] = I.rowv;
#pragma unroll
    for (int r = 0; r < 13; ++r) if (r < nr) {
        const int tok = rl0 + r; float cur[8], y[8]; unpack8(rowv[r], cur);
        float ss = 0.f;
#pragma unroll
        for (int e = 0; e < 8; ++e) { y[e] = silu(w[0][e] * xw[0][e] + w[1][e] * xw[1][e] + w[2][e] * xw[2][e] + w[3][e] * cur[e]); ss += y[e] * y[e];
            xw[0][e] = xw[1][e]; xw[1][e] = xw[2][e]; xw[2][e] = cur[e]; }
        ss = row16_sum(ss);
        const float rstd = rsqrtf(ss + EPS);
        if (tensor == 0) {
            const float sc = rstd * 0.08838834764831845f, eg = sGC[128 + tok]; float qn[8], qd[8];
#pragma unroll
            for (int e = 0; e < 8; ++e) { qn[e] = y[e] * sc; qd[e] = qn[e] * eg; }
            *(LAS v4u*)(sQb + tok * 136 + c8) = pack8(qn);
            const int m = tok >> 4, s = c8 >> 5, jh = (c8 >> 4) & 1, g0 = (c8 & 15) >> 2;
            bf16* dst = QD + (size_t)item * 8192 + ((m * 4 + s) * 64 + 16 * g0 + (tok & 15)) * 8 + 4 * jh;
            v2u p0, p1; p0.x = pkbf(qd[0], qd[1]); p0.y = pkbf(qd[2], qd[3]); p1.x = pkbf(qd[4], qd[5]); p1.y = pkbf(qd[6], qd[7]);
            *(v2u*)dst = p0; *(v2u*)(dst + 16 * 8) = p1;
        } else if (tensor == 1) {
            const float be = sGC[64 + tok] * sGC[128 + tok]; float kn[8], t8[8];
#pragma unroll
            for (int e = 0; e < 8; ++e) { kn[e] = y[e] * rstd; t8[e] = kn[e] * be; }
            *(LAS v4u*)(sKb + tok * 136 + c8) = pack8(kn);
            *(LAS v4u*)(sRH + tok * 256 + 128 + c8) = pack8(t8);
        } else {
            const float be = sGC[64 + tok]; float t8[8];
#pragma unroll
            for (int e = 0; e < 8; ++e) t8[e] = y[e] * be;
            *(LAS v4u*)(sRH + tok * 256 + c8) = pack8(t8);
        }
    }
}
__device__ __forceinline__ void stage_a_pipe(LAS unsigned char* L, int first, int stride, int nitems, const bf16* QKV, const float* BA, const float* cbw,
                                             bf16* NW, bf16* QD, bf16* KDT, bf16* UD, bf16* AQK, float* GLv, int tid_in,
                                             const bf16* Ubuf, bf16* GAbuf, const bf16* UHbuf, const float* caw) {
    LAS float* sA = (LAS float*)(L + SAP_A); LAS bf16* sAQ = (LAS bf16*)(L + SAP_AQ); LAS bf16* stg = (LAS bf16*)(L + SAP_A);
    { int tid = tid_in; asm volatile("" : "+v"(tid)); const int wid = tid >> 6, lane = tid & 63;
      if (wid == 7) sap_scan(L, first, BA, GLv, lane);
      __syncthreads();
      if (wid >= 4 && tid - 256 < 240) { SapIn I; sap_conv_load(I, first, QKV, cbw, tid - 256); sap_conv(L, first, I, QD, tid - 256); }
      else if (wid < 4) branch_a_rest(Ubuf, GAbuf, UHbuf, caw, first, tid);
      __syncthreads(); }
    for (int k = 0; k < nitems; ++k) {
        int tid = tid_in; asm volatile("" : "+v"(tid));
        const int wid = tid >> 6, lane = tid & 63;
        const int item = first + k * stride, nxt = item + stride; const bool has_next = (k + 1 < nitems);
        LAS unsigned char* S = L + (k & 1) * SAP_SETB; LAS unsigned char* Sn = L + ((k + 1) & 1) * SAP_SETB;
        const int c = item & 31, h = (item >> 5) & 7, b = item >> 8, t0 = b * 2048 + c * 64;
        LAS float* sGC = (LAS float*)S; LAS bf16* sQb = (LAS bf16*)(S + 1024); LAS bf16* sKb = (LAS bf16*)(S + 18432); LAS bf16* sRH = (LAS bf16*)(S + 35840);
        if (wid < 4) {
            {
            const int fr = lane & 15, fq = lane >> 4;
#pragma unroll
            for (int mat = 0; mat < 2; ++mat) {
                const LAS bf16* Am = mat ? sQb : sKb;
                f32x4 acc[4];
#pragma unroll
                for (int n = 0; n < 4; ++n) acc[n] = (f32x4){0.f, 0.f, 0.f, 0.f};
#pragma unroll
                for (int s = 0; s < 4; ++s) { const bf16x8 a = *(const LAS bf16x8*)(Am + (16 * wid + fr) * 136 + 32 * s + 8 * fq);
#pragma unroll
                    for (int n = 0; n < 4; ++n) { const bf16x8 bb = *(const LAS bf16x8*)(sKb + (16 * n + fr) * 136 + 32 * s + 8 * fq); acc[n] = __builtin_amdgcn_mfma_f32_16x16x32_bf16(a, bb, acc[n], 0, 0, 0); } }
#pragma unroll
                for (int n = 0; n < 4; ++n)
#pragma unroll
                    for (int r = 0; r < 4; ++r) { const int i = 16 * wid + 4 * fq + r, j = 16 * n + fr; const float d = acc[n][r], dec = __expf(sGC[i] - sGC[j]);
                        if (mat == 0) sA[j * 64 + i] = (i > j) ? sGC[64 + i] * d * dec : 0.f;
                        else { const float v = (i >= j) ? d * dec : 0.f; const int m = i >> 4, s2 = j >> 5, jj = 4 * ((j >> 4) & 1) + (j & 3), lp = 16 * ((j & 15) >> 2) + (i & 15);
                            sAQ[((m * 2 + s2) * 64 + lp) * 8 + jj] = f2bf1(v); } }
            }
            }
            __syncthreads();
            f32x2v x2[32];
            {
            int zoff; asm volatile("v_mov_b32 %0, 0" : "=v"(zoff));
#pragma unroll
            for (int i = 0; i < 32; ++i) x2[i] = (f32x2v){bf1(sRH[(2 * i) * 256 + tid]), bf1(sRH[(2 * i + 1) * 256 + tid])};
#pragma unroll
            for (int j = 0; j < 63; ++j) {
                const float xj = (j & 1) ? x2[j >> 1][1] : x2[j >> 1][0];
                const f32x2v xjj = {xj, xj};
#pragma unroll
                for (int ib = (j + 1) / 4; ib < 16; ++ib) { const f32x4 a4 = *(const LAS f32x4*)(sA + zoff + j * 64 + 4 * ib);
                    x2[2 * ib] = x2[2 * ib] - (f32x2v){a4[0], a4[1]} * xjj; x2[2 * ib + 1] = x2[2 * ib + 1] - (f32x2v){a4[2], a4[3]} * xjj; }
                if ((j & 1) == 1) asm volatile("" : "+v"(zoff), "+v"(x2[(j + 1) >> 1]));
            }
            }
            float x[64];
#pragma unroll
            for (int i = 0; i < 32; ++i) { x[2 * i] = x2[i][0]; x[2 * i + 1] = x2[i][1]; }
            __syncthreads();
            if (tid < 128) {
                const int dv = tid, w_ = dv >> 4;
#pragma unroll
                for (int m = 0; m < 4; ++m)
#pragma unroll
                    for (int g = 0; g < 4; ++g) { v2u p; p.x = pkbf(x[16 * m + 4 * g], x[16 * m + 4 * g + 1]); p.y = pkbf(x[16 * m + 4 * g + 2], x[16 * m + 4 * g + 3]);
                        const int e = ((w_ * 4 + m) * 64 + 16 * g + (dv & 15)) * 4; *(v2u*)(UD + qkv_gran(t0, h, 1024 + (e >> 3)) + (e & 7)) = p; }
            } else {
                const int dk = tid - 128, s = dk >> 5, jh = (dk >> 4) & 1, g = (dk & 15) >> 2, j = 4 * jh + (dk & 3);
#pragma unroll
                for (int tok = 0; tok < 64; ++tok) stg[(((tok >> 4) * 4 + s) * 64 + 16 * g + (tok & 15)) * 8 + j] = f2bf1(-x[tok]);
            }
#pragma unroll
            for (int q = 0; q < 4; ++q) { const int p = tid + 256 * q, l = p & 63, fs = p >> 6, i = fs >> 1, s2 = fs & 1, dk = 16 * i + (l & 15), g = l >> 4; float v8[8];
#pragma unroll
                for (int j = 0; j < 8; ++j) { const int tok = 32 * s2 + 16 * (j >> 2) + 4 * g + (j & 3); v8[j] = bf1(sKb[tok * 136 + dk]) * sGC[192 + tok]; }
                *(v4u*)(KDT + qkv_gran(t0, h, p)) = pack8(v8); }
#pragma unroll
            for (int q = 0; q < 2; ++q) { const int p = tid + 256 * q; *(v4u*)(AQK + (size_t)item * 4096 + p * 8) = *(const LAS v4u*)(sAQ + p * 8); }
            __syncthreads();
#pragma unroll
            for (int q = 0; q < 4; ++q) { const int p = tid + 256 * q; *(v4u*)(NW + (size_t)item * 8192 + p * 8) = *(const LAS v4u*)(stg + p * 8); }
            __syncthreads();
        } else {
            SapIn I;
            if (tid - 256 < 240 && has_next) sap_conv_load(I, nxt, QKV, cbw, tid - 256);
            if (wid == 7 && has_next) sap_scan(Sn, nxt, BA, GLv, lane);
            __syncthreads();
            if (tid - 256 < 240 && has_next) sap_conv(Sn, nxt, I, QD, tid - 256);
            __syncthreads();
            __syncthreads();
            __syncthreads();
        }
    }
}
__device__ __forceinline__ void stage_b(LAS unsigned char* L, int bh, const bf16* NW, const bf16* QD, const bf16* KDT, const bf16* UD, const bf16* AQK,
                                        const float* GLv, bf16* ZBO, const float* onw, float* ndp, int tid, bool dry = false) {
    const int lane = tid & 63, w = tid >> 6, g = lane >> 4, colx = lane & 15, dv = 16 * w + colx, b = bh >> 3, h = bh & 7;
    LAS float* red = (LAS float*)(L + 114688);
    f32x4 S[8];
#pragma unroll
    for (int i = 0; i < 8; ++i) S[i] = (f32x4){0.f, 0.f, 0.f, 0.f};
    const float ow = onw[dv];
    v4u R[7];
    int kdo[2], udo[4], zbo[4][4];
#pragma unroll
    for (int q = 0; q < 2; ++q) { const int i = tid + 512 * q, row = i / 48, j = i - row * 48; kdo[q] = row * 3072 + (j >> 4) * 1024 + (j & 15) * 8; }
#pragma unroll
    for (int m = 0; m < 4; ++m) { const int e_ = ((w * 4 + m) * 64 + lane) * 4, i = 1024 + (e_ >> 3), row = i / 48, j = i - row * 48; udo[m] = row * 3072 + (j >> 4) * 1024 + (j & 15) * 8 + (e_ & 7);
#pragma unroll
        for (int r = 0; r < 4; ++r) zbo[m][r] = (16 * m + 4 * g + r) * 1024 + dv; }
#define SB_ISSUE(item_) do { const bf16* nwb_ = NW + (size_t)(item_) * 8192; const bf16* qdb_ = QD + (size_t)(item_) * 8192; const bf16* aqb_ = AQK + (size_t)(item_) * 4096; \
        const bf16* kdb_ = KDT + (size_t)(b * 2048 + ((item_) & 31) * 64) * 3072 + h * 128; \
        R[0] = __builtin_nontemporal_load((const v4u*)(nwb_ + tid * 8)); R[1] = __builtin_nontemporal_load((const v4u*)(nwb_ + (tid + 512) * 8)); R[2] = __builtin_nontemporal_load((const v4u*)(qdb_ + tid * 8)); R[3] = __builtin_nontemporal_load((const v4u*)(qdb_ + (tid + 512) * 8)); \
        R[4] = __builtin_nontemporal_load((const v4u*)(kdb_ + kdo[0])); R[5] = __builtin_nontemporal_load((const v4u*)(kdb_ + kdo[1])); R[6] = __builtin_nontemporal_load((const v4u*)(aqb_ + tid * 8)); } while (0)
#define SB_COMMIT(bufi_) do { _Pragma("unroll") for (int q = 0; q < 7; ++q) { const int p = tid + 512 * q; *(LAS v4u*)(L + (bufi_) * 57344 + p * 16) = R[q]; } } while (0)
    SB_ISSUE(bh * 32); SB_COMMIT(0);
    v2u udn[4]; unsigned short zbn[4][4];
#define SB_PRE(item_, t0_) do { const bf16* udb_ = UD + (size_t)(t0_) * 3072 + h * 128; const bf16* zbb_ = ZBO + (size_t)(t0_) * 1024 + h * 128; \
        _Pragma("unroll") for (int m = 0; m < 4; ++m) { udn[m] = *(const v2u*)(udb_ + udo[m]); \
        _Pragma("unroll") for (int r = 0; r < 4; ++r) zbn[m][r] = zbb_[zbo[m][r]]; } } while (0)
    SB_PRE(bh * 32, b * 2048);
    float gln = GLv[bh * 32];
    __syncthreads();
    for (int c = 0; c < 32; ++c) {
        const int item = bh * 32 + c, cur = c & 1, t0 = b * 2048 + c * 64;
        LAS unsigned char* B = L + cur * 57344;
        const int nitem = (c + 1 < 32) ? item + 1 : item, nt0 = (c + 1 < 32) ? t0 + 64 : t0;
        SB_ISSUE(nitem);
        f32x4 vn[4]; unsigned short zb[4][4];
#pragma unroll
        for (int m = 0; m < 4; ++m) { const v2u u2 = udn[m]; vn[m] = (f32x4){bflo(u2.x), bfhi(u2.x), bflo(u2.y), bfhi(u2.y)};
#pragma unroll
            for (int r = 0; r < 4; ++r) zb[m][r] = zbn[m][r]; }
        const float gl = gln;
        gln = GLv[nitem]; SB_PRE(nitem, nt0);
        bf16x8 Sb[4];
#pragma unroll
        for (int s = 0; s < 4; ++s) { v4u t; t.x = pk2(S[2 * s][0], S[2 * s][1]); t.y = pk2(S[2 * s][2], S[2 * s][3]); t.z = pk2(S[2 * s + 1][0], S[2 * s + 1][1]); t.w = pk2(S[2 * s + 1][2], S[2 * s + 1][3]); Sb[s] = __builtin_bit_cast(bf16x8, t); }
        f32x4 o[4];
#pragma unroll
        for (int m = 0; m < 4; ++m) o[m] = (f32x4){0.f, 0.f, 0.f, 0.f};
#pragma unroll
        for (int s = 0; s < 4; ++s)
#pragma unroll
            for (int m = 0; m < 4; ++m) { const bf16x8 a = *(const LAS bf16x8*)(B + ((m * 4 + s) * 64 + lane) * 16); vn[m] = __builtin_amdgcn_mfma_f32_16x16x32_bf16(a, Sb[s], vn[m], 0, 0, 0);
                const bf16x8 a2 = *(const LAS bf16x8*)(B + 16384 + ((m * 4 + s) * 64 + lane) * 16); o[m] = __builtin_amdgcn_mfma_f32_16x16x32_bf16(a2, Sb[s], o[m], 0, 0, 0); }
        bf16x8 vb[2];
#pragma unroll
        for (int s = 0; s < 2; ++s) { v4u t; t.x = pk2(vn[2 * s][0], vn[2 * s][1]); t.y = pk2(vn[2 * s][2], vn[2 * s][3]); t.z = pk2(vn[2 * s + 1][0], vn[2 * s + 1][1]); t.w = pk2(vn[2 * s + 1][2], vn[2 * s + 1][3]); vb[s] = __builtin_bit_cast(bf16x8, t); }
#pragma unroll
        for (int s = 0; s < 2; ++s)
#pragma unroll
            for (int m = 0; m < 4; ++m) { const bf16x8 a = *(const LAS bf16x8*)(B + 49152 + ((m * 2 + s) * 64 + lane) * 16); o[m] = __builtin_amdgcn_mfma_f32_16x16x32_bf16(a, vb[s], o[m], 0, 0, 0); }
#pragma unroll
        for (int ih = 0; ih < 2; ++ih) {
#pragma unroll
            for (int i = 4 * ih; i < 4 * ih + 4; ++i) S[i] = S[i] * gl;
#pragma unroll
            for (int s = 0; s < 2; ++s)
#pragma unroll
                for (int i = 4 * ih; i < 4 * ih + 4; ++i) { const bf16x8 a = *(const LAS bf16x8*)(B + 32768 + ((i * 2 + s) * 64 + lane) * 16); S[i] = __builtin_amdgcn_mfma_f32_16x16x32_bf16(a, vb[s], S[i], 0, 0, 0); }
        }
#pragma unroll
        for (int m = 0; m < 4; ++m)
#pragma unroll
            for (int r = 0; r < 4; ++r) { float q = row16_sum(o[m][r] * o[m][r]);
                if (colx == 0) red[(cur * 64 + 16 * m + 4 * g + r) * 8 + w] = q; }
        SB_COMMIT(cur ^ 1);
        __syncthreads();
        {
            LAS float* rs = red + 1024 + (cur * 8 + w) * 64;
            bf16* zst = ZBO + (size_t)t0 * 1024 + h * 128;
            const f32x4 p0 = *(const LAS f32x4*)(red + (cur * 64 + lane) * 8), p1 = *(const LAS f32x4*)(red + (cur * 64 + lane) * 8 + 4);
            rs[lane] = rsqrtf((((p0[0] + p0[1]) + (p0[2] + p0[3])) + ((p1[0] + p1[1]) + (p1[2] + p1[3]))) * (1.f / 128.f) + EPS);
#pragma unroll
            for (int m = 0; m < 4; ++m) { const f32x4 r4 = *(const LAS f32x4*)(rs + 16 * m + 4 * g);
#pragma unroll
                for (int r = 0; r < 4; ++r) { const int tok = 16 * m + 4 * g + r;
                    (void)tok; if (!dry) zst[zbo[m][r]] = f2bf1(o[m][r] * r4[r] * ow * bf1(zb[m][r])); } }
        }
    }
#pragma unroll
    for (int i = 0; i < 8; ++i)
#pragma unroll
        for (int r = 0; r < 4; ++r) if (!dry) ndp[((size_t)bh * 128 + 16 * i + 4 * g + r) * 128 + dv] = S[i][r];
    __syncthreads();
}
__device__ __forceinline__ void sample_delta(LAS unsigned char* L, int item, const float* const* in, unsigned char* ws, float* out, int tid, bool dry = false) {
    const int lane = tid & 63, wid = tid >> 6, s = item >> 3, h = item & 7;
    LAS float* vals = (LAS float*)L; LAS float* part = (LAS float*)(L + 2048); LAS float* misc = (LAS float*)(L + 4096);
    const bf16* QKV = (const bf16*)(ws + WS_BUF + 3 * BUF_BYTES); const float* BA = (const float*)(ws + WS_BA); bf16* ZBO = (bf16*)(ws + WS_BUF + 6 * BUF_BYTES);
    const float* scq = in[5]; const float* cbw = in[12]; const float* sd = in[6];
    if (tid < 384) { const int tensor = tid >> 7, d = tid & 127, colg = tensor * 1024 + h * 128 + d; const float* st = scq + (size_t)(s * 3) * 3072 + colg;
        const float y = cbw[colg] * st[0] + cbw[3072 + colg] * st[3072] + cbw[2 * 3072 + colg] * st[2 * 3072] + cbw[3 * 3072 + colg] * bf1(QKV[(size_t)(MP + s) * 3072 + colg]);
        vals[tid] = silu(y); }
    __syncthreads();
    if (wid < 2) { const float a0 = vals[wid * 128 + lane], a1 = vals[wid * 128 + 64 + lane]; const float ss = wave_sum(a0 * a0 + a1 * a1);
        if (lane == 0) misc[wid] = rsqrtf(ss + EPS) * (wid == 0 ? 0.08838834764831845f : 1.f); }
    __syncthreads();
    const int dv = tid & 127, grp = tid >> 7, dk0 = 32 * grp;
    const float a = __expf(BA[(size_t)(MP + s) * 16 + 8 + h]), beta = BA[(size_t)(MP + s) * 16 + h], rq = misc[0], rk = misc[1];
    const float* S0 = sd + (size_t)item * 16384; float* S1 = out + O_NDS + (size_t)item * 16384;
    float Sr[32]; float ks = 0.f;
#pragma unroll
    for (int i = 0; i < 32; ++i) { Sr[i] = __builtin_nontemporal_load(S0 + (dk0 + i) * 128 + dv); }
#pragma unroll
    for (int i = 0; i < 32; ++i) ks += vals[128 + dk0 + i] * Sr[i];
    part[grp * 128 + dv] = ks;
    __syncthreads();
    const float kS = a * rk * (part[dv] + part[128 + dv] + part[256 + dv] + part[384 + dv]);
    const float vnew = beta * (vals[256 + dv] - kS);
    float po = 0.f;
#pragma unroll
    for (int i = 0; i < 32; ++i) { const float sn = a * Sr[i] + (vals[128 + dk0 + i] * rk) * vnew; if (!dry) S1[(dk0 + i) * 128 + dv] = sn; po += vals[dk0 + i] * sn; }
    __syncthreads();
    part[grp * 128 + dv] = po;
    __syncthreads();
    const float o = rq * (part[dv] + part[128 + dv] + part[256 + dv] + part[384 + dv]);
    if (wid < 2) { const float ss = wave_sum(o * o); if (lane == 0) misc[2 + wid] = ss; }
    __syncthreads();
    if (tid < 128) { const float rstd = rsqrtf((misc[2] + misc[3]) * (1.f / 128.f) + EPS); const size_t oi = (size_t)(MP + s) * 1024 + h * 128 + dv;
        if (!dry) ZBO[oi] = f2bf1(o * rstd * in[15][dv] * bf1(ZBO[oi])); }
    __syncthreads();
}

__device__ __forceinline__ void seq_full(LAS unsigned char* L, int bh, const bf16* QKV, const float* BA, const float* cbw, bf16* ZBO, const float* onw, float* ndp, int tid) {
    const int lane = tid & 63, wid = tid >> 6, b = bh >> 3, h = bh & 7;
    LAS float* vals = (LAS float*)L; LAS float* part = (LAS float*)(L + 2048); LAS float* misc = (LAS float*)(L + 4096);
    const int dv = tid & 127, grp = tid >> 7, dk0 = 32 * grp;
    float Sr[32];
#pragma unroll
    for (int i = 0; i < 32; ++i) Sr[i] = 0.f;
    const float ow = onw[dv];
    for (int t = 0; t < 2048; ++t) {
        const size_t row = (size_t)b * 2048 + t;
        if (tid < 384) { const int tensor = tid >> 7, d = tid & 127, colg = tensor * 1024 + h * 128 + d; float y = 0.f;
#pragma unroll
            for (int j = 0; j < 4; ++j) { if (t - 3 + j >= 0) y += cbw[j * 3072 + colg] * bf1(QKV[(row - 3 + j) * 3072 + colg]); }
            vals[tid] = silu(y); }
        __syncthreads();
        if (wid < 2) { const float a0 = vals[wid * 128 + lane], a1 = vals[wid * 128 + 64 + lane]; const float ss = wave_sum(a0 * a0 + a1 * a1); if (lane == 0) misc[wid] = rsqrtf(ss + EPS) * (wid == 0 ? 0.08838834764831845f : 1.f); }
        __syncthreads();
        const float a = __expf(BA[row * 16 + 8 + h]), beta = BA[row * 16 + h], rq = misc[0], rk = misc[1];
        float ks = 0.f;
#pragma unroll
        for (int i = 0; i < 32; ++i) ks += vals[128 + dk0 + i] * Sr[i];
        part[grp * 128 + dv] = ks;
        __syncthreads();
        const float kS = a * rk * (part[dv] + part[128 + dv] + part[256 + dv] + part[384 + dv]);
        const float vnew = beta * (vals[256 + dv] - kS);
        float po = 0.f;
#pragma unroll
        for (int i = 0; i < 32; ++i) { Sr[i] = a * Sr[i] + (vals[128 + dk0 + i] * rk) * vnew; po += vals[dk0 + i] * Sr[i]; }
        __syncthreads();
        part[grp * 128 + dv] = po;
        __syncthreads();
        const float o = rq * (part[dv] + part[128 + dv] + part[256 + dv] + part[384 + dv]);
        if (wid < 2) { const float ss = wave_sum(o * o); if (lane == 0) misc[2 + wid] = ss; }
        __syncthreads();
        if (tid < 128) { const float rstd = rsqrtf((misc[2] + misc[3]) * (1.f / 128.f) + EPS); const size_t oi = row * 1024 + h * 128 + dv; ZBO[oi] = f2bf1(o * rstd * ow * bf1(ZBO[oi])); }
        __syncthreads();
    }
#pragma unroll
    for (int i = 0; i < 32; ++i) ndp[((size_t)bh * 128 + dk0 + i) * 128 + dv] = Sr[i];
}
__device__ __forceinline__ void phase_final(const float* const* in, unsigned char* ws, float* out, int vcu, int G, int tid) {
    const int lane = tid & 63, wave = tid >> 6, gw = vcu * 8 + wave, NGW = G * 8;
    const bf16* T = (const bf16*)(ws + WS_BUF + 4 * BUF_BYTES); const float* MOD = (const float*)(ws + WS_MOD); const float* npost = in[19];
    f32x4 np[2][2];
#pragma unroll
    for (int j = 0; j < 2; ++j)
#pragma unroll
        for (int q = 0; q < 2; ++q) np[j][q] = *(const f32x4*)(npost + 512 * j + 8 * lane + 4 * q);
    const int nblk = MP / 8;
    for (int blk = gw; blk < nblk + 16 * NS; blk += NGW) {
        const bool samp = blk >= nblk;
        if (samp && ((blk - nblk) & 15)) continue;
        const int sidx = (blk - nblk) >> 4;
        const int m0 = samp ? MP + sidx : blk * 8, nrow = samp ? 1 : 8, mr = samp ? 8 + sidx : (m0 >> 11);
        const float* xr = samp ? in[1] + (size_t)sidx * 1024 : in[0] + (size_t)m0 * 1024;
        f32x4 gn[2][2];
#pragma unroll
        for (int j = 0; j < 2; ++j)
#pragma unroll
            for (int q = 0; q < 2; ++q) gn[j][q] = *(const f32x4*)(MOD + (size_t)mr * 3072 + 2048 + 512 * j + 8 * lane + 4 * q) * np[j][q];
        v4u tn[2]; f32x4 xn[2][2];
#pragma unroll
        for (int j = 0; j < 2; ++j) { tn[j] = __builtin_nontemporal_load((const v4u*)(T + (size_t)m0 * 1024 + 512 * j + 8 * lane));
#pragma unroll
            for (int q = 0; q < 2; ++q) xn[j][q] = __builtin_nontemporal_load((const f32x4*)(xr + 512 * j + 8 * lane + 4 * q)); }
        for (int r = 0; r < nrow; ++r) {
            const int m = m0 + r;
            float t[2][8]; f32x4 xv[2][2]; float ss = 0.f;
#pragma unroll
            for (int j = 0; j < 2; ++j) { unpack8(tn[j], t[j]);
#pragma unroll
                for (int q = 0; q < 2; ++q) xv[j][q] = xn[j][q];
#pragma unroll
                for (int e = 0; e < 8; ++e) ss += t[j][e] * t[j][e]; }
            { const int rn = (r + 1 < nrow) ? r + 1 : r;
#pragma unroll
                for (int j = 0; j < 2; ++j) { tn[j] = __builtin_nontemporal_load((const v4u*)(T + (size_t)(m0 + rn) * 1024 + 512 * j + 8 * lane));
#pragma unroll
                    for (int q = 0; q < 2; ++q) xn[j][q] = __builtin_nontemporal_load((const f32x4*)(xr + (size_t)rn * 1024 + 512 * j + 8 * lane + 4 * q)); } }
            const float rstd = rsqrtf(wave_sum(ss) * (1.f / 1024.f) + EPS);
#pragma unroll
            for (int j = 0; j < 2; ++j)
#pragma unroll
                for (int q = 0; q < 2; ++q) { const int k = 512 * j + 8 * lane + 4 * q;
                    f32x4 tv = {t[j][4 * q], t[j][4 * q + 1], t[j][4 * q + 2], t[j][4 * q + 3]};
                    *(f32x4*)(out + (size_t)m * 1024 + k) = xv[j][q] + gn[j][q] * (tv * rstd); }
        }
    }
}
struct Args { const float* in[20]; float* out; unsigned char* ws; };
__global__ void __launch_bounds__(512, 2) fwd_kernel(Args args) {
    extern __shared__ __attribute__((aligned(16))) unsigned char lds_raw[];
    LAS unsigned char* L = (LAS unsigned char*)lds_raw;
#define FRESH_TID() ({ int t_ = threadIdx.x; asm volatile("" : "+v"(t_)); t_; })
#define FRESH_WAVE() __builtin_amdgcn_readfirstlane(FRESH_TID() >> 6)
    const int G = gridDim.x, bx = blockIdx.x; const int vcu = (G % 8 == 0) ? (bx % 8) * (G / 8) + bx / 8 : bx;
    unsigned char* ws = args.ws; float* out = args.out;
    if (gridDim.x > 65536u) cg::this_grid().sync();
    volatile LAS unsigned* MISC = (volatile LAS unsigned*)(L + MISC_OFF);
    if (threadIdx.x < 16) MISC[threadIdx.x] = 0u;
    __syncthreads();
    XcdBarrier bar = xcd_barrier_post((unsigned*)(ws + WS_CTL) + CW_BAR, MISC + 8);
    const int NGW = G * 8;
    bf16* B0 = (bf16*)(ws + WS_BUF); bf16* B1 = (bf16*)(ws + WS_BUF + 1 * BUF_BYTES); bf16* B2 = (bf16*)(ws + WS_BUF + 2 * BUF_BYTES); bf16* B3 = (bf16*)(ws + WS_BUF + 3 * BUF_BYTES);
    bf16* B4 = (bf16*)(ws + WS_BUF + 4 * BUF_BYTES); bf16* B6 = (bf16*)(ws + WS_BUF + 6 * BUF_BYTES);
    bf16* D0 = (bf16*)out; bf16* D1 = D0 + (size_t)MV * 1024; bf16* D2 = (bf16*)(out + O_NDS); bf16* D3 = D2 + (size_t)MP * 1024;
    bf16* WIN = (bf16*)(ws + WS_WIN); bf16* WA = (bf16*)(ws + WS_WA); bf16* WB = (bf16*)(ws + WS_WB); bf16* WO = (bf16*)(ws + WS_WO);
    float* GLv = (float*)(ws + WS_GL);

    phase_mod(args.in, ws, FRESH_WAVE() * G + vcu, NGW, FRESH_TID() & 63);
    phase0(L, args.in, ws, vcu, G, FRESH_TID());
    xcd_barrier(bar);
#ifdef DBL_P0
    phase0(L, args.in, ws, vcu, G, FRESH_TID());
#endif
    phase1(L, args.in, ws, vcu, G, FRESH_TID());
#ifdef DBL_P1
    __syncthreads();
    phase1(L, args.in, ws, vcu, G, FRESH_TID());
#endif
    xcd_barrier(bar);
    {   pg8::Gemm g{B0, WIN, MPAD, NIN, 1024}; pg8::StaticOrder S; S.init(MPAD, NIN, G, bx);
        EpiIn E{B1, B2, B3, B6, D0, D1, D2};
        pg8::gemm_phase<EpiIn, pg8::StaticOrder, true, true>(L, g, S, E);
#ifdef DBL_P2
        pg8::gemm_phase<EpiIn, pg8::StaticOrder, true, true>(L, g, S, E);
#endif
 }
    xcd_barrier(bar);
    phase3(args.in, ws, out, vcu, G, bx, FRESH_TID());
    __syncthreads();
    stage_a_pipe(L, bx, G, (2048 - bx + G - 1) / G, B3, (const float*)(ws + WS_BA), args.in[12], B0, B1, B3, B3, WIN, GLv, FRESH_TID(), B1, B2, D2, args.in[11]);
    xcd_barrier(bar);
#ifndef USE_SEQ
#ifdef DBL_P5
    if (bx < 64) { _Pragma("nounroll") for (int rep = 0; rep < 2; ++rep) stage_b(L, bx, B0, B1, B3, B3, WIN, GLv, B6, args.in[15], out + O_NDP, FRESH_TID(), rep == 0); }
    else {
        pg8::StaticOrder S; S.init(MP, 1024, G - 64, bx - 64); pg8::Gemm g{B2, WA, MP, 1024, 1024}; EpiEl<FOutA> E{FOutA{D0, D0}};
        pg8::gemm_phase<EpiEl<FOutA>, pg8::StaticOrder, true, true>(L, g, S, E); small_gemm_wg(L, B2, WA, MP, E.f, bx - 64, G - 64, FRESH_TID());
        for (int it = bx - 64; it < 1024; it += G - 64) sample_delta(L, it, args.in, ws, out, FRESH_TID()); }
#else
    if (bx < 64) stage_b(L, bx, B0, B1, B3, B3, WIN, GLv, B6, args.in[15], out + O_NDP, FRESH_TID());
    else {
        phase3b(args.in, ws, out, (bx - 64) * 512 + FRESH_TID(), (G - 64) * 512);
        pg8::StaticOrder S; S.init(MP, 1024, G - 64, bx - 64); pg8::Gemm g{B2, WA, MP, 1024, 1024}; EpiEl<FOutA> E{FOutA{D0, D0}};
        pg8::gemm_phase<EpiEl<FOutA>, pg8::StaticOrder, true, true>(L, g, S, E); small_gemm_wg(L, B2, WA, MP, E.f, bx - 64, G - 64, FRESH_TID());
        if (bx >= 128) { for (int it = bx - 128; it < 832; it += 128) sample_delta(L, it, args.in, ws, out, FRESH_TID()); }
        else { for (int it = 832 + (bx - 64); it < 1024; it += 64) sample_delta(L, it, args.in, ws, out, FRESH_TID()); } }
#endif
#else
    if (bx < 64) seq_full(L, bx, B3, (const float*)(ws + WS_BA), args.in[12], B6, args.in[15], out + O_NDP, FRESH_TID());
#endif
    xcd_barrier(bar);
#ifdef DBL_P6
    _Pragma("nounroll") for (int rep = 0; rep < 2; ++rep)
#endif
    {   pg8::StaticOrder S; S.init(MP, 1024, G, bx);
        { pg8::Gemm g{B6, WB, MP, 1024, 1024}; EpiEl<FOutB> E{FOutB{D1, D0, B3}}; pg8::gemm_phase<EpiEl<FOutB>, pg8::StaticOrder, true, true>(L, g, S, E); small_gemm_wg(L, B6, WB, MP, E.f, bx, G, FRESH_TID()); } }
    xcd_barrier(bar);
#ifdef DBL_P7
    _Pragma("nounroll") for (int rep = 0; rep < 2; ++rep)
#endif
    {   pg8::StaticOrder S; S.init(MP, 1024, G, bx); pg8::Gemm g{B3, WO, MP, 1024, 1024}; EpiEl<FPlain> E{FPlain{B4}};
        pg8::gemm_phase<EpiEl<FPlain>, pg8::StaticOrder, true, true>(L, g, S, E); small_gemm_wg(L, B3, WO, MP, E.f, bx, G, FRESH_TID()); }
    xcd_barrier(bar);
    phase_final(args.in, ws, out, vcu, G, FRESH_TID());
#ifdef DBL_P8
    phase_final(args.in, ws, out, vcu, G, FRESH_TID());
#endif
}

extern "C" void kernel_launch(void* const* d_in, const int* in_sizes, int n_in, void* d_out, int out_size, void* d_ws, size_t ws_size, hipStream_t stream) {
    static int grid = 0;
    if (grid == 0) {
        if (n_in != 20 || (size_t)out_size != O_END || ws_size < WS_END) { fprintf(stderr, "kernel_launch: unexpected shapes: n_in %d out %d ws %zu\n", n_in, out_size, ws_size); grid = -1; return; }
        int dev = 0, cus = 0, per_cu = 0;
        hipGetDevice(&dev); hipDeviceGetAttribute(&cus, hipDeviceAttributeMultiprocessorCount, dev);
        if (hipFuncSetAttribute((const void*)fwd_kernel, hipFuncAttributeMaxDynamicSharedMemorySize, LDS_BYTES) != hipSuccess) { fprintf(stderr, "kernel_launch: hipFuncSetAttribute failed\n"); grid = -1; return; }
        hipOccupancyMaxActiveBlocksPerMultiprocessor(&per_cu, (const void*)fwd_kernel, 512, LDS_BYTES);
        (void)hipGetLastError();
        if (per_cu < 1) fprintf(stderr, "kernel_launch: occupancy query says %d blocks/CU\n", per_cu);
        grid = cus;
    }
    if (grid < 0) return;
    hipMemsetAsync((char*)d_ws + WS_CTL, 0, CTL_BYTES, stream);
    Args a{};
    for (int i = 0; i < 20; ++i) a.in[i] = (const float*)d_in[i];
    a.out = (float*)d_out; a.ws = (unsigned char*)d_ws;
    void* params[] = {&a};
    hipError_t e = hipLaunchCooperativeKernel((const void*)fwd_kernel, dim3(grid), dim3(512), params, LDS_BYTES, stream);
    if (e != hipSuccess) fprintf(stderr, "kernel_launch: cooperative launch failed: %s (grid %d)\n", hipGetErrorString(e), grid);
}
```
